# Optimizing an MI355X kernel written in HIP

```python
import jax, jax.numpy as jnp
from jax import lax
import numpy as np

D_MODEL = 1024
BATCH = 8
SEQ = 4096
DEPTH = 2

CHUNK = 64
MEM_LEN = 256
D_CONV = 3 * D_MODEL // 8
CONV_WIDTH = 31
D_SGU = 3 * D_MODEL // 8
SGU_HEADS = 4
SGU_CHUNK = 128
D_POOL = D_MODEL // 4
POOL_WINDOWS = (2, 4, 8, 16)
POOL_GROUPS = len(POOL_WINDOWS)
D_MIX = D_CONV + D_SGU + D_POOL
D_IN = 2 * D_CONV + 2 * D_SGU + D_POOL
X_HEADS = 4
X_HEAD_DIM = D_MODEL // X_HEADS
D_FF = ((8 * D_MODEL // 3 + 127) // 128) * 128
N_EXPERTS = 8
TOP_K = 2
D_FF_EXPERT = D_FF
N_DENSE = (DEPTH + 1) // 2
N_MOE = DEPTH // 2
EPS = 1e-6

kernel_name = 'hybrid_conv_sgu_pool_moe_block'


def rms_norm(x, g):
    xf = x.astype(jnp.float32)
    y = xf * lax.rsqrt(jnp.mean(xf * xf, axis=-1, keepdims=True) + EPS)
    return (y * g.astype(jnp.float32)).astype(x.dtype)


def layer_norm(x, g, b):
    xf = x.astype(jnp.float32)
    mu = jnp.mean(xf, axis=-1, keepdims=True)
    var = jnp.mean(jnp.square(xf - mu), axis=-1, keepdims=True)
    y = (xf - mu) * lax.rsqrt(var + EPS) * g.astype(jnp.float32) + b.astype(jnp.float32)
    return y.astype(x.dtype)


def conformer_conv(a, conv_w, conv_b, ln_g, ln_b):
    h = a[..., :D_CONV] * jax.nn.sigmoid(a[..., D_CONV:])
    h = lax.conv_general_dilated(
        h, conv_w[:, None, :], window_strides=(1,),
        padding=[(CONV_WIDTH - 1, 0)],
        dimension_numbers=('NWC', 'WIO', 'NWC'),
        feature_group_count=D_CONV) + conv_b
    h = layer_norm(h, ln_g, ln_b)
    return jax.nn.silu(h)


def spatial_gating(z, ln_g, ln_b, sgu_w, sgu_b):
    z = jax.nn.gelu(z)
    u, v = z[..., :D_SGU], z[..., D_SGU:]
    v = layer_norm(v, ln_g, ln_b)
    B, S, _ = v.shape
    v = v.reshape(B, S // SGU_CHUNK, SGU_CHUNK, SGU_HEADS, D_SGU // SGU_HEADS)
    blk = jnp.arange(SGU_CHUNK) // CHUNK
    mask = blk[:, None] >= blk[None, :]
    w = jnp.where(mask[None], sgu_w, 0)
    s = jnp.einsum('hij,bcjhd->bcihd', w, v) + sgu_b.T[None, None, :, :, None]
    return u * s.reshape(B, S, D_SGU)


def multiscale_pool(c, pool_w, pool_b, pool_scale):
    B, S, _ = c.shape
    gd = D_POOL // POOL_GROUPS
    cf = c.astype(jnp.float32)
    pos = jnp.arange(S)
    outs = []
    for gi, w in enumerate(POOL_WINDOWS):
        cg = cf[..., gi * gd:(gi + 1) * gd]
        cs = jnp.cumsum(cg, axis=1)
        prev = jnp.pad(cs, ((0, 0), (w, 0), (0, 0)))[:, :S]
        cnt = jnp.minimum(pos + 1, w).astype(jnp.float32)[None, :, None]
        outs.append((cs - prev) / cnt - cg)
    p = jnp.stack(outs, axis=2).astype(c.dtype)
    y = jnp.einsum('bsgi,gio->bsgo', p, pool_w) + pool_b
    return y.reshape(B, S, D_POOL) * pool_scale


def memory_cross_attention(h, m, wq, wk, wv, wo):
    B, S, D = h.shape
    M = m.shape[1]
    q = (h @ wq).reshape(B, S, X_HEADS, X_HEAD_DIM)
    k = (m @ wk).reshape(B, M, X_HEADS, X_HEAD_DIM)
    v = (m @ wv).reshape(B, M, X_HEADS, X_HEAD_DIM)
    s = jnp.einsum('bshd,bmhd->bhsm', q, k).astype(jnp.float32) * (X_HEAD_DIM ** -0.5)
    p = jax.nn.softmax(s, axis=-1).astype(h.dtype)
    o = jnp.einsum('bhsm,bmhd->bshd', p, v).reshape(B, S, D)
    return o @ wo


def swiglu(h, wg, wu, wd):
    return (jax.nn.silu(h @ wg) * (h @ wu)) @ wd


def moe_swiglu(h, router_w, wg, wu, wd):
    B, S, D = h.shape
    t = h.reshape(B * S, D)
    logits = (t @ router_w).astype(jnp.float32)
    top_v, top_i = lax.top_k(logits, TOP_K)
    gates = jax.nn.softmax(top_v, axis=-1)
    combine = jnp.sum(jax.nn.one_hot(top_i, N_EXPERTS, dtype=jnp.float32) * gates[..., None], axis=1)
    combine = combine.astype(h.dtype)
    y = jnp.zeros_like(t)
    for e in range(N_EXPERTS):
        y = y + combine[:, e:e + 1] * swiglu(t, wg[e], wu[e], wd[e])
    return y.reshape(B, S, D)


def setup_inputs(seed: int = 0) -> dict:
    key = jax.random.key(seed)
    keys = jax.random.split(key, 32)
    cnt = [0]
    f32 = jnp.float32

    def nk():
        k = keys[cnt[0]]
        cnt[0] += 1
        return k

    def nrm(shape, scale):
        return jax.random.normal(nk(), shape, f32) * scale

    def gain(shape):
        return 1.0 + nrm(shape, 0.02)

    L, D = DEPTH, D_MODEL
    gd = D_POOL // POOL_GROUPS
    return {
        'x': nrm((BATCH, SEQ, D), 1.0),
        'mem': nrm((BATCH, MEM_LEN, D), 1.0),
        'mix_norm_g': gain((L, D)),
        'w_in': nrm((L, D, D_IN), D ** -0.5),
        'conv_w': nrm((L, CONV_WIDTH, D_CONV), CONV_WIDTH ** -0.5),
        'conv_b': nrm((L, D_CONV), 0.02),
        'conv_ln_g': gain((L, D_CONV)),
        'conv_ln_b': nrm((L, D_CONV), 0.02),
        'sgu_ln_g': gain((L, D_SGU)),
        'sgu_ln_b': nrm((L, D_SGU), 0.02),
        'sgu_w': nrm((L, SGU_HEADS, SGU_CHUNK, SGU_CHUNK), SGU_CHUNK ** -0.5),
        'sgu_b': 1.0 + nrm((L, SGU_HEADS, SGU_CHUNK), 0.1),
        'pool_w': nrm((L, POOL_GROUPS, gd, gd), gd ** -0.5),
        'pool_b': nrm((L, POOL_GROUPS, gd), 0.02),
        'pool_scale': 1.0 + nrm((L, D_POOL), 0.05),
        'w_out': nrm((L, D_MIX, D), D_MIX ** -0.5),
        'xattn_norm_g': gain((L, D)),
        'mem_norm_g': gain((L, D)),
        'xattn_wq': nrm((L, D, D), D ** -0.5),
        'xattn_wk': nrm((L, D, D), D ** -0.5),
        'xattn_wv': nrm((L, D, D), D ** -0.5),
        'xattn_wo': nrm((L, D, D), D ** -0.5),
        'ffn_norm_g': gain((L, D)),
        'ffn_wg': nrm((N_DENSE, D, D_FF), D ** -0.5),
        'ffn_wu': nrm((N_DENSE, D, D_FF), D ** -0.5),
        'ffn_wd': nrm((N_DENSE, D_FF, D), D_FF ** -0.5),
        'router_w': nrm((N_MOE, D, N_EXPERTS), D ** -0.5),
        'moe_wg': nrm((N_MOE, N_EXPERTS, D, D_FF_EXPERT), D ** -0.5),
        'moe_wu': nrm((N_MOE, N_EXPERTS, D, D_FF_EXPERT), D ** -0.5),
        'moe_wd': nrm((N_MOE, N_EXPERTS, D_FF_EXPERT, D), D_FF_EXPERT ** -0.5),
        'final_norm_g': gain((D,)),
    }


def reference(x, mem, mix_norm_g, w_in, conv_w, conv_b, conv_ln_g, conv_ln_b,
              sgu_ln_g, sgu_ln_b, sgu_w, sgu_b, pool_w, pool_b, pool_scale, w_out,
              xattn_norm_g, mem_norm_g, xattn_wq, xattn_wk, xattn_wv, xattn_wo,
              ffn_norm_g, ffn_wg, ffn_wu, ffn_wd, router_w, moe_wg, moe_wu, moe_wd,
              final_norm_g):
    a_end = 2 * D_CONV
    b_end = a_end + 2 * D_SGU
    for l in range(DEPTH):
        h = rms_norm(x, mix_norm_g[l])
        z = h @ w_in[l]
        y_a = conformer_conv(z[..., :a_end], conv_w[l], conv_b[l], conv_ln_g[l], conv_ln_b[l])
        y_b = spatial_gating(z[..., a_end:b_end], sgu_ln_g[l], sgu_ln_b[l], sgu_w[l], sgu_b[l])
        y_c = multiscale_pool(z[..., b_end:], pool_w[l], pool_b[l], pool_scale[l])
        mixed = jnp.concatenate([y_a, y_b, y_c], axis=-1)
        x = x + mixed @ w_out[l]
        h = rms_norm(x, xattn_norm_g[l])
        m = rms_norm(mem, mem_norm_g[l])
        x = x + memory_cross_attention(h, m, xattn_wq[l], xattn_wk[l], xattn_wv[l], xattn_wo[l])
        h = rms_norm(x, ffn_norm_g[l])
        if l % 2 == 0:
            j = l // 2
            x = x + swiglu(h, ffn_wg[j], ffn_wu[j], ffn_wd[j])
        else:
            j = l // 2
            x = x + moe_swiglu(h, router_w[j], moe_wg[j], moe_wu[j], moe_wd[j])
    return rms_norm(x, final_norm_g)
```

```cpp
#include <hip/hip_runtime.h>
#include <cstdio>
#include <cstdint>

#ifndef MK_PER_PHASE
#define MK_PER_PHASE 1
#endif

#ifndef EN_PRO
#define EN_PRO 1
#endif
#ifndef EN_GEMM
#define EN_GEMM 1
#endif
#ifndef EN_G1
#define EN_G1 1
#endif
#ifndef EN_G2
#define EN_G2 1
#endif
#ifndef EN_G3
#define EN_G3 1
#endif
#ifndef EN_G4
#define EN_G4 1
#endif
#ifndef EN_KV
#define EN_KV 1
#endif
#ifndef EN_MIX
#define EN_MIX 1
#endif
#ifndef EN_ATT
#define EN_ATT 1
#endif
#ifndef EN_MOE
#define EN_MOE 1
#endif
#ifndef EN_ROUTE
#define EN_ROUTE 1
#endif
#define LAS __attribute__((address_space(3)))
#define GAS __attribute__((address_space(1)))
typedef unsigned short bf16;
typedef short bf16x8 __attribute__((ext_vector_type(8)));
typedef float f32x2 __attribute__((ext_vector_type(2)));
typedef float f32x4 __attribute__((ext_vector_type(4)));
typedef float f32x16 __attribute__((ext_vector_type(16)));
typedef unsigned u32x2 __attribute__((ext_vector_type(2)));
typedef unsigned u32x4 __attribute__((ext_vector_type(4)));
typedef __bf16 bf16x2_t __attribute__((ext_vector_type(2)));
typedef unsigned long long u64;
typedef unsigned long long u64x2 __attribute__((ext_vector_type(2)));

constexpr int NB = 8, SEQ = 4096, D = 1024, T = NB * SEQ, DIN = 1792, DFF = 2816, NE = 8, MEMLEN = 256, MROWS = NB * MEMLEN;
constexpr float EPS = 1e-6f;
constexpr int NWAVES = 8, NTHREADS = 512;
constexpr int NPH = 22;

constexpr size_t MiB = 1u << 20;
constexpr size_t CTL_ZERO_BYTES = 2 * MiB;
constexpr int CW_BAR = 4096;
constexpr size_t OFF_ROWSS = 64 * 1024;
constexpr size_t OFF_MOECNT = 32 * 1024;
constexpr size_t OFF_MEMSS = 40 * 1024;
constexpr size_t WS_WIN = 2 * MiB;
constexpr size_t WS_WOUT = 9 * MiB;
constexpr size_t WS_WQ = 13 * MiB;
constexpr size_t WS_WO = 17 * MiB;
constexpr size_t WS_WK = 21 * MiB;
constexpr size_t WS_WV = 25 * MiB;
constexpr size_t WS_WGU = 29 * MiB;
constexpr size_t WS_WD = 40 * MiB;
constexpr size_t WS_MWGU = 46 * MiB;
constexpr size_t WS_MWD = 134 * MiB;
constexpr size_t WS_SGUW = 178 * MiB;
constexpr size_t WS_POOLW = 178 * MiB + 512 * 1024;
constexpr size_t WS_XB = 180 * MiB;
constexpr size_t WS_MEMB = 244 * MiB;
constexpr size_t WS_KB = 248 * MiB;
constexpr size_t WS_VT = 256 * MiB;
constexpr size_t WS_ROUTE = 264 * MiB;
constexpr int PERMROWS = 136 * 256;
constexpr size_t WS_ACT = 266 * MiB;
constexpr size_t WS_Z = WS_ACT;
constexpr size_t WS_MIXED = WS_ACT + 112 * MiB;
constexpr size_t WS_Q = WS_ACT;
constexpr size_t WS_O = WS_ACT + 64 * MiB;
constexpr size_t WS_H = WS_ACT;
constexpr size_t WS_END = 512 * MiB;
static_assert(WS_H + (size_t)PERMROWS * DFF * 2 <= WS_END, "ws map");

constexpr int LDS_BYTES = 160 * 1024;
constexpr int MISC_OFF = LDS_BYTES - 256;

__device__ __forceinline__ float bf_lo(unsigned v) { return __uint_as_float(v << 16); }
__device__ __forceinline__ float bf_hi(unsigned v) { return __uint_as_float(v & 0xffff0000u); }
__device__ __forceinline__ unsigned pk_bf16(float lo, float hi) { f32x2 v = {lo, hi}; bf16x2_t b = __builtin_convertvector(v, bf16x2_t); return __builtin_bit_cast(unsigned, b); }
__device__ __forceinline__ bf16 f2bf(float f) { return (bf16)(pk_bf16(f, 0.f) & 0xffffu); }
__device__ __forceinline__ float sigm(float x) { return __builtin_amdgcn_rcpf(1.0f + __expf(-x)); }
__device__ __forceinline__ float silu_f(float x) { return x * sigm(x); }
__device__ __forceinline__ float gelu_tanh(float x) { const float y = 0.7978845608028654f * (x + 0.044715f * x * x * x); return x * sigm(2.0f * y); }
constexpr float SS_FIX = 16777216.0f;
__device__ __forceinline__ u64 ss_to_fix(float ss) { return (u64)(ss * SS_FIX); }
__device__ __forceinline__ float rstd_ss(u64 ssf) { return __builtin_amdgcn_rsqf((float)ssf * (1.0f / (1024.0f * SS_FIX)) + EPS); }
#define OPAQUE(x) asm volatile("" : "+v"(x))
template <int CTRL> __device__ __forceinline__ float dpp_f(float v) { return __builtin_bit_cast(float, __builtin_amdgcn_update_dpp(0, __builtin_bit_cast(int, v), CTRL, 0xf, 0xf, true)); }
__device__ __forceinline__ float row16_sum(float v) { v += dpp_f<0xB1>(v); v += dpp_f<0x4E>(v); v += dpp_f<0x141>(v); v += dpp_f<0x140>(v); return v; }
__device__ __forceinline__ float wave_sum(float v) { v = row16_sum(v); v += __shfl_xor(v, 16); v += __shfl_xor(v, 32); return v; }

namespace pg8 {
constexpr int BM = 256, BK = 64, HALF = 128, HTB = HALF * BK * 2, STAGE_BYTES = 8 * HTB, NXCD = 8, WGM = 8;
__host__ __device__ __forceinline__ int lds_byte(int r, int c) { const int st = (r >> 4) * 2 + (c >> 5), rr = r & 15, cc = c & 31, ob = rr * 64 + cc * 2; return st * 1024 + (ob ^ (((ob >> 9) & 1) << 5)); }
__host__ __device__ __forceinline__ void stage_rc(int b, int& R, int& C) { const int st = b / 1024, sb = b % 1024, swz = sb ^ (((sb >> 9) & 1) << 5); R = (st >> 1) * 16 + swz / 64; C = (st & 1) * 32 + (swz % 64) / 2; }
__host__ __device__ __forceinline__ int perm32(int rho) { const int n = rho >> 4, i = rho & 15; return 8 * (i >> 2) + 4 * n + (i & 3); }

struct Unit { int pm, pn, brow; };
struct Gemm { const bf16* A; const bf16* Bt; const int* perm; int M, N, K; };

struct StaticOrder {
    int nM, nN, nwg, G, c;
    __device__ void init(int M, int N, int G_, int c_) { nM = M / BM; nN = N / BM; nwg = nM * nN; G = G_; c = c_; }
    __device__ bool next(int i, Unit& u) const {
        const long L = (long)i * G + c; if (L >= nwg) return false;
        int wgid = (int)L; { const int q = nwg / NXCD, r = nwg % NXCD, xcd = wgid % NXCD, off = wgid / NXCD; wgid = (xcd < r ? xcd * (q + 1) : r * (q + 1) + (xcd - r) * q) + off; }
        const int nig = WGM * nN, gid = wgid / nig, fm = gid * WGM, gsz = (nM - fm) < WGM ? (nM - fm) : WGM;
        u.pm = fm + ((wgid % nig) % gsz); u.pn = (wgid % nig) / gsz; u.brow = u.pn; return true;
    }
};
struct MoeOrder {
    int nN, G, c; int tp[9];
    __device__ bool next(int i, Unit& u) const {
        const int L = i * G + c; if (L >= tp[8] * nN) return false;
        int e = 0;
#pragma unroll
        for (int j = 1; j < 8; ++j) e += (L >= tp[j] * nN) ? 1 : 0;
        int base = 0, nx = 0;
#pragma unroll
        for (int j = 0; j < 8; ++j) if (e == j) { base = tp[j]; nx = tp[j + 1]; }
        const int te = nx - base, Lp = L - base * nN; u.pn = Lp / te; u.pm = base + Lp % te; u.brow = e * nN + u.pn; return true;
    }
};

typedef f32x4 Acc[2][2][4][2];

template <bool DIRECT> struct EpiRowScale {
    static constexpr bool PERM = true;
    bf16* O; int ldc; const void* rs; float cst;
    __device__ __forceinline__ void operator()(const Acc& acc, const Unit& u, int wr, int wc, int fr, int fq) const {
        const int row0 = u.pm * BM + wr * 64 + fr, col0 = u.pn * BM + wc * 32 + 8 * fq;
#pragma unroll
        for (int ai = 0; ai < 2; ++ai)
#pragma unroll
            for (int m = 0; m < 4; ++m) { const int row = row0 + ai * HALF + m * 16; const float sc = (DIRECT ? ((const float*)rs)[row] : rstd_ss(((const u64*)rs)[row])) * cst;
                bf16* rowp = O + (size_t)row * ldc + col0;
#pragma unroll
                for (int bj = 0; bj < 2; ++bj) { const f32x4 v0 = acc[ai][bj][m][0] * sc, v1 = acc[ai][bj][m][1] * sc;
                    u32x4 w; w.x = pk_bf16(v0[0], v0[1]); w.y = pk_bf16(v0[2], v0[3]); w.z = pk_bf16(v1[0], v1[1]); w.w = pk_bf16(v1[2], v1[3]);
                    *(u32x4*)(rowp + bj * HALF) = w; } }
    }
};
struct EpiColScale {
    static constexpr bool PERM = true;
    bf16* O; int ldc; const u64* css;
    __device__ __forceinline__ void operator()(const Acc& acc, const Unit& u, int wr, int wc, int fr, int fq) const {
        const int row0 = u.pm * BM + wr * 64 + fr, col0 = u.pn * BM + wc * 32 + 8 * fq;
#pragma unroll
        for (int bj = 0; bj < 2; ++bj) {
            const u64* cp = css + col0 + bj * HALF;
            const f32x4 c0 = (f32x4){rstd_ss(cp[0]), rstd_ss(cp[1]), rstd_ss(cp[2]), rstd_ss(cp[3])}, c1 = (f32x4){rstd_ss(cp[4]), rstd_ss(cp[5]), rstd_ss(cp[6]), rstd_ss(cp[7])};
#pragma unroll
            for (int ai = 0; ai < 2; ++ai)
#pragma unroll
                for (int m = 0; m < 4; ++m) { bf16* rowp = O + (size_t)(row0 + ai * HALF + m * 16) * ldc + col0 + bj * HALF;
                    const f32x4 v0 = acc[ai][bj][m][0] * c0, v1 = acc[ai][bj][m][1] * c1;
                    u32x4 w; w.x = pk_bf16(v0[0], v0[1]); w.y = pk_bf16(v0[2], v0[3]); w.z = pk_bf16(v1[0], v1[1]); w.w = pk_bf16(v1[2], v1[3]);
                    *(u32x4*)rowp = w; }
            asm volatile("" ::: "memory"); }
    }
};
template <bool DIRECT> struct EpiSwiglu {
    static constexpr bool PERM = true;
    bf16* O; int ldc; const void* rs;
    __device__ __forceinline__ void operator()(const Acc& acc, const Unit& u, int wr, int wc, int fr, int fq) const {
        const int row0 = u.pm * BM + wr * 64 + fr, col0 = u.pn * HALF + wc * 32 + 8 * fq;
#pragma unroll
        for (int ai = 0; ai < 2; ++ai)
#pragma unroll
            for (int m = 0; m < 4; ++m) { const int row = row0 + ai * HALF + m * 16; const float sc = DIRECT ? ((const float*)rs)[row] : rstd_ss(((const u64*)rs)[row]);
                u32x4 w;
#pragma unroll
                for (int n = 0; n < 2; ++n) { const f32x4 g = acc[ai][0][m][n] * sc, uu = acc[ai][1][m][n] * sc;
                    const float o0 = silu_f(g[0]) * uu[0], o1 = silu_f(g[1]) * uu[1], o2 = silu_f(g[2]) * uu[2], o3 = silu_f(g[3]) * uu[3];
                    w[2 * n] = pk_bf16(o0, o1); w[2 * n + 1] = pk_bf16(o2, o3); }
                *(u32x4*)(O + (size_t)row * ldc + col0) = w;
                asm volatile("" ::: "memory"); }
    }
};
template <bool SCATTER, bool WRITE_XB, bool ACC_SS> struct EpiResid {
    static constexpr bool PERM = true;
    float* X; bf16* XB; u64* ss_out; const int* perm; const float* gp;
    __device__ __forceinline__ void operator()(const Acc& acc, const Unit& u, int wr, int wc, int fr, int fq) const {
        const int row0 = u.pm * BM + wr * 64 + fr, col0 = u.pn * BM + wc * 32 + 8 * fq;
#pragma unroll
        for (int ai = 0; ai < 2; ++ai)
#pragma unroll
            for (int m = 0; m < 4; ++m) { int row = row0 + ai * HALF + m * 16; float gate = 1.0f; bool valid = true;
                if (SCATTER) { const int tok = perm[row]; gate = gp[row]; valid = tok >= 0; row = valid ? tok : 0; }
                float ss = 0.f;
                if (valid) {
#pragma unroll
                    for (int bj = 0; bj < 2; ++bj) { float* xp = X + (size_t)row * D + col0 + bj * HALF;
                        f32x4 n0 = *(const f32x4*)xp, n1 = *(const f32x4*)(xp + 4);
                        n0 += acc[ai][bj][m][0] * gate; n1 += acc[ai][bj][m][1] * gate;
                        *(f32x4*)xp = n0; *(f32x4*)(xp + 4) = n1;
                        if (WRITE_XB) { u32x4 w; w.x = pk_bf16(n0[0], n0[1]); w.y = pk_bf16(n0[2], n0[3]); w.z = pk_bf16(n1[0], n1[1]); w.w = pk_bf16(n1[2], n1[3]);
                            *(u32x4*)(XB + (size_t)row * D + col0 + bj * HALF) = w; }
                        if (ACC_SS) ss += (n0[0] * n0[0] + n0[1] * n0[1]) + (n0[2] * n0[2] + n0[3] * n0[3]) + (n1[0] * n1[0] + n1[1] * n1[1]) + (n1[2] * n1[2] + n1[3] * n1[3]);
                        asm volatile("" ::: "memory"); }
                }
                if (ACC_SS) { ss += __shfl_xor(ss, 16); ss += __shfl_xor(ss, 32);
                    if (fq == 0 && valid) (void)__hip_atomic_fetch_add(ss_out + row, ss_to_fix(ss), __ATOMIC_RELAXED, __HIP_MEMORY_SCOPE_AGENT); }
                asm volatile("" ::: "memory"); }
    }
};

__device__ __forceinline__ void load_offs(const Gemm& g, const Unit& u, const int (&Rr)[2], const int (&Cc)[2], unsigned (&o)[2][2]) {
#pragma unroll
    for (int h = 0; h < 2; ++h)
#pragma unroll
        for (int i = 0; i < 2; ++i) { int row = g.perm[u.pm * BM + h * HALF + Rr[i]]; row = row < 0 ? 0 : row; o[h][i] = (unsigned)(row * g.K + Cc[i]) * 2u; }
}

template <class Epi, class Sched, bool ALIGN_EPI, bool GATHER>
__device__ __forceinline__ void gemm_phase(LAS unsigned char* lds, const Gemm g, const Sched& S, const Epi& E) {
    int tid_ = threadIdx.x; asm volatile("" : "+v"(tid_));
    const int tid = tid_, wid = __builtin_amdgcn_readfirstlane(tid >> 6), lane = tid & 63, wr = wid >> 2, wc = wid & 3, fr = lane & 15, fq = lane >> 4;
    const int K = g.K, nt = K / BK;
    int Rr[2], Cc[2]; unsigned voffA[2], voffB[2];
#pragma unroll
    for (int i = 0; i < 2; ++i) { int R, C; stage_rc(tid * 16 + i * 8192, R, C); Rr[i] = R; Cc[i] = C; const int Rb = Epi::PERM ? ((R & ~31) + perm32(R & 31)) : R;
        voffA[i] = (unsigned)(R * K + C) * 2u; voffB[i] = (unsigned)(Rb * K + C) * 2u; }
    const size_t kstep = (size_t)(BK * 2);
    const size_t hstep = (size_t)HALF * K * 2;
    const size_t tstep = 2 * hstep;
    const unsigned ldsw = (unsigned)wid * 1024u;
    const int aoff = lds_byte(wr * 64 + fr, fq * 8), boff = lds_byte(wc * 32 + fr, fq * 8);
#define PG8_SA(b, h) (((b) * 2 + (h)) * HTB)
#define PG8_SB(b, h) ((4 + (b) * 2 + (h)) * HTB)
#define PG8_STAGE(bufoff, gbase, voff) do { _Pragma("unroll") for (int _i = 0; _i < 2; ++_i) \
        __builtin_amdgcn_global_load_lds((const unsigned*)((const char*)(gbase) + (voff)[_i]), (LAS unsigned*)(lds + (bufoff) + ldsw + _i * 8192), 16, 0, 0); } while (0)
#define PG8_STAGE_A(bufoff, gbase, h) do { if constexpr (GATHER) PG8_STAGE(bufoff, gbase, offA[h]); else PG8_STAGE(bufoff, (gbase) + (h) * hstep, voffA); } while (0)
#define PG8_LDA(dst, b, h) do { _Pragma("unroll") for (int m = 0; m < 4; ++m) _Pragma("unroll") for (int k = 0; k < 2; ++k) dst[m][k] = *(const LAS bf16x8*)(lds + PG8_SA(b, h) + aoff + m * 2048 + k * 1024); } while (0)
#define PG8_LDB(dst, b, h) do { _Pragma("unroll") for (int n = 0; n < 2; ++n) _Pragma("unroll") for (int k = 0; k < 2; ++k) dst[n][k] = *(const LAS bf16x8*)(lds + PG8_SB(b, h) + boff + n * 2048 + k * 1024); } while (0)
#define PG8_MMA(ai, bj, At, Bt) do { __builtin_amdgcn_s_setprio(1); _Pragma("unroll") for (int m = 0; m < 4; ++m) _Pragma("unroll") for (int n = 0; n < 2; ++n) _Pragma("unroll") for (int k = 0; k < 2; ++k) \
        acc[ai][bj][m][n] = __builtin_amdgcn_mfma_f32_16x16x32_bf16(Bt[n][k], At[m][k], acc[ai][bj][m][n], 0, 0, 0); __builtin_amdgcn_s_setprio(0); } while (0)
#define PG8_WAIT_V(n) asm volatile("s_waitcnt vmcnt(" #n ")" ::: "memory")
#define PG8_WAIT_L(n) asm volatile("s_waitcnt lgkmcnt(" #n ")" ::: "memory")
#define PG8_BAR __builtin_amdgcn_s_barrier()
#define PG8_SCHED __builtin_amdgcn_sched_barrier(0)
    Unit cur, nxt; int ui = 0;
    if (!S.next(0, cur)) return;
    Acc acc;
#pragma unroll
    for (int a = 0; a < 2; ++a)
#pragma unroll
        for (int b = 0; b < 2; ++b)
#pragma unroll
            for (int m = 0; m < 4; ++m)
#pragma unroll
                for (int n = 0; n < 2; ++n) acc[a][b][m][n] = (f32x4){0.f, 0.f, 0.f, 0.f};
    bf16x8 At[4][2], B0[2][2], B1[2][2];
    unsigned offA[2][2], offN[2][2];
    if constexpr (GATHER) load_offs(g, cur, Rr, Cc, offA);
    const char* cA = GATHER ? (const char*)g.A : (const char*)g.A + (size_t)cur.pm * tstep; const char* cB = (const char*)g.Bt + (size_t)cur.brow * tstep;
    PG8_STAGE(PG8_SB(0, 0), cB, voffB); PG8_STAGE(PG8_SB(0, 1), cB + hstep, voffB); PG8_STAGE_A(PG8_SA(0, 0), cA, 0); PG8_STAGE_A(PG8_SA(0, 1), cA, 1);
    if (wr == 1) PG8_BAR;
    PG8_WAIT_V(2); PG8_BAR;
    PG8_STAGE(PG8_SB(1, 0), cB + kstep, voffB); PG8_STAGE_A(PG8_SA(1, 0), cA + kstep, 0); PG8_STAGE(PG8_SB(1, 1), cB + hstep + kstep, voffB);
    PG8_WAIT_V(6); PG8_BAR;
    for (;;) {
        const bool has_next = S.next(ui + 1, nxt);
        if constexpr (GATHER) { if (has_next) load_offs(g, nxt, Rr, Cc, offN); else {
#pragma unroll
            for (int h = 0; h < 2; ++h)
#pragma unroll
                for (int i = 0; i < 2; ++i) offN[h][i] = offA[h][i]; } }
        const char* nA = has_next ? (GATHER ? (const char*)g.A : (const char*)g.A + (size_t)nxt.pm * tstep) : cA; const char* nB = has_next ? (const char*)g.Bt + (size_t)nxt.brow * tstep : cB;
        for (int t = 0; t < nt; t += 2) {
            const bool last = (t == nt - 2);
            const char* a1 = cA + (size_t)(t + 1) * kstep;
            const char* a2 = last ? nA : cA + (size_t)(t + 2) * kstep; const char* b2 = last ? nB : cB + (size_t)(t + 2) * kstep;
            const char* a3 = a2 + kstep; const char* b3 = b2 + kstep;
            PG8_LDB(B0, 0, 0); PG8_LDB(B1, 0, 1); PG8_SCHED; PG8_LDA(At, 0, 0); PG8_STAGE_A(PG8_SA(1, 1), a1, 1);
            if constexpr (GATHER) { if (last) {
#pragma unroll
                for (int h = 0; h < 2; ++h)
#pragma unroll
                    for (int i = 0; i < 2; ++i) offA[h][i] = offN[h][i]; } }
            PG8_WAIT_V(8); PG8_WAIT_L(0); PG8_BAR; PG8_MMA(0, 0, At, B0); PG8_MMA(0, 1, At, B1); PG8_BAR; PG8_SCHED;
            PG8_LDA(At, 0, 1); PG8_STAGE(PG8_SB(0, 0), b2, voffB); PG8_STAGE(PG8_SB(0, 1), b2 + hstep, voffB); PG8_STAGE_A(PG8_SA(0, 0), a2, 0);
            PG8_WAIT_V(8); PG8_WAIT_L(0); PG8_BAR; PG8_MMA(1, 0, At, B0); PG8_MMA(1, 1, At, B1); PG8_BAR; PG8_SCHED;
            PG8_LDB(B0, 1, 0); PG8_LDB(B1, 1, 1); PG8_SCHED; PG8_LDA(At, 1, 0); PG8_STAGE_A(PG8_SA(0, 1), a2, 1);
            PG8_WAIT_V(8); PG8_WAIT_L(0); PG8_BAR; PG8_MMA(0, 0, At, B0); PG8_MMA(0, 1, At, B1); PG8_BAR; PG8_SCHED;
            PG8_LDA(At, 1, 1); PG8_STAGE(PG8_SB(1, 0), b3, voffB); PG8_STAGE(PG8_SB(1, 1), b3 + hstep, voffB); PG8_STAGE_A(PG8_SA(1, 0), a3, 0);
            PG8_WAIT_V(8); PG8_WAIT_L(0); PG8_BAR; PG8_MMA(1, 0, At, B0); PG8_MMA(1, 1, At, B1); PG8_BAR; PG8_SCHED;
        }
        if constexpr (ALIGN_EPI) { if (wr == 0) PG8_BAR; }
        E(acc, cur, wr, wc, fr, fq);
        if (!has_next) break;
#pragma unroll
        for (int a = 0; a < 2; ++a)
#pragma unroll
            for (int b = 0; b < 2; ++b)
#pragma unroll
                for (int m = 0; m < 4; ++m)
#pragma unroll
                    for (int n = 0; n < 2; ++n) acc[a][b][m][n] = (f32x4){0.f, 0.f, 0.f, 0.f};
        cur = nxt; cA = nA; cB = nB; ++ui;
        if constexpr (ALIGN_EPI) { if (wr == 1) PG8_BAR; }
    }
    PG8_WAIT_V(0);
    if constexpr (!ALIGN_EPI) { if (wr == 0) PG8_BAR; }
    PG8_BAR;
#undef PG8_SA
#undef PG8_SB
#undef PG8_STAGE
#undef PG8_STAGE_A
#undef PG8_LDA
#undef PG8_LDB
#undef PG8_MMA
#undef PG8_WAIT_V
#undef PG8_WAIT_L
#undef PG8_BAR
#undef PG8_SCHED
}
}

#define XB_TMO      128
#define XB_XCNT(j)  (256  + 64 * (j))
#define XB_XSUB(j)  (1280 + 64 * (j))
#define XB_XGEN(j)  (2304 + 64 * (j))
#define XB_TOP      3328
#define XB_TOPGEN   3392
#define XCD_BAR_WORDS 3456
#define XB_SPIN_CAP (1u << 18)
__device__ __forceinline__ unsigned xb_ld(unsigned* p)              { return __hip_atomic_load(p, __ATOMIC_RELAXED, __HIP_MEMORY_SCOPE_AGENT); }
__device__ __forceinline__ unsigned xb_add(unsigned* p, unsigned v) { return __hip_atomic_fetch_add(p, v, __ATOMIC_RELAXED, __HIP_MEMORY_SCOPE_AGENT); }
__device__ __forceinline__ unsigned xb_xcc_id() { return (unsigned)__builtin_amdgcn_s_getreg((3 << 11) | 20) & 0xFu; }
#define XB_SPIN(cond, bar) do { unsigned _sp = 0; while (cond) { __builtin_amdgcn_s_sleep(1); \
    if ((++_sp & 255u) == 0u) { if (xb_ld(&(bar)[XB_TMO])) break; if (_sp > XB_SPIN_CAP) { atomicAdd(&(bar)[XB_TMO], 1u); break; } } } } while (0)
struct XcdBarrier { unsigned* bar; unsigned x; volatile LAS unsigned* st; };
__device__ __forceinline__ XcdBarrier xcd_barrier_post(unsigned* bar, volatile LAS unsigned* st) {
    XcdBarrier b; b.bar = bar; b.x = xb_xcc_id(); b.st = st;
    if (threadIdx.x == 0) (void)xb_add(&bar[XB_XCNT(b.x)], 1u);
    return b;
}
__device__ __forceinline__ void xcd_barrier_complete(unsigned* bar, unsigned x, unsigned& nloc, unsigned& nx) {
    const unsigned G = gridDim.x * gridDim.y * gridDim.z;
    unsigned sum, cnt, mine, sp = 0u;
    for (;;) {
        sum = 0u; cnt = 0u; mine = 0u;
#pragma unroll
        for (unsigned j = 0; j < 16; ++j) { const unsigned c = xb_ld(&bar[XB_XCNT(j)]); sum += c; cnt += (c > 0u) ? 1u : 0u; mine = (j == x) ? c : mine; }
        if (sum == G) break;
        __builtin_amdgcn_s_sleep(1);
        if ((++sp & 255u) == 0u) { if (xb_ld(&bar[XB_TMO])) break; if (sp > XB_SPIN_CAP) { atomicAdd(&bar[XB_TMO], 1u); break; } }
    }
    nloc = mine > 0u ? mine : 1u; nx = cnt > 0u ? cnt : 1u;
}
__device__ __forceinline__ void xcd_barrier(const XcdBarrier& b) {
    asm volatile("s_waitcnt vmcnt(0)" ::: "memory");
    __syncthreads();
    if (threadIdx.x == 0) {
        unsigned* bar = b.bar;
        __builtin_amdgcn_s_waitcnt(0);
        unsigned nloc = b.st[0], nx = b.st[1];
        if (nloc == 0u) { xcd_barrier_complete(bar, b.x, nloc, nx); b.st[0] = nloc; b.st[1] = nx; }
        const unsigned old = xb_add(&bar[XB_XSUB(b.x)], 1u);
        const unsigned gen = old / nloc;
        if (old + 1u == (gen + 1u) * nloc) {
            __builtin_amdgcn_fence(__ATOMIC_RELEASE, "agent");
            asm volatile("s_waitcnt vmcnt(0)" ::: "memory");
            const unsigned og = xb_add(&bar[XB_TOP], 1u);
            const unsigned tg = og / nx;
            if (og + 1u == (tg + 1u) * nx) xb_add(&bar[XB_TOPGEN], 1u);
            else XB_SPIN(xb_ld(&bar[XB_TOPGEN]) == tg, bar);
            __builtin_amdgcn_fence(__ATOMIC_ACQUIRE, "agent");
            xb_add(&bar[XB_XGEN(b.x)], 1u);
            asm volatile("s_waitcnt vmcnt(0)" ::: "memory");
        } else {
            XB_SPIN(xb_ld(&bar[XB_XGEN(b.x)]) == gen, bar);
            __builtin_amdgcn_fence(__ATOMIC_ACQUIRE, "agent");
            asm volatile("s_waitcnt vmcnt(0)" ::: "memory");
        }
    }
    __syncthreads();
}

struct Args { const float* in[31]; float* out; unsigned char* ws; int ph_lo, ph_hi; };

__device__ __forceinline__ void cvt_item(const float* W, int N, const float* gain, bf16* WT, int Kd, int k0, int n0, int drow0, LAS float* scr, int lane) {
#pragma unroll 8
    for (int i = 0; i < 32; ++i) { const int kk = 2 * i + (lane >> 5); float v = W[(size_t)(k0 + kk) * N + n0 + (lane & 31)]; if (gain) v *= gain[k0 + kk]; scr[kk * 33 + (lane & 31)] = v; }
    asm volatile("s_waitcnt lgkmcnt(0)" ::: "memory");
    const int c = lane & 7;
#pragma unroll
    for (int j = 0; j < 4; ++j) { const int n = (lane >> 3) + 8 * j; const LAS float* s = scr + (8 * c) * 33 + n;
        u32x4 o; o.x = pk_bf16(s[0 * 33], s[1 * 33]); o.y = pk_bf16(s[2 * 33], s[3 * 33]); o.z = pk_bf16(s[4 * 33], s[5 * 33]); o.w = pk_bf16(s[6 * 33], s[7 * 33]);
        *(u32x4*)(WT + (size_t)(drow0 + n) * Kd + k0 + 8 * c) = o; }
    asm volatile("s_waitcnt lgkmcnt(0)" ::: "memory");
}

__device__ __forceinline__ void phase_prologue(const Args& a, LAS unsigned char* lds, int vcu, int G, int tid, int lane, int wave) {
    unsigned char* ws = a.ws;
    LAS float* scr = (LAS float*)(lds + wave * 16384);
    const int gw = vcu * NWAVES + wave, NGW = G * NWAVES;
    constexpr int I_IN = 16 * 56, I_SQ = 16 * 32, I_UP = 16 * 88, I_DN = 44 * 32, I_LAYER = I_IN + 5 * I_SQ, I_FFN = 2 * I_UP + I_DN;
    constexpr int NITEMS = 2 * I_LAYER + 9 * I_FFN;
    for (int it0 = gw; it0 < NITEMS; it0 += NGW) {
        int it = it0; const float* W; const float* gain = nullptr; bf16* WT; int N, Kd, k0, n0, drow0;
        if (it < 2 * I_LAYER) {
            const int l = it / I_LAYER; int r = it - l * I_LAYER;
            if (r < I_IN) { W = a.in[3] + (size_t)l * D * DIN; N = DIN; gain = a.in[2] + l * D; WT = (bf16*)(ws + WS_WIN) + (size_t)l * DIN * D; Kd = D; k0 = 64 * (r / 56); n0 = 32 * (r % 56); drow0 = n0; }
            else { r -= I_IN; const int m = r / I_SQ; r -= m * I_SQ; N = D; Kd = D; k0 = 64 * (r / 32); n0 = 32 * (r % 32); drow0 = n0;
                if (m == 0)      { W = a.in[15] + (size_t)l * D * D; WT = (bf16*)(ws + WS_WOUT) + (size_t)l * D * D; }
                else if (m == 1) { W = a.in[18] + (size_t)l * D * D; gain = a.in[16] + l * D; WT = (bf16*)(ws + WS_WQ) + (size_t)l * D * D; }
                else if (m == 2) { W = a.in[19] + (size_t)l * D * D; gain = a.in[17] + l * D; WT = (bf16*)(ws + WS_WK) + (size_t)l * D * D; }
                else if (m == 3) { W = a.in[20] + (size_t)l * D * D; gain = a.in[17] + l * D; WT = (bf16*)(ws + WS_WV) + (size_t)l * D * D; }
                else             { W = a.in[21] + (size_t)l * D * D; WT = (bf16*)(ws + WS_WO) + (size_t)l * D * D; } }
        } else {
            it -= 2 * I_LAYER; const int ex = it / I_FFN; int r = it - ex * I_FFN;
            const float *wg, *wu, *wd, *gn; bf16 *gu_t, *d_t;
            if (ex == 0) { wg = a.in[23]; wu = a.in[24]; wd = a.in[25]; gn = a.in[22]; gu_t = (bf16*)(ws + WS_WGU); d_t = (bf16*)(ws + WS_WD); }
            else { const size_t e = ex - 1; wg = a.in[27] + e * D * DFF; wu = a.in[28] + e * D * DFF; wd = a.in[29] + e * DFF * D; gn = a.in[22] + D;
                   gu_t = (bf16*)(ws + WS_MWGU) + e * 2 * DFF * D; d_t = (bf16*)(ws + WS_MWD) + e * D * DFF; }
            if (r < 2 * I_UP) { const int isu = r >= I_UP; r -= isu * I_UP; W = isu ? wu : wg; N = DFF; gain = gn; WT = gu_t; Kd = D; k0 = 64 * (r / 88); n0 = 32 * (r % 88);
                drow0 = (n0 >> 7) * 256 + (n0 & 127) + (isu ? 128 : 0); }
            else { r -= 2 * I_UP; W = wd; N = D; WT = d_t; Kd = DFF; k0 = 64 * (r / 32); n0 = 32 * (r % 32); drow0 = n0; }
        }
        cvt_item(W, N, gain, WT, Kd, k0, n0, drow0, scr, lane);
    }
    const int gt = vcu * NTHREADS + tid, NGT = G * NTHREADS;
    for (int i = gt; i < 2 * 4 * 128 * 128; i += NGT) { const int ii = (i >> 7) & 127, jj = i & 127; const float v = a.in[10][i]; ((bf16*)(ws + WS_SGUW))[i] = f2bf(((ii >> 6) >= (jj >> 6)) ? v : 0.f); }
    for (int i = gt; i < 2 * 4 * 64 * 64; i += NGT) { const int lg = i >> 12, o = (i >> 6) & 63, ii = i & 63; ((bf16*)(ws + WS_POOLW))[i] = f2bf(a.in[12][(lg << 12) + ii * 64 + o]); }
    u64* rowss0 = (u64*)(ws + OFF_ROWSS);
    for (int m = gw; m < T + MROWS; m += NGW) {
        const bool isx = m < T; const int r = isx ? m : m - T;
        const f32x4* xr = (const f32x4*)((isx ? a.in[0] : a.in[1]) + (size_t)r * D) + lane;
        f32x4 v[4]; float s = 0.f;
#pragma unroll
        for (int j = 0; j < 4; ++j) { v[j] = xr[64 * j]; s += (v[j][0] * v[j][0] + v[j][1] * v[j][1]) + (v[j][2] * v[j][2] + v[j][3] * v[j][3]); }
        s = wave_sum(s);
        u32x2* o8 = (u32x2*)((isx ? (bf16*)(ws + WS_XB) : (bf16*)(ws + WS_MEMB)) + (size_t)r * D) + lane;
#pragma unroll
        for (int j = 0; j < 4; ++j) { u32x2 w; w.x = pk_bf16(v[j][0], v[j][1]); w.y = pk_bf16(v[j][2], v[j][3]); o8[64 * j] = w; }
        if (isx) { f32x4* xo = (f32x4*)(a.out + (size_t)r * D) + lane;
#pragma unroll
            for (int j = 0; j < 4; ++j) xo[64 * j] = v[j];
            if (lane == 0) rowss0[r] = ss_to_fix(s); }
        else if (lane == 0) ((u64*)(ws + OFF_MEMSS))[r] = ss_to_fix(s);
    }
}

__device__ __forceinline__ void mixer_unit(const Args& a, LAS unsigned char* lds, int l, int u, int tid_in, int lane_in, int wave) {
    int tid = tid_in, lane = lane_in;
    const bf16* z = (const bf16*)(a.ws + WS_Z); bf16* mixed = (bf16*)(a.ws + WS_MIXED);
    const int b = u >> 5, c = u & 31, t0 = c * 128; const size_t R0 = (size_t)b * SEQ + t0;
    {
        const float* cw = a.in[4] + l * 31 * 384; const float* cb = a.in[5] + l * 384; const float* lg = a.in[6] + l * 384; const float* lb = a.in[7] + l * 384;
        for (int it = tid; it < 158 * 48; it += NTHREADS) { const int j = it / 48, v = it - j * 48; u32x4 o = {0u, 0u, 0u, 0u};
            if (t0 - 30 + j >= 0) { const bf16* rp = z + (R0 + j - 30) * DIN + 8 * v; const u32x4 av = *(const u32x4*)rp, gv = *(const u32x4*)(rp + 384);
#pragma unroll
                for (int q = 0; q < 4; ++q) o[q] = pk_bf16(bf_lo(av[q]) * sigm(bf_lo(gv[q])), bf_hi(av[q]) * sigm(bf_hi(gv[q]))); }
            *(LAS u32x4*)(lds + j * 768 + v * 16) = o; }
        __syncthreads();
        LAS float* part = (LAS float*)(lds + 122880);
        OPAQUE(tid); lane = tid & 63;
#pragma unroll 1
        for (int jt = 0; jt < 3; ++jt) { const int item = tid + NTHREADS * jt, rg = item / 192, p = item - rg * 192, q3 = p >> 6;
            f32x2 w[31];
#pragma unroll
            for (int k = 0; k < 31; ++k) w[k] = *(const f32x2*)(cw + k * 384 + 2 * p);
            const f32x2 bias = *(const f32x2*)(cb + 2 * p);
            float y0[16], y1[16];
#pragma unroll
            for (int i = 0; i < 16; ++i) { y0[i] = bias.x; y1[i] = bias.y; }
            const LAS unsigned* hp = (const LAS unsigned*)lds + (rg * 16) * 192 + p;
#pragma unroll
            for (int jj = 0; jj < 46; ++jj) { const unsigned hv = hp[jj * 192]; const float h0 = bf_lo(hv), h1 = bf_hi(hv);
#pragma unroll
                for (int i = 0; i < 16; ++i) { const int k = jj - i; if (k >= 0 && k <= 30) { y0[i] += w[k].x * h0; y1[i] += w[k].y * h1; } } }
#pragma unroll
            for (int i = 0; i < 16; ++i) { float s1 = y0[i] + y1[i], s2 = y0[i] * y0[i] + y1[i] * y1[i];
                s1 = wave_sum(s1); s2 = wave_sum(s2);
                if (lane == 0) { part[((rg * 16 + i) * 3 + q3) * 2] = s1; part[((rg * 16 + i) * 3 + q3) * 2 + 1] = s2; }
                *(unsigned*)(mixed + (R0 + rg * 16 + i) * D + 2 * p) = pk_bf16(y0[i], y1[i]); }
        }
        __syncthreads();
        OPAQUE(tid);
#pragma unroll 1
        for (int jt = 0; jt < 3; ++jt) { const int item = tid + NTHREADS * jt, rg = item / 192, p = item - rg * 192;
            const f32x2 g2 = *(const f32x2*)(lg + 2 * p), b2 = *(const f32x2*)(lb + 2 * p);
#pragma unroll
            for (int i = 0; i < 16; ++i) { const int row = rg * 16 + i; const LAS float* pr = part + row * 6;
                const float S1 = pr[0] + pr[2] + pr[4], S2 = pr[1] + pr[3] + pr[5];
                const float mean = S1 * (1.0f / 384.0f), var = S2 * (1.0f / 384.0f) - mean * mean, rstd = __builtin_amdgcn_rsqf(var + EPS);
                unsigned* mp = (unsigned*)(mixed + (R0 + row) * D + 2 * p); const unsigned yv = *mp;
                const float o0 = (bf_lo(yv) - mean) * rstd * g2.x + b2.x, o1 = (bf_hi(yv) - mean) * rstd * g2.y + b2.y;
                *mp = pk_bf16(silu_f(o0), silu_f(o1)); } }
    }
    {
        OPAQUE(tid); lane = tid & 63;
        const bf16* pwT = (const bf16*)(a.ws + WS_POOLW) + l * 4 * 64 * 64; const float* pb = a.in[13] + l * 256; const float* psc = a.in[14] + l * 256;
        for (int it = tid; it < 143 * 32; it += NTHREADS) { const int j = it >> 5, v = it & 31; u32x4 o = {0u, 0u, 0u, 0u};
            if (t0 - 15 + j >= 0) o = *(const u32x4*)(z + (R0 + j - 15) * DIN + 1536 + 8 * v);
            *(LAS u32x4*)(lds + j * 512 + v * 16) = o; }
        __syncthreads();
        OPAQUE(tid);
        { const int pp = tid & 127, rq = tid >> 7; const int w = 2 << (pp >> 5); const LAS unsigned* cp = (const LAS unsigned*)lds + pp; const int i0 = rq * 32;
            float s0 = 0.f, s1 = 0.f;
#pragma unroll
            for (int kk = 0; kk < 16; ++kk) if (kk < w) { const unsigned v = cp[(i0 + 15 - kk) * 128]; s0 += bf_lo(v); s1 += bf_hi(v); }
            for (int ii = 0; ii < 32; ++ii) { const int i = i0 + ii; const unsigned cv = cp[(i + 15) * 128];
                const int tpos = t0 + i + 1; const float inv = 1.0f / (float)(tpos < w ? tpos : w);
                *(LAS unsigned*)(lds + 73728 + i * 528 + pp * 4) = pk_bf16(s0 * inv - bf_lo(cv), s1 * inv - bf_hi(cv));
                if (ii < 31) { const unsigned vn = cp[(i + 16) * 128], vo = cp[(i + 16 - w) * 128]; s0 += bf_lo(vn) - bf_lo(vo); s1 += bf_hi(vn) - bf_hi(vo); } } }
        __syncthreads();
        OPAQUE(tid); lane = tid & 63;
        { const int r = lane & 15, kq = lane >> 4; f32x4 acc[4][4];
#pragma unroll
            for (int g = 0; g < 4; ++g)
#pragma unroll
                for (int n = 0; n < 4; ++n) acc[g][n] = (f32x4){0.f, 0.f, 0.f, 0.f};
#pragma unroll
            for (int g = 0; g < 4; ++g)
#pragma unroll
                for (int ks = 0; ks < 2; ++ks) { const bf16x8 af = *(const LAS bf16x8*)(lds + 73728 + (16 * wave + r) * 528 + (g * 64 + 32 * ks + 8 * kq) * 2);
#pragma unroll
                    for (int n = 0; n < 4; ++n) { const bf16x8 bfr = *(const bf16x8*)(pwT + ((g * 64 + 16 * n + r) * 64 + 32 * ks + 8 * kq));
                        acc[g][n] = __builtin_amdgcn_mfma_f32_16x16x32_bf16(bfr, af, acc[g][n], 0, 0, 0); } }
            const int row = 16 * wave + r;
#pragma unroll
            for (int g = 0; g < 4; ++g)
#pragma unroll
                for (int n = 0; n < 4; ++n) { const int ch = g * 64 + 16 * n + 4 * kq; const f32x4 b4 = *(const f32x4*)(pb + ch), s4 = *(const f32x4*)(psc + ch); const f32x4 o = (acc[g][n] + b4) * s4;
                    u32x2 w2; w2.x = pk_bf16(o[0], o[1]); w2.y = pk_bf16(o[2], o[3]); *(u32x2*)(mixed + (R0 + row) * D + 768 + ch) = w2; } }
        __syncthreads();
    }
    {
        OPAQUE(tid); lane = tid & 63;
        const float* lg = a.in[8] + l * 384; const float* lb = a.in[9] + l * 384; const float* sb = a.in[11] + l * 4 * 128;
        const bf16* Wm = (const bf16*)(a.ws + WS_SGUW) + (size_t)l * 4 * 128 * 128;
        for (int it = tid; it < 128 * 48; it += NTHREADS) { const int j = it / 48, v = it - j * 48; *(LAS u32x4*)(lds + j * 784 + v * 16) = *(const u32x4*)(z + (R0 + j) * DIN + 1152 + 8 * v); }
        __syncthreads();
        OPAQUE(tid);
        { const int j = tid & 127, qd = __builtin_amdgcn_readfirstlane(tid >> 7); float vv[96]; float s1 = 0.f, s2 = 0.f;
#pragma unroll
            for (int k = 0; k < 12; ++k) { const u32x4 x = *(const LAS u32x4*)(lds + j * 784 + qd * 192 + 16 * k);
#pragma unroll
                for (int q = 0; q < 4; ++q) { const float e0 = gelu_tanh(bf_lo(x[q])), e1 = gelu_tanh(bf_hi(x[q])); vv[8 * k + 2 * q] = e0; vv[8 * k + 2 * q + 1] = e1; s1 += e0 + e1; s2 += e0 * e0 + e1 * e1; } }
            LAS float* st = (LAS float*)(lds + 122880);
            st[(j * 4 + qd) * 2] = s1; st[(j * 4 + qd) * 2 + 1] = s2;
            __syncthreads();
            const float S1 = st[j * 8] + st[j * 8 + 2] + st[j * 8 + 4] + st[j * 8 + 6], S2 = st[j * 8 + 1] + st[j * 8 + 3] + st[j * 8 + 5] + st[j * 8 + 7];
            const float mean = S1 * (1.0f / 384.0f), var = S2 * (1.0f / 384.0f) - mean * mean, rstd = __builtin_amdgcn_rsqf(var + EPS);
#pragma unroll
            for (int cidx = 0; cidx < 96; ++cidx) { const float o = (vv[cidx] - mean) * rstd * lg[qd * 96 + cidx] + lb[qd * 96 + cidx];
                *(LAS bf16*)(lds + (qd * 96 + cidx) * 272 + j * 2) = f2bf(o); } }
        __syncthreads();
        OPAQUE(tid); lane = tid & 63;
        { const int hd = wave >> 1, ih = wave & 1, r = lane & 15, kq = lane >> 4; f32x4 acc[6][4];
#pragma unroll
            for (int dt = 0; dt < 6; ++dt)
#pragma unroll
                for (int it = 0; it < 4; ++it) acc[dt][it] = (f32x4){0.f, 0.f, 0.f, 0.f};
            const bf16* Wh = Wm + (size_t)hd * 128 * 128; const int nks = ih ? 4 : 2;
            for (int ks = 0; ks < nks; ++ks) { bf16x8 wf[4];
#pragma unroll
                for (int it = 0; it < 4; ++it) wf[it] = *(const bf16x8*)(Wh + (64 * ih + 16 * it + r) * 128 + 32 * ks + 8 * kq);
#pragma unroll
                for (int dt = 0; dt < 6; ++dt) { const bf16x8 vf = *(const LAS bf16x8*)(lds + (hd * 96 + 16 * dt + r) * 272 + (32 * ks + 8 * kq) * 2);
#pragma unroll
                    for (int it = 0; it < 4; ++it) acc[dt][it] = __builtin_amdgcn_mfma_f32_16x16x32_bf16(vf, wf[it], acc[dt][it], 0, 0, 0); } }
#pragma unroll
            for (int it = 0; it < 4; ++it) { const int i = 64 * ih + 16 * it + r; const float sbv = sb[hd * 128 + i];
#pragma unroll
                for (int dt = 0; dt < 6; ++dt) { const int ch = hd * 96 + 16 * dt + 4 * kq; const u32x2 uu = *(const u32x2*)(z + (R0 + i) * DIN + 768 + ch);
                    const float o0 = gelu_tanh(bf_lo(uu.x)) * (acc[dt][it][0] + sbv), o1 = gelu_tanh(bf_hi(uu.x)) * (acc[dt][it][1] + sbv);
                    const float o2 = gelu_tanh(bf_lo(uu.y)) * (acc[dt][it][2] + sbv), o3 = gelu_tanh(bf_hi(uu.y)) * (acc[dt][it][3] + sbv);
                    u32x2 w2; w2.x = pk_bf16(o0, o1); w2.y = pk_bf16(o2, o3); *(u32x2*)(mixed + (R0 + i) * D + 384 + ch) = w2; } } }
        __syncthreads();
    }
}

__device__ __forceinline__ void attn_unit(const Args& a, LAS unsigned char* lds, int l, int u, int tid, int lane, int wave) {
    const bf16* Q = (const bf16*)(a.ws + WS_Q); bf16* O = (bf16*)(a.ws + WS_O);
    const bf16* KB = (const bf16*)(a.ws + WS_KB); const bf16* VT = (const bf16*)(a.ws + WS_VT);
    const int qt = u & 15, bh = u >> 4, b = bh >> 2, h = bh & 3;
    { const bf16* kp = KB + (size_t)(b * 256) * 2048 + l * 1024 + h * 256;
        for (int it = tid; it < 256 * 32; it += NTHREADS) { const int row = it >> 5, v = it & 31; *(LAS u32x4*)(lds + row * 528 + v * 16) = *(const u32x4*)(kp + (size_t)row * 2048 + 8 * v); } }
    __syncthreads();
    const int r = lane & 31, h2 = lane >> 5; const size_t qrow = (size_t)b * SEQ + qt * 256 + wave * 32 + r;
    f32x16 sacc[8];
#pragma unroll
    for (int kt = 0; kt < 8; ++kt)
#pragma unroll
        for (int j = 0; j < 16; ++j) sacc[kt][j] = 0.f;
    const bf16* qp = Q + qrow * D + h * 256 + 8 * h2;
#pragma unroll 4
    for (int s = 0; s < 16; ++s) { const bf16x8 qf = *(const bf16x8*)(qp + 16 * s);
#pragma unroll
        for (int kt = 0; kt < 8; ++kt) { const bf16x8 kf = *(const LAS bf16x8*)(lds + (32 * kt + r) * 528 + (16 * s + 8 * h2) * 2);
            sacc[kt] = __builtin_amdgcn_mfma_f32_32x32x16_bf16(kf, qf, sacc[kt], 0, 0, 0); } }
    float mx = -3.0e38f;
#pragma unroll
    for (int kt = 0; kt < 8; ++kt)
#pragma unroll
        for (int j = 0; j < 16; ++j) mx = fmaxf(mx, sacc[kt][j]);
    mx = fmaxf(mx, __shfl_xor(mx, 32));
    float sum = 0.f; bf16x8 pf[8][2];
#pragma unroll
    for (int kt = 0; kt < 8; ++kt) {
        float p[16];
#pragma unroll
        for (int j = 0; j < 16; ++j) { p[j] = __builtin_amdgcn_exp2f(sacc[kt][j] - mx); sum += p[j]; }
#pragma unroll
        for (int s2 = 0; s2 < 2; ++s2) { u32x4 w; w.x = pk_bf16(p[8 * s2], p[8 * s2 + 1]); w.y = pk_bf16(p[8 * s2 + 2], p[8 * s2 + 3]); w.z = pk_bf16(p[8 * s2 + 4], p[8 * s2 + 5]); w.w = pk_bf16(p[8 * s2 + 6], p[8 * s2 + 7]);
            pf[kt][s2] = __builtin_bit_cast(bf16x8, w); } }
    sum += __shfl_xor(sum, 32);
    const float inv = 1.0f / sum;
    __syncthreads();
    { const bf16* vp = VT + (size_t)(l * 1024 + h * 256) * 2048 + b * 256;
        for (int it = tid; it < 256 * 32; it += NTHREADS) { const int row = it >> 5, v = it & 31; const u32x4 x = *(const u32x4*)(vp + (size_t)row * 2048 + 8 * v);
            const int grp = v >> 1, odd = v & 1; LAS unsigned char* dst = lds + row * 528 + grp * 32 + odd * 8;
            *(LAS u32x2*)(dst) = (u32x2){x.x, x.y}; *(LAS u32x2*)(dst + 16) = (u32x2){x.z, x.w}; } }
    __syncthreads();
#pragma unroll
    for (int dh = 0; dh < 2; ++dh) {
        f32x16 oacc[4];
#pragma unroll
        for (int dt = 0; dt < 4; ++dt)
#pragma unroll
            for (int j = 0; j < 16; ++j) oacc[dt][j] = 0.f;
#pragma unroll
        for (int kt = 0; kt < 8; ++kt)
#pragma unroll
            for (int s2 = 0; s2 < 2; ++s2)
#pragma unroll
                for (int dt = 0; dt < 4; ++dt) { const bf16x8 vf = *(const LAS bf16x8*)(lds + (dh * 128 + 32 * dt + r) * 528 + (kt * 2 + s2) * 32 + 16 * h2);
                    oacc[dt] = __builtin_amdgcn_mfma_f32_32x32x16_bf16(vf, pf[kt][s2], oacc[dt], 0, 0, 0); }
        bf16* op = O + qrow * D + h * 256 + dh * 128 + 4 * h2;
#pragma unroll
        for (int dt = 0; dt < 4; ++dt)
#pragma unroll
            for (int g4 = 0; g4 < 4; ++g4) { u32x2 w; w.x = pk_bf16(oacc[dt][4 * g4] * inv, oacc[dt][4 * g4 + 1] * inv); w.y = pk_bf16(oacc[dt][4 * g4 + 2] * inv, oacc[dt][4 * g4 + 3] * inv);
                *(u32x2*)(op + 32 * dt + 8 * g4) = w; }
    }
    __syncthreads();
}

__device__ __forceinline__ void phase_router(const Args& a, LAS unsigned char* lds, int vcu, int G, int tid, int lane, int wave) {
    unsigned char* ws = a.ws;
    LAS float* grw = (LAS float*)lds;
    LAS int* hist = (LAS int*)(lds + 32768);
    const float* gn = a.in[22] + D; const float* rw = a.in[26];
    for (int i = tid; i < D * NE; i += NTHREADS) grw[i] = gn[i >> 3] * rw[i];
    if (tid < 16) hist[tid] = 0;
    __syncthreads();
    const u64* rowss = (const u64*)(ws + OFF_ROWSS) + 5 * T;
    int* sel = (int*)(ws + WS_ROUTE); float* gate = (float*)(ws + WS_ROUTE + 2 * T * 4);
    const int gw = vcu * NWAVES + wave, NGW = G * NWAVES;
    for (int m = gw; m < T; m += NGW) {
        const f32x4* xr = (const f32x4*)(a.out + (size_t)m * D) + lane;
        float p[8];
#pragma unroll
        for (int e = 0; e < 8; ++e) p[e] = 0.f;
#pragma unroll
        for (int j = 0; j < 4; ++j) { const f32x4 x = xr[64 * j]; const int k0 = 4 * (lane + 64 * j);
#pragma unroll
            for (int q = 0; q < 4; ++q) { const f32x4 w0 = *(const LAS f32x4*)(grw + (k0 + q) * 8), w1 = *(const LAS f32x4*)(grw + (k0 + q) * 8 + 4);
                p[0] += x[q] * w0[0]; p[1] += x[q] * w0[1]; p[2] += x[q] * w0[2]; p[3] += x[q] * w0[3]; p[4] += x[q] * w1[0]; p[5] += x[q] * w1[1]; p[6] += x[q] * w1[2]; p[7] += x[q] * w1[3]; } }
        const float rstd = rstd_ss(rowss[m]);
#pragma unroll
        for (int e = 0; e < 8; ++e) p[e] = wave_sum(p[e]) * rstd;
        int i0 = 0; float v0 = p[0];
#pragma unroll
        for (int e = 1; e < 8; ++e) if (p[e] > v0) { v0 = p[e]; i0 = e; }
        int i1 = -1; float v1 = -3.0e38f;
#pragma unroll
        for (int e = 0; e < 8; ++e) if (e != i0 && p[e] > v1) { v1 = p[e]; i1 = e; }
        const float g0 = 1.0f / (1.0f + __expf(v1 - v0)), g1 = 1.0f - g0;
        if (lane == 0) { sel[m] = i0; sel[T + m] = i1; gate[m] = g0; gate[T + m] = g1; __hip_atomic_fetch_add(&hist[i0], 1, __ATOMIC_RELAXED, __HIP_MEMORY_SCOPE_WORKGROUP); __hip_atomic_fetch_add(&hist[8 + i1], 1, __ATOMIC_RELAXED, __HIP_MEMORY_SCOPE_WORKGROUP); }
    }
    __syncthreads();
    { int t3 = tid; OPAQUE(t3); if (t3 < 16) atomicAdd((int*)(ws + OFF_MOECNT) + t3, hist[t3]); }
}
__device__ __forceinline__ void phase_lists(const Args& a, LAS unsigned char* lds, int vcu, int G, int tid) {
    unsigned char* ws = a.ws;
    const int* cnt = (const int*)(ws + OFF_MOECNT); int* cursor = (int*)(ws + OFF_MOECNT + 256);
    const u64* rowss = (const u64*)(ws + OFF_ROWSS) + 5 * T;
    const int* sel = (const int*)(ws + WS_ROUTE); const float* gate = (const float*)(ws + WS_ROUTE + 2 * T * 4);
    int* perm = (int*)(ws + WS_ROUTE + 4 * T * 4); float* rsp = (float*)(ws + WS_ROUTE + 4 * T * 4 + 2 * PERMROWS * 4); float* gp = (float*)(ws + WS_ROUTE + 4 * T * 4 + 4 * PERMROWS * 4);
    LAS int* lc = (LAS int*)lds;
    LAS int* lb = (LAS int*)(lds + 64);
    for (int chunk = vcu; chunk < T / 128; chunk += G)
        for (int s = 0; s < 2; ++s) {
            __syncthreads();
            if (tid < 8) lc[tid] = 0;
            __syncthreads();
            int e = 0, rnk = 0; const int tok = chunk * 128 + tid;
            if (tid < 128) { e = sel[s * T + tok]; rnk = __hip_atomic_fetch_add(&lc[e], 1, __ATOMIC_RELAXED, __HIP_MEMORY_SCOPE_WORKGROUP); }
            __syncthreads();
            if (tid < 8) lb[tid] = atomicAdd(cursor + s * 8 + tid, lc[tid]);
            __syncthreads();
            if (tid < 128) { int off = 0;
#pragma unroll
                for (int j = 0; j < 8; ++j) { const int tl = (cnt[s * 8 + j] + 255) >> 8; if (j < e) off += tl * 256; }
                const int pos = off + lb[e] + rnk;
                perm[s * PERMROWS + pos] = tok; rsp[s * PERMROWS + pos] = rstd_ss(rowss[tok]); gp[s * PERMROWS + pos] = gate[s * T + tok]; }
        }
    if (vcu < 16) { const int s = vcu >> 3, e = vcu & 7; int off = 0, ce = 0;
#pragma unroll
        for (int j = 0; j < 8; ++j) { const int cj = cnt[s * 8 + j]; const int tl = (cj + 255) >> 8; if (j < e) off += tl * 256; if (j == e) ce = cj; }
        const int end = off + ((ce + 255) >> 8) * 256;
        for (int pos = off + ce + tid; pos < end; pos += NTHREADS) { perm[s * PERMROWS + pos] = -1; rsp[s * PERMROWS + pos] = 0.f; gp[s * PERMROWS + pos] = 0.f; } }
}

__device__ __forceinline__ void phase_final(const Args& a, int vcu, int G, int lane, int wave) {
    const u64* rowss = (const u64*)(a.ws + OFF_ROWSS) + 6 * T; const float* g = a.in[30];
    const int gw = vcu * NWAVES + wave, NGW = G * NWAVES;
    f32x4 gv[4];
#pragma unroll
    for (int j = 0; j < 4; ++j) gv[j] = ((const f32x4*)g)[lane + 64 * j];
    for (int m = gw; m < T; m += NGW) { f32x4* xr = (f32x4*)(a.out + (size_t)m * D) + lane; const float rstd = rstd_ss(rowss[m]);
#pragma unroll
        for (int j = 0; j < 4; ++j) xr[64 * j] = xr[64 * j] * rstd * gv[j]; }
}

__global__ void __launch_bounds__(NTHREADS, 2) fwd_kernel(Args args) {
    extern __shared__ __attribute__((aligned(16))) unsigned char lds_raw[];
    LAS unsigned char* lds = (LAS unsigned char*)lds_raw;
    const int tid = threadIdx.x, lane = tid & 63, wave = __builtin_amdgcn_readfirstlane(tid >> 6);
    const int G = gridDim.x; const int bx = blockIdx.x; const int vcu = (G % 8 == 0) ? (bx % 8) * (G / 8) + bx / 8 : bx;
    unsigned char* ws = args.ws;
    volatile LAS unsigned* MISC = (volatile LAS unsigned*)(lds + MISC_OFF);
    if (tid < 64) MISC[tid] = 0u;
    __syncthreads();
    const int lo = args.ph_lo, hi = args.ph_hi;
    XcdBarrier bar; bar.bar = (unsigned*)ws + CW_BAR; bar.x = 0; bar.st = nullptr;
    if (hi - lo > 1) bar = xcd_barrier_post((unsigned*)ws + CW_BAR, MISC + 8);
#define IN(k) (lo <= (k) && (k) < hi)
#define SEAM(k) do { if (lo <= (k) && (k) + 1 < hi) xcd_barrier(bar); } while (0)
    u64* rowss = (u64*)(ws + OFF_ROWSS);
    bf16* XB = (bf16*)(ws + WS_XB);
    constexpr float QSCALE = 0.0625f * 1.4426950408889634f;

    if (EN_PRO && IN(0)) { int t2 = tid; OPAQUE(t2); phase_prologue(args, lds, vcu, G, t2, t2 & 63, wave); }
    SEAM(0);
#pragma unroll 1
    for (int l = 0; l < 2; ++l) {
        const int pb = 1 + 8 * l;
        if (EN_GEMM && EN_G1 && IN(pb)) {
            if (EN_KV && l == 0 && bx >= 128) {
                if (bx < 192) { pg8::Gemm g{(const bf16*)(ws + WS_MEMB), (const bf16*)(ws + WS_WK), nullptr, MROWS, 2048, D}; pg8::StaticOrder S; S.init(MROWS, 2048, 64, bx - 128);
                    pg8::EpiRowScale<false> E{(bf16*)(ws + WS_KB), 2048, (const void*)(ws + OFF_MEMSS), 1.0f};
                    pg8::gemm_phase<pg8::EpiRowScale<false>, pg8::StaticOrder, true, false>(lds, g, S, E); }
                else { pg8::Gemm g{(const bf16*)(ws + WS_WV), (const bf16*)(ws + WS_MEMB), nullptr, 2048, MROWS, D}; pg8::StaticOrder S; S.init(2048, MROWS, 64, bx - 192);
                    pg8::EpiColScale E{(bf16*)(ws + WS_VT), 2048, (const u64*)(ws + OFF_MEMSS)};
                    pg8::gemm_phase<pg8::EpiColScale, pg8::StaticOrder, true, false>(lds, g, S, E); }
            }
            pg8::Gemm g{XB, (const bf16*)(ws + WS_WIN) + (size_t)l * DIN * D, nullptr, T, DIN, D}; pg8::StaticOrder S; S.init(T, DIN, G, bx);
            pg8::EpiRowScale<false> E{(bf16*)(ws + WS_Z), DIN, rowss + (size_t)(3 * l) * T, 1.0f};
            pg8::gemm_phase<pg8::EpiRowScale<false>, pg8::StaticOrder, true, false>(lds, g, S, E);
        }
        SEAM(pb);
        if (EN_MIX && IN(pb + 1)) { int t2 = tid; asm volatile("" : "+v"(t2)); for (int u = vcu; u < 256; u += G) mixer_unit(args, lds, l, u, t2, t2 & 63, wave); }
        SEAM(pb + 1);
        if (EN_GEMM && EN_G2 && IN(pb + 2)) {
            pg8::Gemm g{(const bf16*)(ws + WS_MIXED), (const bf16*)(ws + WS_WOUT) + (size_t)l * D * D, nullptr, T, D, D}; pg8::StaticOrder S; S.init(T, D, G, bx);
            pg8::EpiResid<false, true, true> E{args.out, XB, rowss + (size_t)(3 * l + 1) * T, nullptr, nullptr};
            pg8::gemm_phase<pg8::EpiResid<false, true, true>, pg8::StaticOrder, true, false>(lds, g, S, E);
        }
        SEAM(pb + 2);
        if (EN_GEMM && EN_G3 && IN(pb + 3)) {
            pg8::Gemm g{XB, (const bf16*)(ws + WS_WQ) + (size_t)l * D * D, nullptr, T, D, D}; pg8::StaticOrder S; S.init(T, D, G, bx);
            pg8::EpiRowScale<false> E{(bf16*)(ws + WS_Q), D, rowss + (size_t)(3 * l + 1) * T, QSCALE};
            pg8::gemm_phase<pg8::EpiRowScale<false>, pg8::StaticOrder, true, false>(lds, g, S, E);
        }
        SEAM(pb + 3);
        if (EN_ATT && IN(pb + 4)) { int t2 = tid; asm volatile("" : "+v"(t2)); for (int u = vcu; u < 512; u += G) attn_unit(args, lds, l, u, t2, t2 & 63, wave); }
        SEAM(pb + 4);
        if (EN_GEMM && EN_G2 && IN(pb + 5)) {
            pg8::Gemm g{(const bf16*)(ws + WS_O), (const bf16*)(ws + WS_WO) + (size_t)l * D * D, nullptr, T, D, D}; pg8::StaticOrder S; S.init(T, D, G, bx);
            pg8::EpiResid<false, true, true> E{args.out, XB, rowss + (size_t)(3 * l + 2) * T, nullptr, nullptr};
            pg8::gemm_phase<pg8::EpiResid<false, true, true>, pg8::StaticOrder, true, false>(lds, g, S, E);
        }
        SEAM(pb + 5);
        if (l == 0) {
            if (EN_GEMM && EN_G4 && IN(7)) {
                pg8::Gemm g{XB, (const bf16*)(ws + WS_WGU), nullptr, T, 2 * DFF, D}; pg8::StaticOrder S; S.init(T, 2 * DFF, G, bx);
                pg8::EpiSwiglu<false> E{(bf16*)(ws + WS_H), DFF, rowss + (size_t)2 * T};
                pg8::gemm_phase<pg8::EpiSwiglu<false>, pg8::StaticOrder, true, false>(lds, g, S, E);
            }
            SEAM(7);
            if (EN_GEMM && EN_G2 && IN(8)) {
                pg8::Gemm g{(const bf16*)(ws + WS_H), (const bf16*)(ws + WS_WD), nullptr, T, D, DFF}; pg8::StaticOrder S; S.init(T, D, G, bx);
                pg8::EpiResid<false, true, true> E{args.out, XB, rowss + (size_t)3 * T, nullptr, nullptr};
                pg8::gemm_phase<pg8::EpiResid<false, true, true>, pg8::StaticOrder, true, false>(lds, g, S, E);
            }
            SEAM(8);
        } else {
            if (EN_ROUTE && IN(15)) { int t2 = tid; OPAQUE(t2); phase_router(args, lds, vcu, G, t2, t2 & 63, wave); }
            SEAM(15);
            if (EN_ROUTE && IN(16)) { int t2 = tid; OPAQUE(t2); phase_lists(args, lds, vcu, G, t2); }
            SEAM(16);
            const int* perm = (const int*)(ws + WS_ROUTE + 4 * T * 4); const float* rsp = (const float*)(ws + WS_ROUTE + 4 * T * 4 + 2 * PERMROWS * 4); const float* gp = (const float*)(ws + WS_ROUTE + 4 * T * 4 + 4 * PERMROWS * 4);
#pragma unroll 1
            for (int s = 0; s < 2; ++s) {
                pg8::MoeOrder S; S.G = G; S.c = bx; S.tp[0] = 0;
                if (IN(17 + 2 * s) || IN(18 + 2 * s)) {
                    const int* cnt = (const int*)(ws + OFF_MOECNT) + s * 8;
#pragma unroll
                    for (int j = 0; j < 8; ++j) S.tp[j + 1] = S.tp[j] + ((__builtin_amdgcn_readfirstlane(cnt[j]) + 255) >> 8);
                } else {
#pragma unroll
                    for (int j = 0; j < 8; ++j) S.tp[j + 1] = 0;
                }
                if (EN_MOE && IN(17 + 2 * s)) {
                    S.nN = 2 * DFF / 256;
                    pg8::Gemm g{XB, (const bf16*)(ws + WS_MWGU), perm + s * PERMROWS, T, 2 * DFF, D};
                    pg8::EpiSwiglu<true> E{(bf16*)(ws + WS_H), DFF, rsp + s * PERMROWS};
                    pg8::gemm_phase<pg8::EpiSwiglu<true>, pg8::MoeOrder, true, true>(lds, g, S, E);
                }
                SEAM(17 + 2 * s);
                if (EN_MOE && IN(18 + 2 * s)) {
                    S.nN = D / 256;
                    pg8::Gemm g{(const bf16*)(ws + WS_H), (const bf16*)(ws + WS_MWD), nullptr, T, D, DFF};
                    pg8::EpiResid<true, false, true> E{args.out, nullptr, rowss + (size_t)6 * T, perm + s * PERMROWS, gp + s * PERMROWS};
                    if (s == 0) { pg8::EpiResid<true, false, false> E0{args.out, nullptr, nullptr, perm, gp};
                        pg8::gemm_phase<pg8::EpiResid<true, false, false>, pg8::MoeOrder, true, false>(lds, g, S, E0); }
                    else pg8::gemm_phase<pg8::EpiResid<true, false, true>, pg8::MoeOrder, true, false>(lds, g, S, E);
                }
                SEAM(18 + 2 * s);
            }
            if (IN(21)) { int t2 = tid; OPAQUE(t2); phase_final(args, vcu, G, t2 & 63, wave); }
        }
    }
#undef IN
#undef SEAM
}

extern "C" void kernel_launch(void* const* d_in, const int* in_sizes, int n_in, void* d_out, int out_size, void* d_ws, size_t ws_size, hipStream_t stream) {
    static int grid = 0;
    if (grid == 0) {
        if (n_in != 31 || in_sizes[0] != T * D || out_size != T * D || ws_size < WS_END) { fprintf(stderr, "kernel_launch: unexpected shapes (n_in %d, in0 %d, out %d, ws %zu)\n", n_in, n_in > 0 ? in_sizes[0] : -1, out_size, ws_size); grid = -1; return; }
        int dev = 0, cus = 0;
        if (hipGetDevice(&dev) != hipSuccess || hipDeviceGetAttribute(&cus, hipDeviceAttributeMultiprocessorCount, dev) != hipSuccess) { grid = -1; return; }
        if (hipFuncSetAttribute((const void*)fwd_kernel, hipFuncAttributeMaxDynamicSharedMemorySize, LDS_BYTES) != hipSuccess) { fprintf(stderr, "kernel_launch: hipFuncSetAttribute failed\n"); grid = -1; return; }
        int per_cu = 0;
        if (hipOccupancyMaxActiveBlocksPerMultiprocessor(&per_cu, (const void*)fwd_kernel, NTHREADS, LDS_BYTES) != hipSuccess || per_cu < 1) fprintf(stderr, "kernel_launch: occupancy query reports %d\n", per_cu);
        (void)hipGetLastError();
        grid = cus;
    }
    if (grid < 0) return;
    (void)hipMemsetAsync(d_ws, 0, CTL_ZERO_BYTES, stream);
    Args a{};
    for (int i = 0; i < 31; ++i) a.in[i] = (const float*)d_in[i];
    a.out = (float*)d_out; a.ws = (unsigned char*)d_ws;
#if MK_PER_PHASE
    for (int ph = 0; ph < NPH; ++ph) { a.ph_lo = ph; a.ph_hi = ph + 1; hipLaunchKernelGGL(fwd_kernel, dim3(grid), dim3(NTHREADS), LDS_BYTES, stream, a); }
#else
    a.ph_lo = 0; a.ph_hi = NPH; hipLaunchKernelGGL(fwd_kernel, dim3(grid), dim3(NTHREADS), LDS_BYTES, stream, a);
#endif
}
```

```cpp
#include <hip/hip_runtime.h>
#include <cstdio>
#include <cstdint>

#ifndef MK_PER_PHASE
#define MK_PER_PHASE 0
#endif

#ifndef EN_PRO
#define EN_PRO 1
#endif
#ifndef EN_GEMM
#define EN_GEMM 1
#endif
#ifndef EN_G1
#define EN_G1 1
#endif
#ifndef EN_G2
#define EN_G2 1
#endif
#ifndef EN_G3
#define EN_G3 1
#endif
#ifndef EN_G4
#define EN_G4 1
#endif
#ifndef EN_KV
#define EN_KV 1
#endif
#ifndef EN_MIX
#define EN_MIX 1
#endif
#ifndef EN_ATT
#define EN_ATT 1
#endif
#ifndef EN_MOE
#define EN_MOE 1
#endif
#ifndef EN_ROUTE
#define EN_ROUTE 1
#endif
#define LAS __attribute__((address_space(3)))
#define GAS __attribute__((address_space(1)))
typedef unsigned short bf16;
typedef short bf16x8 __attribute__((ext_vector_type(8)));
typedef float f32x2 __attribute__((ext_vector_type(2)));
typedef float f32x4 __attribute__((ext_vector_type(4)));
typedef float f32x16 __attribute__((ext_vector_type(16)));
typedef unsigned u32x2 __attribute__((ext_vector_type(2)));
typedef unsigned u32x4 __attribute__((ext_vector_type(4)));
typedef __bf16 bf16x2_t __attribute__((ext_vector_type(2)));
typedef unsigned long long u64;
typedef unsigned long long u64x2 __attribute__((ext_vector_type(2)));

constexpr int NB = 8, SEQ = 4096, D = 1024, T = NB * SEQ, DIN = 1792, DFF = 2816, NE = 8, MEMLEN = 256, MROWS = NB * MEMLEN;
constexpr float EPS = 1e-6f;
constexpr int NWAVES = 8, NTHREADS = 512;
constexpr int NPH = 22;

constexpr size_t MiB = 1u << 20;
constexpr size_t CTL_ZERO_BYTES = 2 * MiB;
constexpr int CW_BAR = 4096;
constexpr size_t OFF_ROWSS = 64 * 1024;
constexpr size_t OFF_MOECNT = 32 * 1024;
constexpr size_t OFF_MEMSS = 40 * 1024;
constexpr size_t WS_WIN = 2 * MiB;
constexpr size_t WS_WOUT = 9 * MiB;
constexpr size_t WS_WQ = 13 * MiB;
constexpr size_t WS_WO = 17 * MiB;
constexpr size_t WS_WK = 21 * MiB;
constexpr size_t WS_WV = 25 * MiB;
constexpr size_t WS_WGU = 29 * MiB;
constexpr size_t WS_WD = 40 * MiB;
constexpr size_t WS_MWGU = 46 * MiB;
constexpr size_t WS_MWD = 134 * MiB;
constexpr size_t WS_SGUW = 178 * MiB;
constexpr size_t WS_POOLW = 178 * MiB + 512 * 1024;
constexpr size_t WS_XB = 180 * MiB;
constexpr size_t WS_MEMB = 244 * MiB;
constexpr size_t WS_KB = 248 * MiB;
constexpr size_t WS_VT = 256 * MiB;
constexpr size_t WS_ROUTE = 264 * MiB;
constexpr int PERMROWS = 136 * 256;
constexpr size_t WS_ACT = 266 * MiB;
constexpr size_t WS_Z = WS_ACT;
constexpr size_t WS_MIXED = WS_ACT + 112 * MiB;
constexpr size_t WS_Q = WS_ACT;
constexpr size_t WS_O = WS_ACT + 64 * MiB;
constexpr size_t WS_H = WS_ACT;
constexpr size_t WS_END = 512 * MiB;
static_assert(WS_H + (size_t)PERMROWS * DFF * 2 <= WS_END, "ws map");

constexpr int LDS_BYTES = 160 * 1024;
constexpr int MISC_OFF = LDS_BYTES - 256;

__device__ __forceinline__ float bf_lo(unsigned v) { return __uint_as_float(v << 16); }
__device__ __forceinline__ float bf_hi(unsigned v) { return __uint_as_float(v & 0xffff0000u); }
__device__ __forceinline__ unsigned pk_bf16(float lo, float hi) { f32x2 v = {lo, hi}; bf16x2_t b = __builtin_convertvector(v, bf16x2_t); return __builtin_bit_cast(unsigned, b); }
__device__ __forceinline__ bf16 f2bf(float f) { return (bf16)(pk_bf16(f, 0.f) & 0xffffu); }
__device__ __forceinline__ float sigm(float x) { return __builtin_amdgcn_rcpf(1.0f + __expf(-x)); }
__device__ __forceinline__ float silu_f(float x) { return x * sigm(x); }
__device__ __forceinline__ float gelu_tanh(float x) { const float y = 0.7978845608028654f * (x + 0.044715f * x * x * x); return x * sigm(2.0f * y); }
constexpr float SS_FIX = 16777216.0f;
__device__ __forceinline__ u64 ss_to_fix(float ss) { return (u64)(ss * SS_FIX); }
__device__ __forceinline__ float rstd_ss(u64 ssf) { return __builtin_amdgcn_rsqf((float)ssf * (1.0f / (1024.0f * SS_FIX)) + EPS); }
#define OPAQUE(x) asm volatile("" : "+v"(x))
template <int CTRL> __device__ __forceinline__ float dpp_f(float v) { return __builtin_bit_cast(float, __builtin_amdgcn_update_dpp(0, __builtin_bit_cast(int, v), CTRL, 0xf, 0xf, true)); }
__device__ __forceinline__ float row16_sum(float v) { v += dpp_f<0xB1>(v); v += dpp_f<0x4E>(v); v += dpp_f<0x141>(v); v += dpp_f<0x140>(v); return v; }
__device__ __forceinline__ float wave_sum(float v) { v = row16_sum(v); v += __shfl_xor(v, 16); v += __shfl_xor(v, 32); return v; }

namespace pg8 {
constexpr int BM = 256, BK = 64, HALF = 128, HTB = HALF * BK * 2, STAGE_BYTES = 8 * HTB, NXCD = 8, WGM = 8;
__host__ __device__ __forceinline__ int lds_byte(int r, int c) { const int st = (r >> 4) * 2 + (c >> 5), rr = r & 15, cc = c & 31, ob = rr * 64 + cc * 2; return st * 1024 + (ob ^ (((ob >> 9) & 1) << 5)); }
__host__ __device__ __forceinline__ void stage_rc(int b, int& R, int& C) { const int st = b / 1024, sb = b % 1024, swz = sb ^ (((sb >> 9) & 1) << 5); R = (st >> 1) * 16 + swz / 64; C = (st & 1) * 32 + (swz % 64) / 2; }
__host__ __device__ __forceinline__ int perm32(int rho) { const int n = rho >> 4, i = rho & 15; return 8 * (i >> 2) + 4 * n + (i & 3); }

struct Unit { int pm, pn, brow; };
struct Gemm { const bf16* A; const bf16* Bt; const int* perm; int M, N, K; };

struct StaticOrder {
    int nM, nN, nwg, G, c;
    __device__ void init(int M, int N, int G_, int c_) { nM = M / BM; nN = N / BM; nwg = nM * nN; G = G_; c = c_; }
    __device__ bool next(int i, Unit& u) const {
        const long L = (long)i * G + c; if (L >= nwg) return false;
        int wgid = (int)L; { const int q = nwg / NXCD, r = nwg % NXCD, xcd = wgid % NXCD, off = wgid / NXCD; wgid = (xcd < r ? xcd * (q + 1) : r * (q + 1) + (xcd - r) * q) + off; }
        const int nig = WGM * nN, gid = wgid / nig, fm = gid * WGM, gsz = (nM - fm) < WGM ? (nM - fm) : WGM;
        u.pm = fm + ((wgid % nig) % gsz); u.pn = (wgid % nig) / gsz; u.brow = u.pn; return true;
    }
};
struct MoeOrder {
    int nN, G, c; int tp[9];
    __device__ bool next(int i, Unit& u) const {
        const int L = i * G + c; if (L >= tp[8] * nN) return false;
        int e = 0;
#pragma unroll
        for (int j = 1; j < 8; ++j) e += (L >= tp[j] * nN) ? 1 : 0;
        int base = 0, nx = 0;
#pragma unroll
        for (int j = 0; j < 8; ++j) if (e == j) { base = tp[j]; nx = tp[j + 1]; }
        const int te = nx - base, Lp = L - base * nN; u.pn = Lp / te; u.pm = base + Lp % te; u.brow = e * nN + u.pn; return true;
    }
};

typedef f32x4 Acc[2][2][4][2];

template <bool DIRECT> struct EpiRowScale {
    static constexpr bool PERM = true;
    bf16* O; int ldc; const void* rs; float cst;
    __device__ __forceinline__ void operator()(const Acc& acc, const Unit& u, int wr, int wc, int fr, int fq) const {
        const int row0 = u.pm * BM + wr * 64 + fr, col0 = u.pn * BM + wc * 32 + 8 * fq;
#pragma unroll
        for (int ai = 0; ai < 2; ++ai)
#pragma unroll
            for (int m = 0; m < 4; ++m) { const int row = row0 + ai * HALF + m * 16; const float sc = (DIRECT ? ((const float*)rs)[row] : rstd_ss(((const u64*)rs)[row])) * cst;
                bf16* rowp = O + (size_t)row * ldc + col0;
#pragma unroll
                for (int bj = 0; bj < 2; ++bj) { const f32x4 v0 = acc[ai][bj][m][0] * sc, v1 = acc[ai][bj][m][1] * sc;
                    u32x4 w; w.x = pk_bf16(v0[0], v0[1]); w.y = pk_bf16(v0[2], v0[3]); w.z = pk_bf16(v1[0], v1[1]); w.w = pk_bf16(v1[2], v1[3]);
                    *(u32x4*)(rowp + bj * HALF) = w; } }
    }
};
struct EpiColScale {
    static constexpr bool PERM = true;
    bf16* O; int ldc; const u64* css;
    __device__ __forceinline__ void operator()(const Acc& acc, const Unit& u, int wr, int wc, int fr, int fq) const {
        const int row0 = u.pm * BM + wr * 64 + fr, col0 = u.pn * BM + wc * 32 + 8 * fq;
#pragma unroll
        for (int bj = 0; bj < 2; ++bj) {
            const u64* cp = css + col0 + bj * HALF;
            const f32x4 c0 = (f32x4){rstd_ss(cp[0]), rstd_ss(cp[1]), rstd_ss(cp[2]), rstd_ss(cp[3])}, c1 = (f32x4){rstd_ss(cp[4]), rstd_ss(cp[5]), rstd_ss(cp[6]), rstd_ss(cp[7])};
#pragma unroll
            for (int ai = 0; ai < 2; ++ai)
#pragma unroll
                for (int m = 0; m < 4; ++m) { bf16* rowp = O + (size_t)(row0 + ai * HALF + m * 16) * ldc + col0 + bj * HALF;
                    const f32x4 v0 = acc[ai][bj][m][0] * c0, v1 = acc[ai][bj][m][1] * c1;
                    u32x4 w; w.x = pk_bf16(v0[0], v0[1]); w.y = pk_bf16(v0[2], v0[3]); w.z = pk_bf16(v1[0], v1[1]); w.w = pk_bf16(v1[2], v1[3]);
                    *(u32x4*)rowp = w; }
            asm volatile("" ::: "memory"); }
    }
};
template <bool DIRECT> struct EpiSwiglu {
    static constexpr bool PERM = true;
    bf16* O; int ldc; const void* rs;
    __device__ __forceinline__ void operator()(const Acc& acc, const Unit& u, int wr, int wc, int fr, int fq) const {
        const int row0 = u.pm * BM + wr * 64 + fr, col0 = u.pn * HALF + wc * 32 + 8 * fq;
#pragma unroll
        for (int ai = 0; ai < 2; ++ai)
#pragma unroll
            for (int m = 0; m < 4; ++m) { const int row = row0 + ai * HALF + m * 16; const float sc = DIRECT ? ((const float*)rs)[row] : rstd_ss(((const u64*)rs)[row]);
                u32x4 w;
#pragma unroll
                for (int n = 0; n < 2; ++n) { const f32x4 g = acc[ai][0][m][n] * sc, uu = acc[ai][1][m][n] * sc;
                    const float o0 = silu_f(g[0]) * uu[0], o1 = silu_f(g[1]) * uu[1], o2 = silu_f(g[2]) * uu[2], o3 = silu_f(g[3]) * uu[3];
                    w[2 * n] = pk_bf16(o0, o1); w[2 * n + 1] = pk_bf16(o2, o3); }
                *(u32x4*)(O + (size_t)row * ldc + col0) = w;
                asm volatile("" ::: "memory"); }
    }
};
template <bool SCATTER, bool WRITE_XB, bool ACC_SS> struct EpiResid {
    static constexpr bool PERM = true;
    float* X; bf16* XB; u64* ss_out; const int* perm; const float* gp;
    __device__ __forceinline__ void operator()(const Acc& acc, const Unit& u, int wr, int wc, int fr, int fq) const {
        const int row0 = u.pm * BM + wr * 64 + fr, col0 = u.pn * BM + wc * 32 + 8 * fq;
#pragma unroll
        for (int ai = 0; ai < 2; ++ai)
#pragma unroll
            for (int m = 0; m < 4; ++m) { int row = row0 + ai * HALF + m * 16; float gate = 1.0f; bool valid = true;
                if (SCATTER) { const int tok = perm[row]; gate = gp[row]; valid = tok >= 0; row = valid ? tok : 0; }
                float ss = 0.f;
                if (valid) {
#pragma unroll
                    for (int bj = 0; bj < 2; ++bj) { float* xp = X + (size_t)row * D + col0 + bj * HALF;
                        f32x4 n0 = *(const f32x4*)xp, n1 = *(const f32x4*)(xp + 4);
                        n0 += acc[ai][bj][m][0] * gate; n1 += acc[ai][bj][m][1] * gate;
                        *(f32x4*)xp = n0; *(f32x4*)(xp + 4) = n1;
                        if (WRITE_XB) { u32x4 w; w.x = pk_bf16(n0[0], n0[1]); w.y = pk_bf16(n0[2], n0[3]); w.z = pk_bf16(n1[0], n1[1]); w.w = pk_bf16(n1[2], n1[3]);
                            *(u32x4*)(XB + (size_t)row * D + col0 + bj * HALF) = w; }
                        if (ACC_SS) ss += (n0[0] * n0[0] + n0[1] * n0[1]) + (n0[2] * n0[2] + n0[3] * n0[3]) + (n1[0] * n1[0] + n1[1] * n1[1]) + (n1[2] * n1[2] + n1[3] * n1[3]);
                        asm volatile("" ::: "memory"); }
                }
                if (ACC_SS) { ss += __shfl_xor(ss, 16); ss += __shfl_xor(ss, 32);
                    if (fq == 0 && valid) (void)__hip_atomic_fetch_add(ss_out + row, ss_to_fix(ss), __ATOMIC_RELAXED, __HIP_MEMORY_SCOPE_AGENT); }
                asm volatile("" ::: "memory"); }
    }
};

__device__ __forceinline__ void load_offs(const Gemm& g, const Unit& u, const int (&Rr)[2], const int (&Cc)[2], unsigned (&o)[2][2]) {
#pragma unroll
    for (int h = 0; h < 2; ++h)
#pragma unroll
        for (int i = 0; i < 2; ++i) { int row = g.perm[u.pm * BM + h * HALF + Rr[i]]; row = row < 0 ? 0 : row; o[h][i] = (unsigned)(row * g.K + Cc[i]) * 2u; }
}

template <class Epi, class Sched, bool ALIGN_EPI, bool GATHER>
__device__ __forceinline__ void gemm_phase(LAS unsigned char* lds, const Gemm g, const Sched& S, const Epi& E) {
    int tid_ = threadIdx.x; asm volatile("" : "+v"(tid_));
    const int tid = tid_, wid = __builtin_amdgcn_readfirstlane(tid >> 6), lane = tid & 63, wr = wid >> 2, wc = wid & 3, fr = lane & 15, fq = lane >> 4;
    const int K = g.K, nt = K / BK;
    int Rr[2], Cc[2]; unsigned voffA[2], voffB[2];
#pragma unroll
    for (int i = 0; i < 2; ++i) { int R, C; stage_rc(tid * 16 + i * 8192, R, C); Rr[i] = R; Cc[i] = C; const int Rb = Epi::PERM ? ((R & ~31) + perm32(R & 31)) : R;
        voffA[i] = (unsigned)(R * K + C) * 2u; voffB[i] = (unsigned)(Rb * K + C) * 2u; }
    const size_t kstep = (size_t)(BK * 2);
    const size_t hstep = (size_t)HALF * K * 2;
    const size_t tstep = 2 * hstep;
    const unsigned ldsw = (unsigned)wid * 1024u;
    const int aoff = lds_byte(wr * 64 + fr, fq * 8), boff = lds_byte(wc * 32 + fr, fq * 8);
#define PG8_SA(b, h) (((b) * 2 + (h)) * HTB)
#define PG8_SB(b, h) ((4 + (b) * 2 + (h)) * HTB)
#define PG8_STAGE(bufoff, gbase, voff) do { _Pragma("unroll") for (int _i = 0; _i < 2; ++_i) \
        __builtin_amdgcn_global_load_lds((const unsigned*)((const char*)(gbase) + (voff)[_i]), (LAS unsigned*)(lds + (bufoff) + ldsw + _i * 8192), 16, 0, 0); } while (0)
#define PG8_STAGE_A(bufoff, gbase, h) do { if constexpr (GATHER) PG8_STAGE(bufoff, gbase, offA[h]); else PG8_STAGE(bufoff, (gbase) + (h) * hstep, voffA); } while (0)
#define PG8_LDA(dst, b, h) do { _Pragma("unroll") for (int m = 0; m < 4; ++m) _Pragma("unroll") for (int k = 0; k < 2; ++k) dst[m][k] = *(const LAS bf16x8*)(lds + PG8_SA(b, h) + aoff + m * 2048 + k * 1024); } while (0)
#define PG8_LDB(dst, b, h) do { _Pragma("unroll") for (int n = 0; n < 2; ++n) _Pragma("unroll") for (int k = 0; k < 2; ++k) dst[n][k] = *(const LAS bf16x8*)(lds + PG8_SB(b, h) + boff + n * 2048 + k * 1024); } while (0)
#define PG8_MMA(ai, bj, At, Bt) do { __builtin_amdgcn_s_setprio(1); _Pragma("unroll") for (int m = 0; m < 4; ++m) _Pragma("unroll") for (int n = 0; n < 2; ++n) _Pragma("unroll") for (int k = 0; k < 2; ++k) \
        acc[ai][bj][m][n] = __builtin_amdgcn_mfma_f32_16x16x32_bf16(Bt[n][k], At[m][k], acc[ai][bj][m][n], 0, 0, 0); __builtin_amdgcn_s_setprio(0); } while (0)
#define PG8_WAIT_V(n) asm volatile("s_waitcnt vmcnt(" #n ")" ::: "memory")
#define PG8_WAIT_L(n) asm volatile("s_waitcnt lgkmcnt(" #n ")" ::: "memory")
#define PG8_BAR __builtin_amdgcn_s_barrier()
#define PG8_SCHED __builtin_amdgcn_sched_barrier(0)
    Unit cur, nxt; int ui = 0;
    if (!S.next(0, cur)) return;
    Acc acc;
#pragma unroll
    for (int a = 0; a < 2; ++a)
#pragma unroll
        for (int b = 0; b < 2; ++b)
#pragma unroll
            for (int m = 0; m < 4; ++m)
#pragma unroll
                for (int n = 0; n < 2; ++n) acc[a][b][m][n] = (f32x4){0.f, 0.f, 0.f, 0.f};
    bf16x8 At[4][2], B0[2][2], B1[2][2];
    unsigned offA[2][2], offN[2][2];
    if constexpr (GATHER) load_offs(g, cur, Rr, Cc, offA);
    const char* cA = GATHER ? (const char*)g.A : (const char*)g.A + (size_t)cur.pm * tstep; const char* cB = (const char*)g.Bt + (size_t)cur.brow * tstep;
    PG8_STAGE(PG8_SB(0, 0), cB, voffB); PG8_STAGE(PG8_SB(0, 1), cB + hstep, voffB); PG8_STAGE_A(PG8_SA(0, 0), cA, 0); PG8_STAGE_A(PG8_SA(0, 1), cA, 1);
    if (wr == 1) PG8_BAR;
    PG8_WAIT_V(2); PG8_BAR;
    PG8_STAGE(PG8_SB(1, 0), cB + kstep, voffB); PG8_STAGE_A(PG8_SA(1, 0), cA + kstep, 0); PG8_STAGE(PG8_SB(1, 1), cB + hstep + kstep, voffB);
    PG8_WAIT_V(6); PG8_BAR;
    for (;;) {
        const bool has_next = S.next(ui + 1, nxt);
        if constexpr (GATHER) { if (has_next) load_offs(g, nxt, Rr, Cc, offN); else {
#pragma unroll
            for (int h = 0; h < 2; ++h)
#pragma unroll
                for (int i = 0; i < 2; ++i) offN[h][i] = offA[h][i]; } }
        const char* nA = has_next ? (GATHER ? (const char*)g.A : (const char*)g.A + (size_t)nxt.pm * tstep) : cA; const char* nB = has_next ? (const char*)g.Bt + (size_t)nxt.brow * tstep : cB;
        for (int t = 0; t < nt; t += 2) {
            const bool last = (t == nt - 2);
            const char* a1 = cA + (size_t)(t + 1) * kstep;
            const char* a2 = last ? nA : cA + (size_t)(t + 2) * kstep; const char* b2 = last ? nB : cB + (size_t)(t + 2) * kstep;
            const char* a3 = a2 + kstep; const char* b3 = b2 + kstep;
            PG8_LDB(B0, 0, 0); PG8_LDB(B1, 0, 1); PG8_SCHED; PG8_LDA(At, 0, 0); PG8_STAGE_A(PG8_SA(1, 1), a1, 1);
            if constexpr (GATHER) { if (last) {
#pragma unroll
                for (int h = 0; h < 2; ++h)
#pragma unroll
                    for (int i = 0; i < 2; ++i) offA[h][i] = offN[h][i]; } }
            PG8_WAIT_V(8); PG8_WAIT_L(0); PG8_BAR; PG8_MMA(0, 0, At, B0); PG8_MMA(0, 1, At, B1); PG8_BAR; PG8_SCHED;
            PG8_LDA(At, 0, 1); PG8_STAGE(PG8_SB(0, 0), b2, voffB); PG8_STAGE(PG8_SB(0, 1), b2 + hstep, voffB); PG8_STAGE_A(PG8_SA(0, 0), a2, 0);
            PG8_WAIT_V(8); PG8_WAIT_L(0); PG8_BAR; PG8_MMA(1, 0, At, B0); PG8_MMA(1, 1, At, B1); PG8_BAR; PG8_SCHED;
            PG8_LDB(B0, 1, 0); PG8_LDB(B1, 1, 1); PG8_SCHED; PG8_LDA(At, 1, 0); PG8_STAGE_A(PG8_SA(0, 1), a2, 1);
            PG8_WAIT_V(8); PG8_WAIT_L(0); PG8_BAR; PG8_MMA(0, 0, At, B0); PG8_MMA(0, 1, At, B1); PG8_BAR; PG8_SCHED;
            PG8_LDA(At, 1, 1); PG8_STAGE(PG8_SB(1, 0), b3, voffB); PG8_STAGE(PG8_SB(1, 1), b3 + hstep, voffB); PG8_STAGE_A(PG8_SA(1, 0), a3, 0);
            PG8_WAIT_V(8); PG8_WAIT_L(0); PG8_BAR; PG8_MMA(1, 0, At, B0); PG8_MMA(1, 1, At, B1); PG8_BAR; PG8_SCHED;
        }
        if constexpr (ALIGN_EPI) { if (wr == 0) PG8_BAR; }
        E(acc, cur, wr, wc, fr, fq);
        if (!has_next) break;
#pragma unroll
        for (int a = 0; a < 2; ++a)
#pragma unroll
            for (int b = 0; b < 2; ++b)
#pragma unroll
                for (int m = 0; m < 4; ++m)
#pragma unroll
                    for (int n = 0; n < 2; ++n) acc[a][b][m][n] = (f32x4){0.f, 0.f, 0.f, 0.f};
        cur = nxt; cA = nA; cB = nB; ++ui;
        if constexpr (ALIGN_EPI) { if (wr == 1) PG8_BAR; }
    }
    PG8_WAIT_V(0);
    if constexpr (!ALIGN_EPI) { if (wr == 0) PG8_BAR; }
    PG8_BAR;
#undef PG8_SA
#undef PG8_SB
#undef PG8_STAGE
#undef PG8_STAGE_A
#undef PG8_LDA
#undef PG8_LDB
#undef PG8_MMA
#undef PG8_WAIT_V
#undef PG8_WAIT_L
#undef PG8_BAR
#undef PG8_SCHED
}
}

#define XB_TMO      128
#define XB_XCNT(j)  (256  + 64 * (j))
#define XB_XSUB(j)  (1280 + 64 * (j))
#define XB_XGEN(j)  (2304 + 64 * (j))
#define XB_TOP      3328
#define XB_TOPGEN   3392
#define XCD_BAR_WORDS 3456
#define XB_SPIN_CAP (1u << 18)
__device__ __forceinline__ unsigned xb_ld(unsigned* p)              { return __hip_atomic_load(p, __ATOMIC_RELAXED, __HIP_MEMORY_SCOPE_AGENT); }
__device__ __forceinline__ unsigned xb_add(unsigned* p, unsigned v) { return __hip_atomic_fetch_add(p, v, __ATOMIC_RELAXED, __HIP_MEMORY_SCOPE_AGENT); }
__device__ __forceinline__ unsigned xb_xcc_id() { return (unsigned)__builtin_amdgcn_s_getreg((3 << 11) | 20) & 0xFu; }
#define XB_SPIN(cond, bar) do { unsigned _sp = 0; while (cond) { __builtin_amdgcn_s_sleep(1); \
    if ((++_sp & 255u) == 0u) { if (xb_ld(&(bar)[XB_TMO])) break; if (_sp > XB_SPIN_CAP) { atomicAdd(&(bar)[XB_TMO], 1u); break; } } } } while (0)
struct XcdBarrier { unsigned* bar; unsigned x; volatile LAS unsigned* st; };
__device__ __forceinline__ XcdBarrier xcd_barrier_post(unsigned* bar, volatile LAS unsigned* st) {
    XcdBarrier b; b.bar = bar; b.x = xb_xcc_id(); b.st = st;
    if (threadIdx.x == 0) (void)xb_add(&bar[XB_XCNT(b.x)], 1u);
    return b;
}
__device__ __forceinline__ void xcd_barrier_complete(unsigned* bar, unsigned x, unsigned& nloc, unsigned& nx) {
    const unsigned G = gridDim.x * gridDim.y * gridDim.z;
    unsigned sum, cnt, mine, sp = 0u;
    for (;;) {
        sum = 0u; cnt = 0u; mine = 0u;
#pragma unroll
        for (unsigned j = 0; j < 16; ++j) { const unsigned c = xb_ld(&bar[XB_XCNT(j)]); sum += c; cnt += (c > 0u) ? 1u : 0u; mine = (j == x) ? c : mine; }
        if (sum == G) break;
        __builtin_amdgcn_s_sleep(1);
        if ((++sp & 255u) == 0u) { if (xb_ld(&bar[XB_TMO])) break; if (sp > XB_SPIN_CAP) { atomicAdd(&bar[XB_TMO], 1u); break; } }
    }
    nloc = mine > 0u ? mine : 1u; nx = cnt > 0u ? cnt : 1u;
}
__device__ __forceinline__ void xcd_barrier(const XcdBarrier& b) {
    asm volatile("s_waitcnt vmcnt(0)" ::: "memory");
    __syncthreads();
    if (threadIdx.x == 0) {
        unsigned* bar = b.bar;
        __builtin_amdgcn_s_waitcnt(0);
        unsigned nloc = b.st[0], nx = b.st[1];
        if (nloc == 0u) { xcd_barrier_complete(bar, b.x, nloc, nx); b.st[0] = nloc; b.st[1] = nx; }
        const unsigned old = xb_add(&bar[XB_XSUB(b.x)], 1u);
        const unsigned gen = old / nloc;
        if (old + 1u == (gen + 1u) * nloc) {
            __builtin_amdgcn_fence(__ATOMIC_RELEASE, "agent");
            asm volatile("s_waitcnt vmcnt(0)" ::: "memory");
            const unsigned og = xb_add(&bar[XB_TOP], 1u);
            const unsigned tg = og / nx;
            if (og + 1u == (tg + 1u) * nx) xb_add(&bar[XB_TOPGEN], 1u);
            else XB_SPIN(xb_ld(&bar[XB_TOPGEN]) == tg, bar);
            __builtin_amdgcn_fence(__ATOMIC_ACQUIRE, "agent");
            xb_add(&bar[XB_XGEN(b.x)], 1u);
            asm volatile("s_waitcnt vmcnt(0)" ::: "memory");
        } else {
            XB_SPIN(xb_ld(&bar[XB_XGEN(b.x)]) == gen, bar);
            __builtin_amdgcn_fence(__ATOMIC_ACQUIRE, "agent");
            asm volatile("s_waitcnt vmcnt(0)" ::: "memory");
        }
    }
    __syncthreads();
}

struct Args { const float* in[31]; float* out; unsigned char* ws; int ph_lo, ph_hi; };

__device__ __forceinline__ void cvt_item(const float* W, int N, const float* gain, bf16* WT, int Kd, int k0, int n0, int drow0, LAS float* scr, int lane) {
#pragma unroll 8
    for (int i = 0; i < 32; ++i) { const int kk = 2 * i + (lane >> 5); float v = W[(size_t)(k0 + kk) * N + n0 + (lane & 31)]; if (gain) v *= gain[k0 + kk]; scr[kk * 33 + (lane & 31)] = v; }
    asm volatile("s_waitcnt lgkmcnt(0)" ::: "memory");
    const int c = lane & 7;
#pragma unroll
    for (int j = 0; j < 4; ++j) { const int n = (lane >> 3) + 8 * j; const LAS float* s = scr + (8 * c) * 33 + n;
        u32x4 o; o.x = pk_bf16(s[0 * 33], s[1 * 33]); o.y = pk_bf16(s[2 * 33], s[3 * 33]); o.z = pk_bf16(s[4 * 33], s[5 * 33]); o.w = pk_bf16(s[6 * 33], s[7 * 33]);
        *(u32x4*)(WT + (size_t)(drow0 + n) * Kd + k0 + 8 * c) = o; }
    asm volatile("s_waitcnt lgkmcnt(0)" ::: "memory");
}

__device__ __forceinline__ void phase_prologue(const Args& a, LAS unsigned char* lds, int vcu, int G, int tid, int lane, int wave) {
    unsigned char* ws = a.ws;
    LAS float* scr = (LAS float*)(lds + wave * 16384);
    const int gw = vcu * NWAVES + wave, NGW = G * NWAVES;
    constexpr int I_IN = 16 * 56, I_SQ = 16 * 32, I_UP = 16 * 88, I_DN = 44 * 32, I_LAYER = I_IN + 5 * I_SQ, I_FFN = 2 * I_UP + I_DN;
    constexpr int NITEMS = 2 * I_LAYER + 9 * I_FFN;
    for (int it0 = gw; it0 < NITEMS; it0 += NGW) {
        int it = it0; const float* W; const float* gain = nullptr; bf16* WT; int N, Kd, k0, n0, drow0;
        if (it < 2 * I_LAYER) {
            const int l = it / I_LAYER; int r = it - l * I_LAYER;
            if (r < I_IN) { W = a.in[3] + (size_t)l * D * DIN; N = DIN; gain = a.in[2] + l * D; WT = (bf16*)(ws + WS_WIN) + (size_t)l * DIN * D; Kd = D; k0 = 64 * (r / 56); n0 = 32 * (r % 56); drow0 = n0; }
            else { r -= I_IN; const int m = r / I_SQ; r -= m * I_SQ; N = D; Kd = D; k0 = 64 * (r / 32); n0 = 32 * (r % 32); drow0 = n0;
                if (m == 0)      { W = a.in[15] + (size_t)l * D * D; WT = (bf16*)(ws + WS_WOUT) + (size_t)l * D * D; }
                else if (m == 1) { W = a.in[18] + (size_t)l * D * D; gain = a.in[16] + l * D; WT = (bf16*)(ws + WS_WQ) + (size_t)l * D * D; }
                else if (m == 2) { W = a.in[19] + (size_t)l * D * D; gain = a.in[17] + l * D; WT = (bf16*)(ws + WS_WK) + (size_t)l * D * D; }
                else if (m == 3) { W = a.in[20] + (size_t)l * D * D; gain = a.in[17] + l * D; WT = (bf16*)(ws + WS_WV) + (size_t)l * D * D; }
                else             { W = a.in[21] + (size_t)l * D * D; WT = (bf16*)(ws + WS_WO) + (size_t)l * D * D; } }
        } else {
            it -= 2 * I_LAYER; const int ex = it / I_FFN; int r = it - ex * I_FFN;
            const float *wg, *wu, *wd, *gn; bf16 *gu_t, *d_t;
            if (ex == 0) { wg = a.in[23]; wu = a.in[24]; wd = a.in[25]; gn = a.in[22]; gu_t = (bf16*)(ws + WS_WGU); d_t = (bf16*)(ws + WS_WD); }
            else { const size_t e = ex - 1; wg = a.in[27] + e * D * DFF; wu = a.in[28] + e * D * DFF; wd = a.in[29] + e * DFF * D; gn = a.in[22] + D;
                   gu_t = (bf16*)(ws + WS_MWGU) + e * 2 * DFF * D; d_t = (bf16*)(ws + WS_MWD) + e * D * DFF; }
            if (r < 2 * I_UP) { const int isu = r >= I_UP; r -= isu * I_UP; W = isu ? wu : wg; N = DFF; gain = gn; WT = gu_t; Kd = D; k0 = 64 * (r / 88); n0 = 32 * (r % 88);
                drow0 = (n0 >> 7) * 256 + (n0 & 127) + (isu ? 128 : 0); }
            else { r -= 2 * I_UP; W = wd; N = D; WT = d_t; Kd = DFF; k0 = 64 * (r / 32); n0 = 32 * (r % 32); drow0 = n0; }
        }
        cvt_item(W, N, gain, WT, Kd, k0, n0, drow0, scr, lane);
    }
    const int gt = vcu * NTHREADS + tid, NGT = G * NTHREADS;
    for (int i = gt; i < 2 * 4 * 128 * 128; i += NGT) { const int ii = (i >> 7) & 127, jj = i & 127; const float v = a.in[10][i]; ((bf16*)(ws + WS_SGUW))[i] = f2bf(((ii >> 6) >= (jj >> 6)) ? v : 0.f); }
    for (int i = gt; i < 2 * 4 * 64 * 64; i += NGT) { const int lg = i >> 12, o = (i >> 6) & 63, ii = i & 63; ((bf16*)(ws + WS_POOLW))[i] = f2bf(a.in[12][(lg << 12) + ii * 64 + o]); }
    u64* rowss0 = (u64*)(ws + OFF_ROWSS);
    for (int m = gw; m < T + MROWS; m += NGW) {
        const bool isx = m < T; const int r = isx ? m : m - T;
        const f32x4* xr = (const f32x4*)((isx ? a.in[0] : a.in[1]) + (size_t)r * D) + lane;
        f32x4 v[4]; float s = 0.f;
#pragma unroll
        for (int j = 0; j < 4; ++j) { v[j] = xr[64 * j]; s += (v[j][0] * v[j][0] + v[j][1] * v[j][1]) + (v[j][2] * v[j][2] + v[j][3] * v[j][3]); }
        s = wave_sum(s);
        u32x2* o8 = (u32x2*)((isx ? (bf16*)(ws + WS_XB) : (bf16*)(ws + WS_MEMB)) + (size_t)r * D) + lane;
#pragma unroll
        for (int j = 0; j < 4; ++j) { u32x2 w; w.x = pk_bf16(v[j][0], v[j][1]); w.y = pk_bf16(v[j][2], v[j][3]); o8[64 * j] = w; }
        if (isx) { f32x4* xo = (f32x4*)(a.out + (size_t)r * D) + lane;
#pragma unroll
            for (int j = 0; j < 4; ++j) xo[64 * j] = v[j];
            if (lane == 0) rowss0[r] = ss_to_fix(s); }
        else if (lane == 0) ((u64*)(ws + OFF_MEMSS))[r] = ss_to_fix(s);
    }
}

__device__ __forceinline__ void mixer_unit(const Args& a, LAS unsigned char* lds, int l, int u, int tid_in, int lane_in, int wave) {
    int tid = tid_in, lane = lane_in;
    const bf16* z = (const bf16*)(a.ws + WS_Z); bf16* mixed = (bf16*)(a.ws + WS_MIXED);
    const int b = u >> 5, c = u & 31, t0 = c * 128; const size_t R0 = (size_t)b * SEQ + t0;
    {
        const float* cw = a.in[4] + l * 31 * 384; const float* cb = a.in[5] + l * 384; const float* lg = a.in[6] + l * 384; const float* lb = a.in[7] + l * 384;
        for (int it = tid; it < 158 * 48; it += NTHREADS) { const int j = it / 48, v = it - j * 48; u32x4 o = {0u, 0u, 0u, 0u};
            if (t0 - 30 + j >= 0) { const bf16* rp = z + (R0 + j - 30) * DIN + 8 * v; const u32x4 av = *(const u32x4*)rp, gv = *(const u32x4*)(rp + 384);
#pragma unroll
                for (int q = 0; q < 4; ++q) o[q] = pk_bf16(bf_lo(av[q]) * sigm(bf_lo(gv[q])), bf_hi(av[q]) * sigm(bf_hi(gv[q]))); }
            *(LAS u32x4*)(lds + j * 768 + v * 16) = o; }
        __syncthreads();
        LAS float* part = (LAS float*)(lds + 122880);
        OPAQUE(tid); lane = tid & 63;
#pragma unroll 1
        for (int jt = 0; jt < 3; ++jt) { const int item = tid + NTHREADS * jt, rg = item / 192, p = item - rg * 192, q3 = p >> 6;
            f32x2 w[31];
#pragma unroll
            for (int k = 0; k < 31; ++k) w[k] = *(const f32x2*)(cw + k * 384 + 2 * p);
            const f32x2 bias = *(const f32x2*)(cb + 2 * p);
            float y0[16], y1[16];
#pragma unroll
            for (int i = 0; i < 16; ++i) { y0[i] = bias.x; y1[i] = bias.y; }
            const LAS unsigned* hp = (const LAS unsigned*)lds + (rg * 16) * 192 + p;
#pragma unroll
            for (int jj = 0; jj < 46; ++jj) { const unsigned hv = hp[jj * 192]; const float h0 = bf_lo(hv), h1 = bf_hi(hv);
#pragma unroll
                for (int i = 0; i < 16; ++i) { const int k = jj - i; if (k >= 0 && k <= 30) { y0[i] += w[k].x * h0; y1[i] += w[k].y * h1; } } }
#pragma unroll
            for (int i = 0; i < 16; ++i) { float s1 = y0[i] + y1[i], s2 = y0[i] * y0[i] + y1[i] * y1[i];
                s1 = wave_sum(s1); s2 = wave_sum(s2);
                if (lane == 0) { part[((rg * 16 + i) * 3 + q3) * 2] = s1; part[((rg * 16 + i) * 3 + q3) * 2 + 1] = s2; }
                *(unsigned*)(mixed + (R0 + rg * 16 + i) * D + 2 * p) = pk_bf16(y0[i], y1[i]); }
        }
        __syncthreads();
        OPAQUE(tid);
#pragma unroll 1
        for (int jt = 0; jt < 3; ++jt) { const int item = tid + NTHREADS * jt, rg = item / 192, p = item - rg * 192;
            const f32x2 g2 = *(const f32x2*)(lg + 2 * p), b2 = *(const f32x2*)(lb + 2 * p);
#pragma unroll
            for (int i = 0; i < 16; ++i) { const int row = rg * 16 + i; const LAS float* pr = part + row * 6;
                const float S1 = pr[0] + pr[2] + pr[4], S2 = pr[1] + pr[3] + pr[5];
                const float mean = S1 * (1.0f / 384.0f), var = S2 * (1.0f / 384.0f) - mean * mean, rstd = __builtin_amdgcn_rsqf(var + EPS);
                unsigned* mp = (unsigned*)(mixed + (R0 + row) * D + 2 * p); const unsigned yv = *mp;
                const float o0 = (bf_lo(yv) - mean) * rstd * g2.x + b2.x, o1 = (bf_hi(yv) - mean) * rstd * g2.y + b2.y;
                *mp = pk_bf16(silu_f(o0), silu_f(o1)); } }
    }
    {
        OPAQUE(tid); lane = tid & 63;
        const bf16* pwT = (const bf16*)(a.ws + WS_POOLW) + l * 4 * 64 * 64; const float* pb = a.in[13] + l * 256; const float* psc = a.in[14] + l * 256;
        for (int it = tid; it < 143 * 32; it += NTHREADS) { const int j = it >> 5, v = it & 31; u32x4 o = {0u, 0u, 0u, 0u};
            if (t0 - 15 + j >= 0) o = *(const u32x4*)(z + (R0 + j - 15) * DIN + 1536 + 8 * v);
            *(LAS u32x4*)(lds + j * 512 + v * 16) = o; }
        __syncthreads();
        OPAQUE(tid);
        { const int pp = tid & 127, rq = tid >> 7; const int w = 2 << (pp >> 5); const LAS unsigned* cp = (const LAS unsigned*)lds + pp; const int i0 = rq * 32;
            float s0 = 0.f, s1 = 0.f;
#pragma unroll
            for (int kk = 0; kk < 16; ++kk) if (kk < w) { const unsigned v = cp[(i0 + 15 - kk) * 128]; s0 += bf_lo(v); s1 += bf_hi(v); }
            for (int ii = 0; ii < 32; ++ii) { const int i = i0 + ii; const unsigned cv = cp[(i + 15) * 128];
                const int tpos = t0 + i + 1; const float inv = 1.0f / (float)(tpos < w ? tpos : w);
                *(LAS unsigned*)(lds + 73728 + i * 528 + pp * 4) = pk_bf16(s0 * inv - bf_lo(cv), s1 * inv - bf_hi(cv));
                if (ii < 31) { const unsigned vn = cp[(i + 16) * 128], vo = cp[(i + 16 - w) * 128]; s0 += bf_lo(vn) - bf_lo(vo); s1 += bf_hi(vn) - bf_hi(vo); } } }
        __syncthreads();
        OPAQUE(tid); lane = tid & 63;
        { const int r = lane & 15, kq = lane >> 4; f32x4 acc[4][4];
#pragma unroll
            for (int g = 0; g < 4; ++g)
#pragma unroll
                for (int n = 0; n < 4; ++n) acc[g][n] = (f32x4){0.f, 0.f, 0.f, 0.f};
#pragma unroll
            for (int g = 0; g < 4; ++g)
#pragma unroll
                for (int ks = 0; ks < 2; ++ks) { const bf16x8 af = *(const LAS bf16x8*)(lds + 73728 + (16 * wave + r) * 528 + (g * 64 + 32 * ks + 8 * kq) * 2);
#pragma unroll
                    for (int n = 0; n < 4; ++n) { const bf16x8 bfr = *(const bf16x8*)(pwT + ((g * 64 + 16 * n + r) * 64 + 32 * ks + 8 * kq));
                        acc[g][n] = __builtin_amdgcn_mfma_f32_16x16x32_bf16(bfr, af, acc[g][n], 0, 0, 0); } }
            const int row = 16 * wave + r;
#pragma unroll
            for (int g = 0; g < 4; ++g)
#pragma unroll
                for (int n = 0; n < 4; ++n) { const int ch = g * 64 + 16 * n + 4 * kq; const f32x4 b4 = *(const f32x4*)(pb + ch), s4 = *(const f32x4*)(psc + ch); const f32x4 o = (acc[g][n] + b4) * s4;
                    u32x2 w2; w2.x = pk_bf16(o[0], o[1]); w2.y = pk_bf16(o[2], o[3]); *(u32x2*)(mixed + (R0 + row) * D + 768 + ch) = w2; } }
        __syncthreads();
    }
    {
        OPAQUE(tid); lane = tid & 63;
        const float* lg = a.in[8] + l * 384; const float* lb = a.in[9] + l * 384; const float* sb = a.in[11] + l * 4 * 128;
        const bf16* Wm = (const bf16*)(a.ws + WS_SGUW) + (size_t)l * 4 * 128 * 128;
        for (int it = tid; it < 128 * 48; it += NTHREADS) { const int j = it / 48, v = it - j * 48; *(LAS u32x4*)(lds + j * 784 + v * 16) = *(const u32x4*)(z + (R0 + j) * DIN + 1152 + 8 * v); }
        __syncthreads();
        OPAQUE(tid);
        { const int j = tid & 127, qd = __builtin_amdgcn_readfirstlane(tid >> 7); float vv[96]; float s1 = 0.f, s2 = 0.f;
#pragma unroll
            for (int k = 0; k < 12; ++k) { const u32x4 x = *(const LAS u32x4*)(lds + j * 784 + qd * 192 + 16 * k);
#pragma unroll
                for (int q = 0; q < 4; ++q) { const float e0 = gelu_tanh(bf_lo(x[q])), e1 = gelu_tanh(bf_hi(x[q])); vv[8 * k + 2 * q] = e0; vv[8 * k + 2 * q + 1] = e1; s1 += e0 + e1; s2 += e0 * e0 + e1 * e1; } }
            LAS float* st = (LAS float*)(lds + 122880);
            st[(j * 4 + qd) * 2] = s1; st[(j * 4 + qd) * 2 + 1] = s2;
            __syncthreads();
            const float S1 = st[j * 8] + st[j * 8 + 2] + st[j * 8 + 4] + st[j * 8 + 6], S2 = st[j * 8 + 1] + st[j * 8 + 3] + st[j * 8 + 5] + st[j * 8 + 7];
            const float mean = S1 * (1.0f / 384.0f), var = S2 * (1.0f / 384.0f) - mean * mean, rstd = __builtin_amdgcn_rsqf(var + EPS);
#pragma unroll
            for (int cidx = 0; cidx < 96; ++cidx) { const float o = (vv[cidx] - mean) * rstd * lg[qd * 96 + cidx] + lb[qd * 96 + cidx];
                *(LAS bf16*)(lds + (qd * 96 + cidx) * 272 + j * 2) = f2bf(o); } }
        __syncthreads();
        OPAQUE(tid); lane = tid & 63;
        { const int hd = wave >> 1, ih = wave & 1, r = lane & 15, kq = lane >> 4; f32x4 acc[6][4];
#pragma unroll
            for (int dt = 0; dt < 6; ++dt)
#pragma unroll
                for (int it = 0; it < 4; ++it) acc[dt][it] = (f32x4){0.f, 0.f, 0.f, 0.f};
            const bf16* Wh = Wm + (size_t)hd * 128 * 128; const int nks = ih ? 4 : 2;
            for (int ks = 0; ks < nks; ++ks) { bf16x8 wf[4];
#pragma unroll
                for (int it = 0; it < 4; ++it) wf[it] = *(const bf16x8*)(Wh + (64 * ih + 16 * it + r) * 128 + 32 * ks + 8 * kq);
#pragma unroll
                for (int dt = 0; dt < 6; ++dt) { const bf16x8 vf = *(const LAS bf16x8*)(lds + (hd * 96 + 16 * dt + r) * 272 + (32 * ks + 8 * kq) * 2);
#pragma unroll
                    for (int it = 0; it < 4; ++it) acc[dt][it] = __builtin_amdgcn_mfma_f32_16x16x32_bf16(vf, wf[it], acc[dt][it], 0, 0, 0); } }
#pragma unroll
            for (int it = 0; it < 4; ++it) { const int i = 64 * ih + 16 * it + r; const float sbv = sb[hd * 128 + i];
#pragma unroll
                for (int dt = 0; dt < 6; ++dt) { const int ch = hd * 96 + 16 * dt + 4 * kq; const u32x2 uu = *(const u32x2*)(z + (R0 + i) * DIN + 768 + ch);
                    const float o0 = gelu_tanh(bf_lo(uu.x)) * (acc[dt][it][0] + sbv), o1 = gelu_tanh(bf_hi(uu.x)) * (acc[dt][it][1] + sbv);
                    const float o2 = gelu_tanh(bf_lo(uu.y)) * (acc[dt][it][2] + sbv), o3 = gelu_tanh(bf_hi(uu.y)) * (acc[dt][it][3] + sbv);
                    u32x2 w2; w2.x = pk_bf16(o0, o1); w2.y = pk_bf16(o2, o3); *(u32x2*)(mixed + (R0 + i) * D + 384 + ch) = w2; } } }
        __syncthreads();
    }
}

__device__ __forceinline__ void attn_unit(const Args& a, LAS unsigned char* lds, int l, int u, int tid, int lane, int wave) {
    const bf16* Q = (const bf16*)(a.ws + WS_Q); bf16* O = (bf16*)(a.ws + WS_O);
    const bf16* KB = (const bf16*)(a.ws + WS_KB); const bf16* VT = (const bf16*)(a.ws + WS_VT);
    const int qt = u & 15, bh = u >> 4, b = bh >> 2, h = bh & 3;
    { const bf16* kp = KB + (size_t)(b * 256) * 2048 + l * 1024 + h * 256;
        for (int it = tid; it < 256 * 32; it += NTHREADS) { const int row = it >> 5, v = it & 31; *(LAS u32x4*)(lds + row * 528 + v * 16) = *(const u32x4*)(kp + (size_t)row * 2048 + 8 * v); } }
    __syncthreads();
    const int r = lane & 31, h2 = lane >> 5; const size_t qrow = (size_t)b * SEQ + qt * 256 + wave * 32 + r;
    f32x16 sacc[8];
#pragma unroll
    for (int kt = 0; kt < 8; ++kt)
#pragma unroll
        for (int j = 0; j < 16; ++j) sacc[kt][j] = 0.f;
    const bf16* qp = Q + qrow * D + h * 256 + 8 * h2;
#pragma unroll 4
    for (int s = 0; s < 16; ++s) { const bf16x8 qf = *(const bf16x8*)(qp + 16 * s);
#pragma unroll
        for (int kt = 0; kt < 8; ++kt) { const bf16x8 kf = *(const LAS bf16x8*)(lds + (32 * kt + r) * 528 + (16 * s + 8 * h2) * 2);
            sacc[kt] = __builtin_amdgcn_mfma_f32_32x32x16_bf16(kf, qf, sacc[kt], 0, 0, 0); } }
    float mx = -3.0e38f;
#pragma unroll
    for (int kt = 0; kt < 8; ++kt)
#pragma unroll
        for (int j = 0; j < 16; ++j) mx = fmaxf(mx, sacc[kt][j]);
    mx = fmaxf(mx, __shfl_xor(mx, 32));
    float sum = 0.f; bf16x8 pf[8][2];
#pragma unroll
    for (int kt = 0; kt < 8; ++kt) {
        float p[16];
#pragma unroll
        for (int j = 0; j < 16; ++j) { p[j] = __builtin_amdgcn_exp2f(sacc[kt][j] - mx); sum += p[j]; }
#pragma unroll
        for (int s2 = 0; s2 < 2; ++s2) { u32x4 w; w.x = pk_bf16(p[8 * s2], p[8 * s2 + 1]); w.y = pk_bf16(p[8 * s2 + 2], p[8 * s2 + 3]); w.z = pk_bf16(p[8 * s2 + 4], p[8 * s2 + 5]); w.w = pk_bf16(p[8 * s2 + 6], p[8 * s2 + 7]);
            pf[kt][s2] = __builtin_bit_cast(bf16x8, w); } }
    sum += __shfl_xor(sum, 32);
    const float inv = 1.0f / sum;
    __syncthreads();
    { const bf16* vp = VT + (size_t)(l * 1024 + h * 256) * 2048 + b * 256;
        for (int it = tid; it < 256 * 32; it += NTHREADS) { const int row = it >> 5, v = it & 31; const u32x4 x = *(const u32x4*)(vp + (size_t)row * 2048 + 8 * v);
            const int grp = v >> 1, odd = v & 1; LAS unsigned char* dst = lds + row * 528 + grp * 32 + odd * 8;
            *(LAS u32x2*)(dst) = (u32x2){x.x, x.y}; *(LAS u32x2*)(dst + 16) = (u32x2){x.z, x.w}; } }
    __syncthreads();
#pragma unroll
    for (int dh = 0; dh < 2; ++dh) {
        f32x16 oacc[4];
#pragma unroll
        for (int dt = 0; dt < 4; ++dt)
#pragma unroll
            for (int j = 0; j < 16; ++j) oacc[dt][j] = 0.f;
#pragma unroll
        for (int kt = 0; kt < 8; ++kt)
#pragma unroll
            for (int s2 = 0; s2 < 2; ++s2)
#pragma unroll
                for (int dt = 0; dt < 4; ++dt) { const bf16x8 vf = *(const LAS bf16x8*)(lds + (dh * 128 + 32 * dt + r) * 528 + (kt * 2 + s2) * 32 + 16 * h2);
                    oacc[dt] = __builtin_amdgcn_mfma_f32_32x32x16_bf16(vf, pf[kt][s2], oacc[dt], 0, 0, 0); }
        bf16* op = O + qrow * D + h * 256 + dh * 128 + 4 * h2;
#pragma unroll
        for (int dt = 0; dt < 4; ++dt)
#pragma unroll
            for (int g4 = 0; g4 < 4; ++g4) { u32x2 w; w.x = pk_bf16(oacc[dt][4 * g4] * inv, oacc[dt][4 * g4 + 1] * inv); w.y = pk_bf16(oacc[dt][4 * g4 + 2] * inv, oacc[dt][4 * g4 + 3] * inv);
                *(u32x2*)(op + 32 * dt + 8 * g4) = w; }
    }
    __syncthreads();
}

__device__ __forceinline__ void phase_router(const Args& a, LAS unsigned char* lds, int vcu, int G, int tid, int lane, int wave) {
    unsigned char* ws = a.ws;
    LAS float* grw = (LAS float*)lds;
    LAS int* hist = (LAS int*)(lds + 32768);
    const float* gn = a.in[22] + D; const float* rw = a.in[26];
    for (int i = tid; i < D * NE; i += NTHREADS) grw[i] = gn[i >> 3] * rw[i];
    if (tid < 16) hist[tid] = 0;
    __syncthreads();
    const u64* rowss = (const u64*)(ws + OFF_ROWSS) + 5 * T;
    int* sel = (int*)(ws + WS_ROUTE); float* gate = (float*)(ws + WS_ROUTE + 2 * T * 4);
    const int gw = vcu * NWAVES + wave, NGW = G * NWAVES;
    for (int m = gw; m < T; m += NGW) {
        const f32x4* xr = (const f32x4*)(a.out + (size_t)m * D) + lane;
        float p[8];
#pragma unroll
        for (int e = 0; e < 8; ++e) p[e] = 0.f;
#pragma unroll
        for (int j = 0; j < 4; ++j) { const f32x4 x = xr[64 * j]; const int k0 = 4 * (lane + 64 * j);
#pragma unroll
            for (int q = 0; q < 4; ++q) { const f32x4 w0 = *(const LAS f32x4*)(grw + (k0 + q) * 8), w1 = *(const LAS f32x4*)(grw + (k0 + q) * 8 + 4);
                p[0] += x[q] * w0[0]; p[1] += x[q] * w0[1]; p[2] += x[q] * w0[2]; p[3] += x[q] * w0[3]; p[4] += x[q] * w1[0]; p[5] += x[q] * w1[1]; p[6] += x[q] * w1[2]; p[7] += x[q] * w1[3]; } }
        const float rstd = rstd_ss(rowss[m]);
#pragma unroll
        for (int e = 0; e < 8; ++e) p[e] = wave_sum(p[e]) * rstd;
        int i0 = 0; float v0 = p[0];
#pragma unroll
        for (int e = 1; e < 8; ++e) if (p[e] > v0) { v0 = p[e]; i0 = e; }
        int i1 = -1; float v1 = -3.0e38f;
#pragma unroll
        for (int e = 0; e < 8; ++e) if (e != i0 && p[e] > v1) { v1 = p[e]; i1 = e; }
        const float g0 = 1.0f / (1.0f + __expf(v1 - v0)), g1 = 1.0f - g0;
        if (lane == 0) { sel[m] = i0; sel[T + m] = i1; gate[m] = g0; gate[T + m] = g1; __hip_atomic_fetch_add(&hist[i0], 1, __ATOMIC_RELAXED, __HIP_MEMORY_SCOPE_WORKGROUP); __hip_atomic_fetch_add(&hist[8 + i1], 1, __ATOMIC_RELAXED, __HIP_MEMORY_SCOPE_WORKGROUP); }
    }
    __syncthreads();
    { int t3 = tid; OPAQUE(t3); if (t3 < 16) atomicAdd((int*)(ws + OFF_MOECNT) + t3, hist[t3]); }
}
__device__ __forceinline__ void phase_lists(const Args& a, LAS unsigned char* lds, int vcu, int G, int tid) {
    unsigned char* ws = a.ws;
    const int* cnt = (const int*)(ws + OFF_MOECNT); int* cursor = (int*)(ws + OFF_MOECNT + 256);
    const u64* rowss = (const u64*)(ws + OFF_ROWSS) + 5 * T;
    const int* sel = (const int*)(ws + WS_ROUTE); const float* gate = (const float*)(ws + WS_ROUTE + 2 * T * 4);
    int* perm = (int*)(ws + WS_ROUTE + 4 * T * 4); float* rsp = (float*)(ws + WS_ROUTE + 4 * T * 4 + 2 * PERMROWS * 4); float* gp = (float*)(ws + WS_ROUTE + 4 * T * 4 + 4 * PERMROWS * 4);
    LAS int* lc = (LAS int*)lds;
    LAS int* lb = (LAS int*)(lds + 64);
    for (int chunk = vcu; chunk < T / 128; chunk += G)
        for (int s = 0; s < 2; ++s) {
            __syncthreads();
            if (tid < 8) lc[tid] = 0;
            __syncthreads();
            int e = 0, rnk = 0; const int tok = chunk * 128 + tid;
            if (tid < 128) { e = sel[s * T + tok]; rnk = __hip_atomic_fetch_add(&lc[e], 1, __ATOMIC_RELAXED, __HIP_MEMORY_SCOPE_WORKGROUP); }
            __syncthreads();
            if (tid < 8) lb[tid] = atomicAdd(cursor + s * 8 + tid, lc[tid]);
            __syncthreads();
            if (tid < 128) { int off = 0;
#pragma unroll
                for (int j = 0; j < 8; ++j) { const int tl = (cnt[s * 8 + j] + 255) >> 8; if (j < e) off += tl * 256; }
                const int pos = off + lb[e] + rnk;
                perm[s * PERMROWS + pos] = tok; rsp[s * PERMROWS + pos] = rstd_ss(rowss[tok]); gp[s * PERMROWS + pos] = gate[s * T + tok]; }
        }
    if (vcu < 16) { const int s = vcu >> 3, e = vcu & 7; int off = 0, ce = 0;
#pragma unroll
        for (int j = 0; j < 8; ++j) { const int cj = cnt[s * 8 + j]; const int tl = (cj + 255) >> 8; if (j < e) off += tl * 256; if (j == e) ce = cj; }
        const int end = off + ((ce + 255) >> 8) * 256;
        for (int pos = off + ce + tid; pos < end; pos += NTHREADS) { perm[s * PERMROWS + pos] = -1; rsp[s * PERMROWS + pos] = 0.f; gp[s * PERMROWS + pos] = 0.f; } }
}

__device__ __forceinline__ void phase_final(const Args& a, int vcu, int G, int lane, int wave) {
    const u64* rowss = (const u64*)(a.ws + OFF_ROWSS) + 6 * T; const float* g = a.in[30];
    const int gw = vcu * NWAVES + wave, NGW = G * NWAVES;
    f32x4 gv[4];
#pragma unroll
    for (int j = 0; j < 4; ++j) gv[j] = ((const f32x4*)g)[lane + 64 * j];
    for (int m = gw; m < T; m += NGW) { f32x4* xr = (f32x4*)(a.out + (size_t)m * D) + lane; const float rstd = rstd_ss(rowss[m]);
#pragma unroll
        for (int j = 0; j < 4; ++j) xr[64 * j] = xr[64 * j] * rstd * gv[j]; }
}

__global__ void __launch_bounds__(NTHREADS, 2) fwd_kernel(Args args) {
    extern __shared__ __attribute__((aligned(16))) unsigned char lds_raw[];
    LAS unsigned char* lds = (LAS unsigned char*)lds_raw;
    const int tid = threadIdx.x, lane = tid & 63, wave = __builtin_amdgcn_readfirstlane(tid >> 6);
    const int G = gridDim.x; const int bx = blockIdx.x; const int vcu = (G % 8 == 0) ? (bx % 8) * (G / 8) + bx / 8 : bx;
    unsigned char* ws = args.ws;
    volatile LAS unsigned* MISC = (volatile LAS unsigned*)(lds + MISC_OFF);
    if (tid < 64) MISC[tid] = 0u;
    __syncthreads();
    const int lo = args.ph_lo, hi = args.ph_hi;
    XcdBarrier bar; bar.bar = (unsigned*)ws + CW_BAR; bar.x = 0; bar.st = nullptr;
    if (hi - lo > 1) bar = xcd_barrier_post((unsigned*)ws + CW_BAR, MISC + 8);
#define IN(k) (lo <= (k) && (k) < hi)
#define SEAM(k) do { if (lo <= (k) && (k) + 1 < hi) xcd_barrier(bar); } while (0)
    u64* rowss = (u64*)(ws + OFF_ROWSS);
    bf16* XB = (bf16*)(ws + WS_XB);
    constexpr float QSCALE = 0.0625f * 1.4426950408889634f;

    if (EN_PRO && IN(0)) { int t2 = tid; OPAQUE(t2); phase_prologue(args, lds, vcu, G, t2, t2 & 63, wave); }
    SEAM(0);
#pragma unroll 1
    for (int l = 0; l < 2; ++l) {
        const int pb = 1 + 8 * l;
        if (EN_GEMM && EN_G1 && IN(pb)) {
            if (EN_KV && l == 0 && bx >= 128) {
                if (bx < 192) { pg8::Gemm g{(const bf16*)(ws + WS_MEMB), (const bf16*)(ws + WS_WK), nullptr, MROWS, 2048, D}; pg8::StaticOrder S; S.init(MROWS, 2048, 64, bx - 128);
                    pg8::EpiRowScale<false> E{(bf16*)(ws + WS_KB), 2048, (const void*)(ws + OFF_MEMSS), 1.0f};
                    pg8::gemm_phase<pg8::EpiRowScale<false>, pg8::StaticOrder, true, false>(lds, g, S, E); }
                else { pg8::Gemm g{(const bf16*)(ws + WS_WV), (const bf16*)(ws + WS_MEMB), nullptr, 2048, MROWS, D}; pg8::StaticOrder S; S.init(2048, MROWS, 64, bx - 192);
                    pg8::EpiColScale E{(bf16*)(ws + WS_VT), 2048, (const u64*)(ws + OFF_MEMSS)};
                    pg8::gemm_phase<pg8::EpiColScale, pg8::StaticOrder, true, false>(lds, g, S, E); }
            }
            pg8::Gemm g{XB, (const bf16*)(ws + WS_WIN) + (size_t)l * DIN * D, nullptr, T, DIN, D}; pg8::StaticOrder S; S.init(T, DIN, G, bx);
            pg8::EpiRowScale<false> E{(bf16*)(ws + WS_Z), DIN, rowss + (size_t)(3 * l) * T, 1.0f};
            pg8::gemm_phase<pg8::EpiRowScale<false>, pg8::StaticOrder, true, false>(lds, g, S, E);
        }
        SEAM(pb);
        if (EN_MIX && IN(pb + 1)) { int t2 = tid; asm volatile("" : "+v"(t2)); for (int u = vcu; u < 256; u += G) mixer_unit(args, lds, l, u, t2, t2 & 63, wave); }
        SEAM(pb + 1);
        if (EN_GEMM && EN_G2 && IN(pb + 2)) {
            pg8::Gemm g{(const bf16*)(ws + WS_MIXED), (const bf16*)(ws + WS_WOUT) + (size_t)l * D * D, nullptr, T, D, D}; pg8::StaticOrder S; S.init(T, D, G, bx);
            pg8::EpiResid<false, true, true> E{args.out, XB, rowss + (size_t)(3 * l + 1) * T, nullptr, nullptr};
            pg8::gemm_phase<pg8::EpiResid<false, true, true>, pg8::StaticOrder, true, false>(lds, g, S, E);
        }
        SEAM(pb + 2);
        if (EN_GEMM && EN_G3 && IN(pb + 3)) {
            pg8::Gemm g{XB, (const bf16*)(ws + WS_WQ) + (size_t)l * D * D, nullptr, T, D, D}; pg8::StaticOrder S; S.init(T, D, G, bx);
            pg8::EpiRowScale<false> E{(bf16*)(ws + WS_Q), D, rowss + (size_t)(3 * l + 1) * T, QSCALE};
            pg8::gemm_phase<pg8::EpiRowScale<false>, pg8::StaticOrder, true, false>(lds, g, S, E);
        }
        SEAM(pb + 3);
        if (EN_ATT && IN(pb + 4)) { int t2 = tid; asm volatile("" : "+v"(t2)); for (int u = vcu; u < 512; u += G) attn_unit(args, lds, l, u, t2, t2 & 63, wave); }
        SEAM(pb + 4);
        if (EN_GEMM && EN_G2 && IN(pb + 5)) {
            pg8::Gemm g{(const bf16*)(ws + WS_O), (const bf16*)(ws + WS_WO) + (size_t)l * D * D, nullptr, T, D, D}; pg8::StaticOrder S; S.init(T, D, G, bx);
            pg8::EpiResid<false, true, true> E{args.out, XB, rowss + (size_t)(3 * l + 2) * T, nullptr, nullptr};
            pg8::gemm_phase<pg8::EpiResid<false, true, true>, pg8::StaticOrder, true, false>(lds, g, S, E);
        }
        SEAM(pb + 5);
        if (l == 0) {
            if (EN_GEMM && EN_G4 && IN(7)) {
                pg8::Gemm g{XB, (const bf16*)(ws + WS_WGU), nullptr, T, 2 * DFF, D}; pg8::StaticOrder S; S.init(T, 2 * DFF, G, bx);
                pg8::EpiSwiglu<false> E{(bf16*)(ws + WS_H), DFF, rowss + (size_t)2 * T};
                pg8::gemm_phase<pg8::EpiSwiglu<false>, pg8::StaticOrder, true, false>(lds, g, S, E);
            }
            SEAM(7);
            if (EN_GEMM && EN_G2 && IN(8)) {
                pg8::Gemm g{(const bf16*)(ws + WS_H), (const bf16*)(ws + WS_WD), nullptr, T, D, DFF}; pg8::StaticOrder S; S.init(T, D, G, bx);
                pg8::EpiResid<false, true, true> E{args.out, XB, rowss + (size_t)3 * T, nullptr, nullptr};
                pg8::gemm_phase<pg8::EpiResid<false, true, true>, pg8::StaticOrder, true, false>(lds, g, S, E);
            }
            SEAM(8);
        } else {
            if (EN_ROUTE && IN(15)) { int t2 = tid; OPAQUE(t2); phase_router(args, lds, vcu, G, t2, t2 & 63, wave); }
            SEAM(15);
            if (EN_ROUTE && IN(16)) { int t2 = tid; OPAQUE(t2); phase_lists(args, lds, vcu, G, t2); }
            SEAM(16);
            const int* perm = (const int*)(ws + WS_ROUTE + 4 * T * 4); const float* rsp = (const float*)(ws + WS_ROUTE + 4 * T * 4 + 2 * PERMROWS * 4); const float* gp = (const float*)(ws + WS_ROUTE + 4 * T * 4 + 4 * PERMROWS * 4);
#pragma unroll 1
            for (int s = 0; s < 2; ++s) {
                pg8::MoeOrder S; S.G = G; S.c = bx; S.tp[0] = 0;
                if (IN(17 + 2 * s) || IN(18 + 2 * s)) {
                    const int* cnt = (const int*)(ws + OFF_MOECNT) + s * 8;
#pragma unroll
                    for (int j = 0; j < 8; ++j) S.tp[j + 1] = S.tp[j] + ((__builtin_amdgcn_readfirstlane(cnt[j]) + 255) >> 8);
                } else {
#pragma unroll
                    for (int j = 0; j < 8; ++j) S.tp[j + 1] = 0;
                }
                if (EN_MOE && IN(17 + 2 * s)) {
                    S.nN = 2 * DFF / 256;
                    pg8::Gemm g{XB, (const bf16*)(ws + WS_MWGU), perm + s * PERMROWS, T, 2 * DFF, D};
                    pg8::EpiSwiglu<true> E{(bf16*)(ws + WS_H), DFF, rsp + s * PERMROWS};
                    pg8::gemm_phase<pg8::EpiSwiglu<true>, pg8::MoeOrder, true, true>(lds, g, S, E);
                }
                SEAM(17 + 2 * s);
                if (EN_MOE && IN(18 + 2 * s)) {
                    S.nN = D / 256;
                    pg8::Gemm g{(const bf16*)(ws + WS_H), (const bf16*)(ws + WS_MWD), nullptr, T, D, DFF};
                    pg8::EpiResid<true, false, true> E{args.out, nullptr, rowss + (size_t)6 * T, perm + s * PERMROWS, gp + s * PERMROWS};
                    if (s == 0) { pg8::EpiResid<true, false, false> E0{args.out, nullptr, nullptr, perm, gp};
                        pg8::gemm_phase<pg8::EpiResid<true, false, false>, pg8::MoeOrder, true, false>(lds, g, S, E0); }
                    else pg8::gemm_phase<pg8::EpiResid<true, false, true>, pg8::MoeOrder, true, false>(lds, g, S, E);
                }
                SEAM(18 + 2 * s);
            }
            if (IN(21)) { int t2 = tid; OPAQUE(t2); phase_final(args, vcu, G, t2 & 63, wave); }
        }
    }
#undef IN
#undef SEAM
}

extern "C" void kernel_launch(void* const* d_in, const int* in_sizes, int n_in, void* d_out, int out_size, void* d_ws, size_t ws_size, hipStream_t stream) {
    static int grid = 0;
    if (grid == 0) {
        if (n_in != 31 || in_sizes[0] != T * D || out_size != T * D || ws_size < WS_END) { fprintf(stderr, "kernel_launch: unexpected shapes (n_in %d, in0 %d, out %d, ws %zu)\n", n_in, n_in > 0 ? in_sizes[0] : -1, out_size, ws_size); grid = -1; return; }
        int dev = 0, cus = 0;
        if (hipGetDevice(&dev) != hipSuccess || hipDeviceGetAttribute(&cus, hipDeviceAttributeMultiprocessorCount, dev) != hipSuccess) { grid = -1; return; }
        if (hipFuncSetAttribute((const void*)fwd_kernel, hipFuncAttributeMaxDynamicSharedMemorySize, LDS_BYTES) != hipSuccess) { fprintf(stderr, "kernel_launch: hipFuncSetAttribute failed\n"); grid = -1; return; }
        int per_cu = 0;
        if (hipOccupancyMaxActiveBlocksPerMultiprocessor(&per_cu, (const void*)fwd_kernel, NTHREADS, LDS_BYTES) != hipSuccess || per_cu < 1) fprintf(stderr, "kernel_launch: occupancy query reports %d\n", per_cu);
        (void)hipGetLastError();
        grid = cus;
    }
    if (grid < 0) return;
    (void)hipMemsetAsync(d_ws, 0, CTL_ZERO_BYTES, stream);
    Args a{};
    for (int i = 0; i < 31; ++i) a.in[i] = (const float*)d_in[i];
    a.out = (float*)d_out; a.ws = (unsigned char*)d_ws;
#if MK_PER_PHASE
    for (int ph = 0; ph < NPH; ++ph) { a.ph_lo = ph; a.ph_hi = ph + 1; hipLaunchKernelGGL(fwd_kernel, dim3(grid), dim3(NTHREADS), LDS_BYTES, stream, a); }
#else
    a.ph_lo = 0; a.ph_hi = NPH; hipLaunchKernelGGL(fwd_kernel, dim3(grid), dim3(NTHREADS), LDS_BYTES, stream, a);
#endif
}
```

```cpp
#include <hip/hip_runtime.h>
#include <cstdio>
#include <cstdint>

#ifndef MK_PER_PHASE
#define MK_PER_PHASE 0
#endif

#ifndef EN_PRO
#define EN_PRO 1
#endif
#ifndef EN_GEMM
#define EN_GEMM 1
#endif
#ifndef EN_G1
#define EN_G1 1
#endif
#ifndef EN_G2
#define EN_G2 1
#endif
#ifndef EN_G3
#define EN_G3 1
#endif
#ifndef EN_G4
#define EN_G4 1
#endif
#ifndef EN_KV
#define EN_KV 1
#endif
#ifndef REP_PRO
#define REP_PRO 1
#endif
#ifndef REP_MIX
#define REP_MIX 1
#endif
#ifndef REP_ATT
#define REP_ATT 1
#endif
#ifndef REP_Q
#define REP_Q 1
#endif
#ifndef REP_UP
#define REP_UP 1
#endif
#ifndef EN_MUP
#define EN_MUP 1
#endif
#ifndef EN_MDN
#define EN_MDN 1
#endif
#ifndef EN_MIX
#define EN_MIX 1
#endif
#ifndef EN_ATT
#define EN_ATT 1
#endif
#ifndef EN_MOE
#define EN_MOE 1
#endif
#ifndef EN_ROUTE
#define EN_ROUTE 1
#endif
#define LAS __attribute__((address_space(3)))
#define GAS __attribute__((address_space(1)))
typedef unsigned short bf16;
typedef short bf16x8 __attribute__((ext_vector_type(8)));
typedef float f32x2 __attribute__((ext_vector_type(2)));
typedef float f32x4 __attribute__((ext_vector_type(4)));
typedef float f32x16 __attribute__((ext_vector_type(16)));
typedef unsigned u32x2 __attribute__((ext_vector_type(2)));
typedef unsigned u32x4 __attribute__((ext_vector_type(4)));
typedef __bf16 bf16x2_t __attribute__((ext_vector_type(2)));
typedef int i32x4 __attribute__((ext_vector_type(4)));
typedef int i32x8 __attribute__((ext_vector_type(8)));
typedef unsigned long long u64;
typedef unsigned long long u64x2 __attribute__((ext_vector_type(2)));

constexpr int NB = 8, SEQ = 4096, D = 1024, T = NB * SEQ, DIN = 1792, DFF = 2816, NE = 8, MEMLEN = 256, MROWS = NB * MEMLEN;
constexpr float EPS = 1e-6f;
constexpr float S8_UP = 32.0f, S8_DN = 64.0f;
constexpr int NWAVES = 8, NTHREADS = 512;
constexpr int NPH = 22;

constexpr size_t MiB = 1u << 20;
constexpr size_t CTL_ZERO_BYTES = 2 * MiB;
constexpr int CW_BAR = 4096;
constexpr size_t OFF_ROWSS = 64 * 1024;
constexpr size_t OFF_MOECNT = 32 * 1024;
constexpr size_t OFF_MEMSS = 40 * 1024;
constexpr size_t WS_WIN = 2 * MiB;
constexpr size_t WS_WOUT = 9 * MiB;
constexpr size_t WS_WQ = 13 * MiB;
constexpr size_t WS_WO = 17 * MiB;
constexpr size_t WS_WK = 21 * MiB;
constexpr size_t WS_WV = 25 * MiB;
constexpr size_t WS_WGU = 29 * MiB;
constexpr size_t WS_WD = 40 * MiB;
constexpr size_t WS_MWGU = 46 * MiB;
constexpr size_t WS_MWD = 134 * MiB;
constexpr size_t WS_SGUW = 178 * MiB;
constexpr size_t WS_POOLW = 178 * MiB + 512 * 1024;
constexpr size_t WS_XB = 180 * MiB;
constexpr size_t WS_MEMB = 244 * MiB;
constexpr size_t WS_KB = 248 * MiB;
constexpr size_t WS_VT = 256 * MiB;
constexpr size_t WS_ROUTE = 264 * MiB;
constexpr int PERMROWS = 136 * 256;
constexpr size_t WS_ACT = 266 * MiB;
constexpr size_t WS_Z = WS_ACT;
constexpr size_t WS_MIXED = WS_ACT + 112 * MiB;
constexpr size_t WS_Q = WS_ACT;
constexpr size_t WS_O = WS_ACT + 64 * MiB;
constexpr size_t WS_H = WS_ACT;
constexpr size_t WS_END = 512 * MiB;
static_assert(WS_H + (size_t)PERMROWS * DFF * 2 <= WS_END, "ws map");

constexpr int LDS_BYTES = 160 * 1024;
constexpr int MISC_OFF = LDS_BYTES - 256;

__device__ __forceinline__ float bf_lo(unsigned v) { return __uint_as_float(v << 16); }
__device__ __forceinline__ float bf_hi(unsigned v) { return __uint_as_float(v & 0xffff0000u); }
__device__ __forceinline__ unsigned pk_bf16(float lo, float hi) { f32x2 v = {lo, hi}; bf16x2_t b = __builtin_convertvector(v, bf16x2_t); return __builtin_bit_cast(unsigned, b); }
__device__ __forceinline__ bf16 f2bf(float f) { return (bf16)(pk_bf16(f, 0.f) & 0xffffu); }
__device__ __forceinline__ float sigm(float x) { return __builtin_amdgcn_rcpf(1.0f + __expf(-x)); }
__device__ __forceinline__ float silu_f(float x) { return x * sigm(x); }
__device__ __forceinline__ float gelu_tanh(float x) { const float y = 0.7978845608028654f * (x + 0.044715f * x * x * x); return x * sigm(2.0f * y); }
constexpr float SS_FIX = 16777216.0f;
__device__ __forceinline__ u64 ss_to_fix(float ss) { return (u64)(ss * SS_FIX); }
__device__ __forceinline__ float rstd_ss(u64 ssf) { return __builtin_amdgcn_rsqf((float)ssf * (1.0f / (1024.0f * SS_FIX)) + EPS); }
__device__ __forceinline__ unsigned pk_fp8x4(float a, float b, float c, float d) { int p = __builtin_amdgcn_cvt_pk_fp8_f32(a, b, 0, false); p = __builtin_amdgcn_cvt_pk_fp8_f32(c, d, p, true); return (unsigned)p; }
__device__ __forceinline__ int lane_id() { int l; asm volatile("v_mbcnt_lo_u32_b32 %0, -1, 0\n\tv_mbcnt_hi_u32_b32 %0, -1, %0" : "=v"(l)); return l; }
__device__ __forceinline__ float shfl_xor_f(float v, int mask) { const int idx = (lane_id() ^ mask) << 2; return __builtin_bit_cast(float, __builtin_amdgcn_ds_bpermute(idx, __builtin_bit_cast(int, v))); }
#define OPAQUE(x) asm volatile("" : "+v"(x))
template <int CTRL> __device__ __forceinline__ float dpp_f(float v) { return __builtin_bit_cast(float, __builtin_amdgcn_update_dpp(0, __builtin_bit_cast(int, v), CTRL, 0xf, 0xf, true)); }
__device__ __forceinline__ float row16_sum(float v) { v += dpp_f<0xB1>(v); v += dpp_f<0x4E>(v); v += dpp_f<0x141>(v); v += dpp_f<0x140>(v); return v; }
__device__ __forceinline__ float wave_sum(float v) { v = row16_sum(v); v += shfl_xor_f(v, 16); v += shfl_xor_f(v, 32); return v; }

namespace pg8 {
__device__ __forceinline__ void glds_s(const void* sbase, unsigned voff, unsigned lds_dst) {
    asm volatile("s_mov_b32 m0, %2\n\ts_nop 0\n\tglobal_load_lds_dwordx4 %0, %1" : : "v"(voff), "s"(sbase), "s"(lds_dst) : "memory", "m0");
}
constexpr int BM = 256, BK = 64, HALF = 128, HTB = HALF * BK * 2, STAGE_BYTES = 8 * HTB, NXCD = 8, WGM = 8;
__host__ __device__ __forceinline__ int lds_byte(int r, int c) { const int st = (r >> 4) * 2 + (c >> 5), rr = r & 15, cc = c & 31, ob = rr * 64 + cc * 2; return st * 1024 + (ob ^ (((ob >> 9) & 1) << 5)); }
__host__ __device__ __forceinline__ void stage_rc(int b, int& R, int& C) { const int st = b / 1024, sb = b % 1024, swz = sb ^ (((sb >> 9) & 1) << 5); R = (st >> 1) * 16 + swz / 64; C = (st & 1) * 32 + (swz % 64) / 2; }
__host__ __device__ __forceinline__ int perm32(int rho) { const int n = rho >> 4, i = rho & 15; return 8 * (i >> 2) + 4 * n + (i & 3); }

struct Unit { int pm, pn, brow; };
struct Gemm { const bf16* A; const bf16* Bt; const int* perm; int M, N, K; };

struct StaticOrder {
    int nM, nN, nwg, G, c;
    __device__ void init(int M, int N, int G_, int c_) { nM = M / BM; nN = N / BM; nwg = nM * nN; G = G_; c = c_; }
    __device__ bool next(int i, Unit& u) const {
        const long L = (long)i * G + c; if (L >= nwg) return false;
        int wgid = (int)L; { const int q = nwg / NXCD, r = nwg % NXCD, xcd = wgid % NXCD, off = wgid / NXCD; wgid = (xcd < r ? xcd * (q + 1) : r * (q + 1) + (xcd - r) * q) + off; }
        const int nig = WGM * nN, gid = wgid / nig, fm = gid * WGM, gsz = (nM - fm) < WGM ? (nM - fm) : WGM;
        u.pm = fm + ((wgid % nig) % gsz); u.pn = (wgid % nig) / gsz; u.brow = u.pn; return true;
    }
};
struct MoeOrder {
    int nN, G, c; int tp[9];
    __device__ bool next(int i, Unit& u) const {
        const int L = i * G + c; if (L >= tp[8] * nN) return false;
        int e = 0;
#pragma unroll
        for (int j = 1; j < 8; ++j) e += (L >= tp[j] * nN) ? 1 : 0;
        int base = 0, nx = 0;
#pragma unroll
        for (int j = 0; j < 8; ++j) if (e == j) { base = tp[j]; nx = tp[j + 1]; }
        const int te = nx - base, Lp = L - base * nN; u.pn = Lp / te; u.pm = base + Lp % te; u.brow = e * nN + u.pn; return true;
    }
};

typedef f32x4 Acc[2][2][4][2];

template <bool DIRECT> struct EpiRowScale {
    static constexpr bool PERM = true;
    bf16* O; int ldc; const void* rs; float cst;
    __device__ __forceinline__ void operator()(const Acc& acc, const Unit& u, int wr, int wc, int fr, int fq) const {
        { const int ln = lane_id(); fr = ln & 15; fq = ln >> 4; }
        const int row0 = u.pm * BM + wr * 64 + fr, col0 = u.pn * BM + wc * 32 + 8 * fq;
#pragma unroll
        for (int ai = 0; ai < 2; ++ai)
#pragma unroll
            for (int m = 0; m < 4; ++m) { const int row = row0 + ai * HALF + m * 16; const float sc = (DIRECT ? ((const float*)rs)[row] : rstd_ss(((const u64*)rs)[row])) * cst;
                bf16* rowp = O + (size_t)row * ldc + col0;
#pragma unroll
                for (int bj = 0; bj < 2; ++bj) { const f32x4 v0 = acc[ai][bj][m][0] * sc, v1 = acc[ai][bj][m][1] * sc;
                    u32x4 w; w.x = pk_bf16(v0[0], v0[1]); w.y = pk_bf16(v0[2], v0[3]); w.z = pk_bf16(v1[0], v1[1]); w.w = pk_bf16(v1[2], v1[3]);
                    *(u32x4*)(rowp + bj * HALF) = w; } }
    }
};
struct EpiColScale {
    static constexpr bool PERM = true;
    bf16* O; int ldc; const u64* css;
    __device__ __forceinline__ void operator()(const Acc& acc, const Unit& u, int wr, int wc, int fr, int fq) const {
        { const int ln = lane_id(); fr = ln & 15; fq = ln >> 4; }
        const int row0 = u.pm * BM + wr * 64 + fr, col0 = u.pn * BM + wc * 32 + 8 * fq;
#pragma unroll
        for (int bj = 0; bj < 2; ++bj) {
            const u64* cp = css + col0 + bj * HALF;
            const f32x4 c0 = (f32x4){rstd_ss(cp[0]), rstd_ss(cp[1]), rstd_ss(cp[2]), rstd_ss(cp[3])}, c1 = (f32x4){rstd_ss(cp[4]), rstd_ss(cp[5]), rstd_ss(cp[6]), rstd_ss(cp[7])};
#pragma unroll
            for (int ai = 0; ai < 2; ++ai)
#pragma unroll
                for (int m = 0; m < 4; ++m) { bf16* rowp = O + (size_t)(row0 + ai * HALF + m * 16) * ldc + col0 + bj * HALF;
                    const f32x4 v0 = acc[ai][bj][m][0] * c0, v1 = acc[ai][bj][m][1] * c1;
                    u32x4 w; w.x = pk_bf16(v0[0], v0[1]); w.y = pk_bf16(v0[2], v0[3]); w.z = pk_bf16(v1[0], v1[1]); w.w = pk_bf16(v1[2], v1[3]);
                    *(u32x4*)rowp = w; }
            asm volatile("" ::: "memory"); }
    }
};
template <bool DIRECT> struct EpiSwiglu {
    static constexpr bool PERM = true;
    bf16* O; int ldc; const void* rs;
    __device__ __forceinline__ void operator()(const Acc& acc, const Unit& u, int wr, int wc, int fr, int fq) const {
        { const int ln = lane_id(); fr = ln & 15; fq = ln >> 4; }
        const int row0 = u.pm * BM + wr * 64 + fr, col0 = u.pn * HALF + wc * 32 + 8 * fq;
#pragma unroll
        for (int ai = 0; ai < 2; ++ai)
#pragma unroll
            for (int m = 0; m < 4; ++m) { const int row = row0 + ai * HALF + m * 16; const float sc = DIRECT ? ((const float*)rs)[row] : rstd_ss(((const u64*)rs)[row]);
                u32x4 w;
#pragma unroll
                for (int n = 0; n < 2; ++n) { const f32x4 g = acc[ai][0][m][n] * sc, uu = acc[ai][1][m][n] * sc;
                    const float o0 = silu_f(g[0]) * uu[0], o1 = silu_f(g[1]) * uu[1], o2 = silu_f(g[2]) * uu[2], o3 = silu_f(g[3]) * uu[3];
                    w[2 * n] = pk_bf16(o0, o1); w[2 * n + 1] = pk_bf16(o2, o3); }
                *(u32x4*)(O + (size_t)row * ldc + col0) = w;
                asm volatile("" ::: "memory"); }
    }
};
struct EpiSwiglu8 {
    static constexpr bool PERM = true;
    unsigned char* O; int ldc; const float* rs;
    __device__ __forceinline__ void operator()(const Acc& acc, const Unit& u, int wr, int wc, int fr, int fq) const {
        { const int ln = lane_id(); fr = ln & 15; fq = ln >> 4; }
        const int row0 = u.pm * BM + wr * 64 + fr, col0 = u.pn * HALF + wc * 32 + 8 * fq;
#pragma unroll
        for (int ai = 0; ai < 2; ++ai)
#pragma unroll
            for (int m = 0; m < 4; ++m) { const int row = row0 + ai * HALF + m * 16; const float sc = rs[row] * (1.0f / S8_UP);
                u32x2 w;
#pragma unroll
                for (int n = 0; n < 2; ++n) { const f32x4 g = acc[ai][0][m][n] * sc, uu = acc[ai][1][m][n] * sc;
                    w[n] = pk_fp8x4(silu_f(g[0]) * uu[0], silu_f(g[1]) * uu[1], silu_f(g[2]) * uu[2], silu_f(g[3]) * uu[3]); }
                *(u32x2*)(O + (size_t)row * ldc + col0) = w;
                asm volatile("" ::: "memory"); }
    }
};
template <bool SCATTER, bool WRITE_XB, bool ACC_SS> struct EpiResid {
    static constexpr bool PERM = true;
    float* X; bf16* XB; u64* ss_out; const int* perm; const float* gp; float gscale; bool xb8;
    __device__ __forceinline__ void operator()(const Acc& acc, const Unit& u, int wr, int wc, int fr, int fq) const {
        { const int ln = lane_id(); fr = ln & 15; fq = ln >> 4; }
        const int row0 = u.pm * BM + wr * 64 + fr, col0 = u.pn * BM + wc * 32 + 8 * fq;
#pragma unroll
        for (int ai = 0; ai < 2; ++ai)
#pragma unroll
            for (int m = 0; m < 4; ++m) { int row = row0 + ai * HALF + m * 16; float gate = 1.0f; bool valid = true;
                if (SCATTER) { const int tok = perm[row]; gate = gp[row] * gscale; valid = tok >= 0; row = valid ? tok : 0; }
                float ss = 0.f;
                if (valid) {
#pragma unroll
                    for (int bj = 0; bj < 2; ++bj) { float* xp = X + (size_t)row * D + col0 + bj * HALF;
                        f32x4 n0 = *(const f32x4*)xp, n1 = *(const f32x4*)(xp + 4);
                        n0 += acc[ai][bj][m][0] * gate; n1 += acc[ai][bj][m][1] * gate;
                        *(f32x4*)xp = n0; *(f32x4*)(xp + 4) = n1;
                        if (WRITE_XB) {
                            if (xb8) { u32x2 w; w.x = pk_fp8x4(n0[0], n0[1], n0[2], n0[3]); w.y = pk_fp8x4(n1[0], n1[1], n1[2], n1[3]); *(u32x2*)((unsigned char*)XB + (size_t)row * D + col0 + bj * HALF) = w; }
                            else { u32x4 w; w.x = pk_bf16(n0[0], n0[1]); w.y = pk_bf16(n0[2], n0[3]); w.z = pk_bf16(n1[0], n1[1]); w.w = pk_bf16(n1[2], n1[3]);
                                *(u32x4*)(XB + (size_t)row * D + col0 + bj * HALF) = w; } }
                        if (ACC_SS) ss += (n0[0] * n0[0] + n0[1] * n0[1]) + (n0[2] * n0[2] + n0[3] * n0[3]) + (n1[0] * n1[0] + n1[1] * n1[1]) + (n1[2] * n1[2] + n1[3] * n1[3]);
                        asm volatile("" ::: "memory"); }
                }
                if (ACC_SS) { ss += shfl_xor_f(ss, 16); ss += shfl_xor_f(ss, 32);
                    if (fq == 0 && valid && ss_out) (void)__hip_atomic_fetch_add(ss_out + row, ss_to_fix(ss), __ATOMIC_RELAXED, __HIP_MEMORY_SCOPE_AGENT); }
                asm volatile("" ::: "memory"); }
    }
};

__device__ __forceinline__ void load_offs(const Gemm& g, const Unit& u, const int (&Rr)[2], const int (&Cc)[2], unsigned (&o)[2][2]) {
#pragma unroll
    for (int h = 0; h < 2; ++h)
#pragma unroll
        for (int i = 0; i < 2; ++i) { int row = g.perm[u.pm * BM + h * HALF + Rr[i]]; row = row < 0 ? 0 : row; o[h][i] = (unsigned)(row * g.K + Cc[i]) * 2u; }
}

template <class Epi, class Sched, bool ALIGN_EPI, bool GATHER, bool FP8 = false>
__device__ __forceinline__ void gemm_phase(LAS unsigned char* lds, const Gemm g, const Sched& S, const Epi& E, int wave_id) {
    int tid_ = wave_id * 64 + lane_id(); asm volatile("" : "+v"(tid_));
    const int tid = tid_, wid = __builtin_amdgcn_readfirstlane(tid >> 6), lane = tid & 63, wr = wid >> 2, wc = wid & 3, fr = lane & 15, fq = lane >> 4;
    const int K = g.K, nt = K / BK;
    int Rr[2], Cc[2]; unsigned voffA[2], voffB[2];
#pragma unroll
    for (int i = 0; i < 2; ++i) { int R, C; stage_rc(tid * 16 + i * 8192, R, C); Rr[i] = R; Cc[i] = C; const int Rb = Epi::PERM ? ((R & ~31) + perm32(R & 31)) : R;
        voffA[i] = (unsigned)(R * K + C) * 2u; voffB[i] = (unsigned)(Rb * K + C) * 2u; }
    const size_t kstep = (size_t)(BK * 2);
    const size_t hstep = (size_t)HALF * K * 2;
    const size_t tstep = 2 * hstep;
    const unsigned ldsw = (unsigned)wid * 1024u, ldsbase = (unsigned)(size_t)lds;
    const int aoff = lds_byte(wr * 64 + fr, fq * 8), boff = lds_byte(wc * 32 + fr, fq * 8);
#define PG8_SA(b, h) (((b) * 2 + (h)) * HTB)
#define PG8_SB(b, h) ((4 + (b) * 2 + (h)) * HTB)
#define PG8_STAGE(bufoff, gbase, voff) do { _Pragma("unroll") for (int _i = 0; _i < 2; ++_i) glds_s((const void*)(gbase), (voff)[_i], ldsbase + (unsigned)(bufoff) + ldsw + _i * 8192u); } while (0)
#define PG8_STAGE_A(bufoff, gbase, h) do { if constexpr (GATHER) PG8_STAGE(bufoff, gbase, offA[h]); else PG8_STAGE(bufoff, (gbase) + (h) * hstep, voffA); } while (0)
#define PG8_LDA(dst, b, h) do { _Pragma("unroll") for (int m = 0; m < 4; ++m) _Pragma("unroll") for (int k = 0; k < 2; ++k) dst[m][k] = *(const LAS bf16x8*)(lds + PG8_SA(b, h) + aoff + m * 2048 + k * 1024); } while (0)
#define PG8_LDB(dst, b, h) do { _Pragma("unroll") for (int n = 0; n < 2; ++n) _Pragma("unroll") for (int k = 0; k < 2; ++k) dst[n][k] = *(const LAS bf16x8*)(lds + PG8_SB(b, h) + boff + n * 2048 + k * 1024); } while (0)
#define PG8_CAT8(x) __builtin_shufflevector(__builtin_bit_cast(i32x4, (x)[0]), __builtin_bit_cast(i32x4, (x)[1]), 0, 1, 2, 3, 4, 5, 6, 7)
#define PG8_MMA(ai, bj, At, Bt) do { __builtin_amdgcn_s_setprio(1); \
        if constexpr (FP8) { _Pragma("unroll") for (int m = 0; m < 4; ++m) _Pragma("unroll") for (int n = 0; n < 2; ++n) \
            acc[ai][bj][m][n] = __builtin_amdgcn_mfma_scale_f32_16x16x128_f8f6f4(PG8_CAT8(Bt[n]), PG8_CAT8(At[m]), acc[ai][bj][m][n], 0, 0, 0, 0x7F7F7F7F, 0, 0x7F7F7F7F); } \
        else { _Pragma("unroll") for (int m = 0; m < 4; ++m) _Pragma("unroll") for (int n = 0; n < 2; ++n) _Pragma("unroll") for (int k = 0; k < 2; ++k) \
            acc[ai][bj][m][n] = __builtin_amdgcn_mfma_f32_16x16x32_bf16(Bt[n][k], At[m][k], acc[ai][bj][m][n], 0, 0, 0); } \
        __builtin_amdgcn_s_setprio(0); } while (0)
#define PG8_WAIT_V(n) asm volatile("s_waitcnt vmcnt(" #n ")" ::: "memory")
#define PG8_WAIT_L(n) asm volatile("s_waitcnt lgkmcnt(" #n ")" ::: "memory")
#define PG8_BAR __builtin_amdgcn_s_barrier()
#define PG8_SCHED __builtin_amdgcn_sched_barrier(0)
    Unit cur, nxt; int ui = 0;
    if (!S.next(0, cur)) return;
    Acc acc;
#pragma unroll
    for (int a = 0; a < 2; ++a)
#pragma unroll
        for (int b = 0; b < 2; ++b)
#pragma unroll
            for (int m = 0; m < 4; ++m)
#pragma unroll
                for (int n = 0; n < 2; ++n) acc[a][b][m][n] = (f32x4){0.f, 0.f, 0.f, 0.f};
    bf16x8 At[4][2], B0[2][2], B1[2][2];
    unsigned offA[2][2], offN[2][2];
    if constexpr (GATHER) load_offs(g, cur, Rr, Cc, offA);
    const char* cA = GATHER ? (const char*)g.A : (const char*)g.A + (size_t)cur.pm * tstep; const char* cB = (const char*)g.Bt + (size_t)cur.brow * tstep;
    PG8_STAGE(PG8_SB(0, 0), cB, voffB); PG8_STAGE(PG8_SB(0, 1), cB + hstep, voffB); PG8_STAGE_A(PG8_SA(0, 0), cA, 0); PG8_STAGE_A(PG8_SA(0, 1), cA, 1);
    if (wr == 1) PG8_BAR;
    PG8_WAIT_V(2); PG8_BAR;
    PG8_STAGE(PG8_SB(1, 0), cB + kstep, voffB); PG8_STAGE_A(PG8_SA(1, 0), cA + kstep, 0); PG8_STAGE(PG8_SB(1, 1), cB + hstep + kstep, voffB);
    PG8_WAIT_V(6); PG8_BAR;
    for (;;) {
        const bool has_next = S.next(ui + 1, nxt);
        if constexpr (GATHER) { if (has_next) load_offs(g, nxt, Rr, Cc, offN); else {
#pragma unroll
            for (int h = 0; h < 2; ++h)
#pragma unroll
                for (int i = 0; i < 2; ++i) offN[h][i] = offA[h][i]; } }
        const char* nA = has_next ? (GATHER ? (const char*)g.A : (const char*)g.A + (size_t)nxt.pm * tstep) : cA; const char* nB = has_next ? (const char*)g.Bt + (size_t)nxt.brow * tstep : cB;
        for (int t = 0; t < nt; t += 2) {
            const bool last = (t == nt - 2);
            const char* a1 = cA + (size_t)(t + 1) * kstep;
            const char* a2 = last ? nA : cA + (size_t)(t + 2) * kstep; const char* b2 = last ? nB : cB + (size_t)(t + 2) * kstep;
            const char* a3 = a2 + kstep; const char* b3 = b2 + kstep;
            PG8_LDB(B0, 0, 0); PG8_LDB(B1, 0, 1); PG8_SCHED; PG8_LDA(At, 0, 0); PG8_STAGE_A(PG8_SA(1, 1), a1, 1);
            if constexpr (GATHER) { if (last) {
#pragma unroll
                for (int h = 0; h < 2; ++h)
#pragma unroll
                    for (int i = 0; i < 2; ++i) offA[h][i] = offN[h][i]; } }
            PG8_WAIT_V(8); PG8_WAIT_L(0); PG8_BAR; PG8_MMA(0, 0, At, B0); PG8_MMA(0, 1, At, B1); PG8_BAR; PG8_SCHED;
            PG8_LDA(At, 0, 1); PG8_STAGE(PG8_SB(0, 0), b2, voffB); PG8_STAGE(PG8_SB(0, 1), b2 + hstep, voffB); PG8_STAGE_A(PG8_SA(0, 0), a2, 0);
            PG8_WAIT_V(8); PG8_WAIT_L(0); PG8_BAR; PG8_MMA(1, 0, At, B0); PG8_MMA(1, 1, At, B1); PG8_BAR; PG8_SCHED;
            PG8_LDB(B0, 1, 0); PG8_LDB(B1, 1, 1); PG8_SCHED; PG8_LDA(At, 1, 0); PG8_STAGE_A(PG8_SA(0, 1), a2, 1);
            PG8_WAIT_V(8); PG8_WAIT_L(0); PG8_BAR; PG8_MMA(0, 0, At, B0); PG8_MMA(0, 1, At, B1); PG8_BAR; PG8_SCHED;
            PG8_LDA(At, 1, 1); PG8_STAGE(PG8_SB(1, 0), b3, voffB); PG8_STAGE(PG8_SB(1, 1), b3 + hstep, voffB); PG8_STAGE_A(PG8_SA(1, 0), a3, 0);
            PG8_WAIT_V(8); PG8_WAIT_L(0); PG8_BAR; PG8_MMA(1, 0, At, B0); PG8_MMA(1, 1, At, B1); PG8_BAR; PG8_SCHED;
        }
        if constexpr (ALIGN_EPI) { if (wr == 0) PG8_BAR; }
        E(acc, cur, wr, wc, fr, fq);
        if (!has_next) break;
#pragma unroll
        for (int a = 0; a < 2; ++a)
#pragma unroll
            for (int b = 0; b < 2; ++b)
#pragma unroll
                for (int m = 0; m < 4; ++m)
#pragma unroll
                    for (int n = 0; n < 2; ++n) acc[a][b][m][n] = (f32x4){0.f, 0.f, 0.f, 0.f};
        cur = nxt; cA = nA; cB = nB; ++ui;
        if constexpr (ALIGN_EPI) { if (wr == 1) PG8_BAR; }
    }
    PG8_WAIT_V(0);
    if constexpr (!ALIGN_EPI) { if (wr == 0) PG8_BAR; }
    PG8_BAR;
#undef PG8_SA
#undef PG8_SB
#undef PG8_STAGE
#undef PG8_STAGE_A
#undef PG8_LDA
#undef PG8_LDB
#undef PG8_MMA
#undef PG8_CAT8
#undef PG8_WAIT_V
#undef PG8_WAIT_L
#undef PG8_BAR
#undef PG8_SCHED
}
}

#define XB_TMO      128
#define XB_XCNT(j)  (256  + 64 * (j))
#define XB_XSUB(j)  (1280 + 64 * (j))
#define XB_XGEN(j)  (2304 + 64 * (j))
#define XB_TOP      3328
#define XB_TOPGEN   3392
#define XCD_BAR_WORDS 3456
#define XB_SPIN_CAP (1u << 18)
__device__ __forceinline__ unsigned xb_ld(unsigned* p)              { return __hip_atomic_load(p, __ATOMIC_RELAXED, __HIP_MEMORY_SCOPE_AGENT); }
__device__ __forceinline__ unsigned xb_add(unsigned* p, unsigned v) { return __hip_atomic_fetch_add(p, v, __ATOMIC_RELAXED, __HIP_MEMORY_SCOPE_AGENT); }
__device__ __forceinline__ unsigned xb_xcc_id() { return (unsigned)__builtin_amdgcn_s_getreg((3 << 11) | 20) & 0xFu; }
#define XB_SPIN(cond, bar) do { unsigned _sp = 0; while (cond) { __builtin_amdgcn_s_sleep(1); \
    if ((++_sp & 255u) == 0u) { if (xb_ld(&(bar)[XB_TMO])) break; if (_sp > XB_SPIN_CAP) { atomicAdd(&(bar)[XB_TMO], 1u); break; } } } } while (0)
struct XcdBarrier { unsigned* bar; unsigned x; volatile LAS unsigned* st; };
__device__ __forceinline__ XcdBarrier xcd_barrier_post(unsigned* bar, volatile LAS unsigned* st) {
    XcdBarrier b; b.bar = bar; b.x = xb_xcc_id(); b.st = st;
    if (threadIdx.x == 0) (void)xb_add(&bar[XB_XCNT(b.x)], 1u);
    return b;
}
__device__ __forceinline__ void xcd_barrier_complete(unsigned* bar, unsigned x, unsigned& nloc, unsigned& nx) {
    const unsigned G = gridDim.x * gridDim.y * gridDim.z;
    unsigned sum, cnt, mine, sp = 0u;
    for (;;) {
        sum = 0u; cnt = 0u; mine = 0u;
#pragma unroll
        for (unsigned j = 0; j < 16; ++j) { const unsigned c = xb_ld(&bar[XB_XCNT(j)]); sum += c; cnt += (c > 0u) ? 1u : 0u; mine = (j == x) ? c : mine; }
        if (sum == G) break;
        __builtin_amdgcn_s_sleep(1);
        if ((++sp & 255u) == 0u) { if (xb_ld(&bar[XB_TMO])) break; if (sp > XB_SPIN_CAP) { atomicAdd(&bar[XB_TMO], 1u); break; } }
    }
    nloc = mine > 0u ? mine : 1u; nx = cnt > 0u ? cnt : 1u;
}
__device__ __forceinline__ void xcd_barrier(const XcdBarrier& b) {
    asm volatile("s_waitcnt vmcnt(0)" ::: "memory");
    __syncthreads();
    if (threadIdx.x == 0) {
        unsigned* bar = b.bar;
        __builtin_amdgcn_s_waitcnt(0);
        unsigned nloc = b.st[0], nx = b.st[1];
        if (nloc == 0u) { xcd_barrier_complete(bar, b.x, nloc, nx); b.st[0] = nloc; b.st[1] = nx; }
        const unsigned old = xb_add(&bar[XB_XSUB(b.x)], 1u);
        const unsigned gen = old / nloc;
        if (old + 1u == (gen + 1u) * nloc) {
            __builtin_amdgcn_fence(__ATOMIC_RELEASE, "agent");
            asm volatile("s_waitcnt vmcnt(0)" ::: "memory");
            const unsigned og = xb_add(&bar[XB_TOP], 1u);
            const unsigned tg = og / nx;
            if (og + 1u == (tg + 1u) * nx) xb_add(&bar[XB_TOPGEN], 1u);
            else XB_SPIN(xb_ld(&bar[XB_TOPGEN]) == tg, bar);
            __builtin_amdgcn_fence(__ATOMIC_ACQUIRE, "agent");
            xb_add(&bar[XB_XGEN(b.x)], 1u);
            asm volatile("s_waitcnt vmcnt(0)" ::: "memory");
        } else {
            XB_SPIN(xb_ld(&bar[XB_XGEN(b.x)]) == gen, bar);
            __builtin_amdgcn_fence(__ATOMIC_ACQUIRE, "agent");
            asm volatile("s_waitcnt vmcnt(0)" ::: "memory");
        }
    }
    __syncthreads();
}

struct Args { const float* in[31]; float* out; unsigned char* ws; int ph_lo, ph_hi; };
typedef const __attribute__((address_space(4))) Args* ArgsP;

__device__ __forceinline__ void cvt_item(const float* W, int N, const float* gain, bf16* WT, int Kd, int k0, int n0, int drow0, LAS float* scr, int lane) {
#pragma unroll 8
    for (int i = 0; i < 32; ++i) { const int kk = 2 * i + (lane >> 5); float v = W[(size_t)(k0 + kk) * N + n0 + (lane & 31)]; if (gain) v *= gain[k0 + kk]; scr[kk * 33 + (lane & 31)] = v; }
    asm volatile("s_waitcnt lgkmcnt(0)" ::: "memory");
    const int c = lane & 7;
#pragma unroll
    for (int j = 0; j < 4; ++j) { const int n = (lane >> 3) + 8 * j; const LAS float* s = scr + (8 * c) * 33 + n;
        u32x4 o; o.x = pk_bf16(s[0 * 33], s[1 * 33]); o.y = pk_bf16(s[2 * 33], s[3 * 33]); o.z = pk_bf16(s[4 * 33], s[5 * 33]); o.w = pk_bf16(s[6 * 33], s[7 * 33]);
        *(u32x4*)(WT + (size_t)(drow0 + n) * Kd + k0 + 8 * c) = o; }
    asm volatile("s_waitcnt lgkmcnt(0)" ::: "memory");
}

__device__ __forceinline__ void cvt_item8(const float* W, int N, const float* gain, unsigned char* WT, int Kd, int k0, int n0, int drow0, LAS float* scr, int lane, float qs) {
#pragma unroll 8
    for (int i = 0; i < 32; ++i) { const int kk = 2 * i + (lane >> 5); float v = W[(size_t)(k0 + kk) * N + n0 + (lane & 31)] * qs; if (gain) v *= gain[k0 + kk]; scr[kk * 33 + (lane & 31)] = v; }
    asm volatile("s_waitcnt lgkmcnt(0)" ::: "memory");
    const int c = lane & 3;
#pragma unroll
    for (int j = 0; j < 2; ++j) { const int n = (lane >> 2) + 16 * j; const LAS float* s = scr + (16 * c) * 33 + n;
        u32x4 o; o.x = pk_fp8x4(s[0 * 33], s[1 * 33], s[2 * 33], s[3 * 33]); o.y = pk_fp8x4(s[4 * 33], s[5 * 33], s[6 * 33], s[7 * 33]);
        o.z = pk_fp8x4(s[8 * 33], s[9 * 33], s[10 * 33], s[11 * 33]); o.w = pk_fp8x4(s[12 * 33], s[13 * 33], s[14 * 33], s[15 * 33]);
        *(u32x4*)(WT + (size_t)(drow0 + n) * Kd + k0 + 16 * c) = o; }
    asm volatile("s_waitcnt lgkmcnt(0)" ::: "memory");
}

__device__ __forceinline__ void phase_prologue(ArgsP a, LAS unsigned char* lds, int vcu, int G, int tid, int lane, int wave) {
    unsigned char* ws = a->ws;
    LAS float* scr = (LAS float*)(lds + wave * 16384);
    const int gw = vcu * NWAVES + wave, NGW = G * NWAVES;
    constexpr int I_IN = 16 * 56, I_SQ = 16 * 32, I_UP = 16 * 88, I_DN = 44 * 32, I_LAYER = I_IN + 5 * I_SQ, I_FFN = 2 * I_UP + I_DN;
    constexpr int NITEMS = 2 * I_LAYER + 9 * I_FFN;
    for (int it0 = gw; it0 < NITEMS; it0 += NGW) {
        int it = it0; const float* W; const float* gain = nullptr; bf16* WT; int N, Kd, k0, n0, drow0;
        if (it < 2 * I_LAYER) {
            const int l = it / I_LAYER; int r = it - l * I_LAYER;
            if (r < I_IN) { W = a->in[3] + (size_t)l * D * DIN; N = DIN; gain = a->in[2] + l * D; WT = (bf16*)(ws + WS_WIN) + (size_t)l * DIN * D; Kd = D; k0 = 64 * (r / 56); n0 = 32 * (r % 56); drow0 = n0; }
            else { r -= I_IN; const int m = r / I_SQ; r -= m * I_SQ; N = D; Kd = D; k0 = 64 * (r / 32); n0 = 32 * (r % 32); drow0 = n0;
                if (m == 0)      { W = a->in[15] + (size_t)l * D * D; WT = (bf16*)(ws + WS_WOUT) + (size_t)l * D * D; }
                else if (m == 1) { W = a->in[18] + (size_t)l * D * D; gain = a->in[16] + l * D; WT = (bf16*)(ws + WS_WQ) + (size_t)l * D * D; }
                else if (m == 2) { W = a->in[19] + (size_t)l * D * D; gain = a->in[17] + l * D; WT = (bf16*)(ws + WS_WK) + (size_t)l * D * D; }
                else if (m == 3) { W = a->in[20] + (size_t)l * D * D; gain = a->in[17] + l * D; WT = (bf16*)(ws + WS_WV) + (size_t)l * D * D; }
                else             { W = a->in[21] + (size_t)l * D * D; WT = (bf16*)(ws + WS_WO) + (size_t)l * D * D; } }
        } else {
            it -= 2 * I_LAYER; const int ex = it / I_FFN; int r = it - ex * I_FFN;
            const float *wg, *wu, *wd, *gn;
            if (ex == 0) { wg = a->in[23]; wu = a->in[24]; wd = a->in[25]; gn = a->in[22]; }
            else { const size_t e = ex - 1; wg = a->in[27] + e * D * DFF; wu = a->in[28] + e * D * DFF; wd = a->in[29] + e * DFF * D; gn = a->in[22] + D; }
            const bool up = r < 2 * I_UP; int isu = 0;
            if (up) { isu = r >= I_UP; r -= isu * I_UP; W = isu ? wu : wg; N = DFF; gain = gn; Kd = D; k0 = 64 * (r / 88); n0 = 32 * (r % 88); drow0 = (n0 >> 7) * 256 + (n0 & 127) + (isu ? 128 : 0); }
            else { r -= 2 * I_UP; W = wd; N = D; Kd = DFF; k0 = 64 * (r / 32); n0 = 32 * (r % 32); drow0 = n0; }
            if (ex == 0) WT = up ? (bf16*)(ws + WS_WGU) : (bf16*)(ws + WS_WD);
            else { const size_t e = ex - 1; unsigned char* w8 = up ? (ws + WS_MWGU) + e * 2 * DFF * D : (ws + WS_MWD) + e * D * DFF;
                cvt_item8(W, N, gain, w8, Kd, k0, n0, drow0, scr, lane, up ? S8_UP : S8_DN); continue; }
        }
        cvt_item(W, N, gain, WT, Kd, k0, n0, drow0, scr, lane);
    }
    const int gt = vcu * NTHREADS + tid, NGT = G * NTHREADS;
    for (int i = gt; i < 2 * 4 * 128 * 128; i += NGT) { const int ii = (i >> 7) & 127, jj = i & 127; const float v = a->in[10][i]; ((bf16*)(ws + WS_SGUW))[i] = f2bf(((ii >> 6) >= (jj >> 6)) ? v : 0.f); }
    for (int i = gt; i < 2 * 4 * 64 * 64; i += NGT) { const int lg = i >> 12, o = (i >> 6) & 63, ii = i & 63; ((bf16*)(ws + WS_POOLW))[i] = f2bf(a->in[12][(lg << 12) + ii * 64 + o]); }
    u64* rowss0 = (u64*)(ws + OFF_ROWSS);
    for (int m = gw; m < T + MROWS; m += NGW) {
        const bool isx = m < T; const int r = isx ? m : m - T;
        const f32x4* xr = (const f32x4*)((isx ? a->in[0] : a->in[1]) + (size_t)r * D) + lane;
        f32x4 v[4]; float s = 0.f;
#pragma unroll
        for (int j = 0; j < 4; ++j) { v[j] = xr[64 * j]; s += (v[j][0] * v[j][0] + v[j][1] * v[j][1]) + (v[j][2] * v[j][2] + v[j][3] * v[j][3]); }
        s = wave_sum(s);
        u32x2* o8 = (u32x2*)((isx ? (bf16*)(ws + WS_XB) : (bf16*)(ws + WS_MEMB)) + (size_t)r * D) + lane;
#pragma unroll
        for (int j = 0; j < 4; ++j) { u32x2 w; w.x = pk_bf16(v[j][0], v[j][1]); w.y = pk_bf16(v[j][2], v[j][3]); o8[64 * j] = w; }
        if (isx) { f32x4* xo = (f32x4*)(a->out + (size_t)r * D) + lane;
#pragma unroll
            for (int j = 0; j < 4; ++j) xo[64 * j] = v[j];
            if (lane == 0) rowss0[r] = ss_to_fix(s); }
        else if (lane == 0) ((u64*)(ws + OFF_MEMSS))[r] = ss_to_fix(s);
    }
}

__device__ __forceinline__ void mixer_unit(ArgsP a, LAS unsigned char* lds, int l, int u, int tid_in, int lane_in, int wave) {
    int tid = tid_in, lane = lane_in;
    const bf16* z = (const bf16*)(a->ws + WS_Z); bf16* mixed = (bf16*)(a->ws + WS_MIXED);
    const int b = u >> 5, c = u & 31, t0 = c * 128; const size_t R0 = (size_t)b * SEQ + t0;
    {
        const float* cw = a->in[4] + l * 31 * 384; const float* cb = a->in[5] + l * 384; const float* lg = a->in[6] + l * 384; const float* lb = a->in[7] + l * 384;
        for (int it = tid; it < 158 * 48; it += NTHREADS) { const int j = it / 48, v = it - j * 48; u32x4 o = {0u, 0u, 0u, 0u};
            if (t0 - 30 + j >= 0) { const bf16* rp = z + (R0 + j - 30) * DIN + 8 * v; const u32x4 av = *(const u32x4*)rp, gv = *(const u32x4*)(rp + 384);
#pragma unroll
                for (int q = 0; q < 4; ++q) o[q] = pk_bf16(bf_lo(av[q]) * sigm(bf_lo(gv[q])), bf_hi(av[q]) * sigm(bf_hi(gv[q]))); }
            *(LAS u32x4*)(lds + j * 768 + v * 16) = o; }
        __syncthreads();
        LAS float* part = (LAS float*)(lds + 122880);
        OPAQUE(tid); lane = tid & 63;
#pragma unroll 1
        for (int jt = 0; jt < 3; ++jt) { const int item = tid + NTHREADS * jt, rg = item / 192, p = item - rg * 192, q3 = p >> 6;
            f32x2 w[31];
#pragma unroll
            for (int k = 0; k < 31; ++k) w[k] = *(const f32x2*)(cw + k * 384 + 2 * p);
            const f32x2 bias = *(const f32x2*)(cb + 2 * p);
            float y0[16], y1[16];
#pragma unroll
            for (int i = 0; i < 16; ++i) { y0[i] = bias.x; y1[i] = bias.y; }
            const LAS unsigned* hp = (const LAS unsigned*)lds + (rg * 16) * 192 + p;
#pragma unroll
            for (int jj = 0; jj < 46; ++jj) { const unsigned hv = hp[jj * 192]; const float h0 = bf_lo(hv), h1 = bf_hi(hv);
#pragma unroll
                for (int i = 0; i < 16; ++i) { const int k = jj - i; if (k >= 0 && k <= 30) { y0[i] += w[k].x * h0; y1[i] += w[k].y * h1; } } }
#pragma unroll
            for (int i = 0; i < 16; ++i) { float s1 = y0[i] + y1[i], s2 = y0[i] * y0[i] + y1[i] * y1[i];
                s1 = wave_sum(s1); s2 = wave_sum(s2);
                if (lane == 0) { part[((rg * 16 + i) * 3 + q3) * 2] = s1; part[((rg * 16 + i) * 3 + q3) * 2 + 1] = s2; }
                *(unsigned*)(mixed + (R0 + rg * 16 + i) * D + 2 * p) = pk_bf16(y0[i], y1[i]); }
        }
        __syncthreads();
        OPAQUE(tid);
#pragma unroll 1
        for (int jt = 0; jt < 3; ++jt) { const int item = tid + NTHREADS * jt, rg = item / 192, p = item - rg * 192;
            const f32x2 g2 = *(const f32x2*)(lg + 2 * p), b2 = *(const f32x2*)(lb + 2 * p);
#pragma unroll
            for (int i = 0; i < 16; ++i) { const int row = rg * 16 + i; const LAS float* pr = part + row * 6;
                const float S1 = pr[0] + pr[2] + pr[4], S2 = pr[1] + pr[3] + pr[5];
                const float mean = S1 * (1.0f / 384.0f), var = S2 * (1.0f / 384.0f) - mean * mean, rstd = __builtin_amdgcn_rsqf(var + EPS);
                unsigned* mp = (unsigned*)(mixed + (R0 + row) * D + 2 * p); const unsigned yv = *mp;
                const float o0 = (bf_lo(yv) - mean) * rstd * g2.x + b2.x, o1 = (bf_hi(yv) - mean) * rstd * g2.y + b2.y;
                *mp = pk_bf16(silu_f(o0), silu_f(o1)); } }
    }
    {
        OPAQUE(tid); lane = tid & 63;
        const bf16* pwT = (const bf16*)(a->ws + WS_POOLW) + l * 4 * 64 * 64; const float* pb = a->in[13] + l * 256; const float* psc = a->in[14] + l * 256;
        for (int it = tid; it < 143 * 32; it += NTHREADS) { const int j = it >> 5, v = it & 31; u32x4 o = {0u, 0u, 0u, 0u};
            if (t0 - 15 + j >= 0) o = *(const u32x4*)(z + (R0 + j - 15) * DIN + 1536 + 8 * v);
            *(LAS u32x4*)(lds + j * 512 + v * 16) = o; }
        __syncthreads();
        OPAQUE(tid);
        { const int pp = tid & 127, rq = tid >> 7; const int w = 2 << (pp >> 5); const LAS unsigned* cp = (const LAS unsigned*)lds + pp; const int i0 = rq * 32;
            float s0 = 0.f, s1 = 0.f;
#pragma unroll
            for (int kk = 0; kk < 16; ++kk) if (kk < w) { const unsigned v = cp[(i0 + 15 - kk) * 128]; s0 += bf_lo(v); s1 += bf_hi(v); }
            for (int ii = 0; ii < 32; ++ii) { const int i = i0 + ii; const unsigned cv = cp[(i + 15) * 128];
                const int tpos = t0 + i + 1; const float inv = 1.0f / (float)(tpos < w ? tpos : w);
                *(LAS unsigned*)(lds + 73728 + i * 528 + pp * 4) = pk_bf16(s0 * inv - bf_lo(cv), s1 * inv - bf_hi(cv));
                if (ii < 31) { const unsigned vn = cp[(i + 16) * 128], vo = cp[(i + 16 - w) * 128]; s0 += bf_lo(vn) - bf_lo(vo); s1 += bf_hi(vn) - bf_hi(vo); } } }
        __syncthreads();
        OPAQUE(tid); lane = tid & 63;
        { const int r = lane & 15, kq = lane >> 4; f32x4 acc[4][4];
#pragma unroll
            for (int g = 0; g < 4; ++g)
#pragma unroll
                for (int n = 0; n < 4; ++n) acc[g][n] = (f32x4){0.f, 0.f, 0.f, 0.f};
#pragma unroll
            for (int g = 0; g < 4; ++g)
#pragma unroll
                for (int ks = 0; ks < 2; ++ks) { const bf16x8 af = *(const LAS bf16x8*)(lds + 73728 + (16 * wave + r) * 528 + (g * 64 + 32 * ks + 8 * kq) * 2);
#pragma unroll
                    for (int n = 0; n < 4; ++n) { const bf16x8 bfr = *(const bf16x8*)(pwT + ((g * 64 + 16 * n + r) * 64 + 32 * ks + 8 * kq));
                        acc[g][n] = __builtin_amdgcn_mfma_f32_16x16x32_bf16(bfr, af, acc[g][n], 0, 0, 0); } }
            const int row = 16 * wave + r;
#pragma unroll
            for (int g = 0; g < 4; ++g)
#pragma unroll
                for (int n = 0; n < 4; ++n) { const int ch = g * 64 + 16 * n + 4 * kq; const f32x4 b4 = *(const f32x4*)(pb + ch), s4 = *(const f32x4*)(psc + ch); const f32x4 o = (acc[g][n] + b4) * s4;
                    u32x2 w2; w2.x = pk_bf16(o[0], o[1]); w2.y = pk_bf16(o[2], o[3]); *(u32x2*)(mixed + (R0 + row) * D + 768 + ch) = w2; } }
        __syncthreads();
    }
    {
        OPAQUE(tid); lane = tid & 63;
        const float* lg = a->in[8] + l * 384; const float* lb = a->in[9] + l * 384; const float* sb = a->in[11] + l * 4 * 128;
        const bf16* Wm = (const bf16*)(a->ws + WS_SGUW) + (size_t)l * 4 * 128 * 128;
        for (int it = tid; it < 128 * 48; it += NTHREADS) { const int j = it / 48, v = it - j * 48; *(LAS u32x4*)(lds + j * 784 + v * 16) = *(const u32x4*)(z + (R0 + j) * DIN + 1152 + 8 * v); }
        __syncthreads();
        OPAQUE(tid);
        { const int j = tid & 127, qd = __builtin_amdgcn_readfirstlane(tid >> 7); float vv[96]; float s1 = 0.f, s2 = 0.f;
#pragma unroll
            for (int k = 0; k < 12; ++k) { const u32x4 x = *(const LAS u32x4*)(lds + j * 784 + qd * 192 + 16 * k);
#pragma unroll
                for (int q = 0; q < 4; ++q) { const float e0 = gelu_tanh(bf_lo(x[q])), e1 = gelu_tanh(bf_hi(x[q])); vv[8 * k + 2 * q] = e0; vv[8 * k + 2 * q + 1] = e1; s1 += e0 + e1; s2 += e0 * e0 + e1 * e1; } }
            LAS float* st = (LAS float*)(lds + 122880);
            st[(j * 4 + qd) * 2] = s1; st[(j * 4 + qd) * 2 + 1] = s2;
            __syncthreads();
            const float S1 = st[j * 8] + st[j * 8 + 2] + st[j * 8 + 4] + st[j * 8 + 6], S2 = st[j * 8 + 1] + st[j * 8 + 3] + st[j * 8 + 5] + st[j * 8 + 7];
            const float mean = S1 * (1.0f / 384.0f), var = S2 * (1.0f / 384.0f) - mean * mean, rstd = __builtin_amdgcn_rsqf(var + EPS);
#pragma unroll
            for (int cidx = 0; cidx < 96; ++cidx) { const float o = (vv[cidx] - mean) * rstd * lg[qd * 96 + cidx] + lb[qd * 96 + cidx];
                *(LAS bf16*)(lds + (qd * 96 + cidx) * 272 + j * 2) = f2bf(o); } }
        __syncthreads();
        OPAQUE(tid); lane = tid & 63;
        { const int hd = wave >> 1, ih = wave & 1, r = lane & 15, kq = lane >> 4; f32x4 acc[6][4];
#pragma unroll
            for (int dt = 0; dt < 6; ++dt)
#pragma unroll
                for (int it = 0; it < 4; ++it) acc[dt][it] = (f32x4){0.f, 0.f, 0.f, 0.f};
            const bf16* Wh = Wm + (size_t)hd * 128 * 128; const int nks = ih ? 4 : 2;
            for (int ks = 0; ks < nks; ++ks) { bf16x8 wf[4];
#pragma unroll
                for (int it = 0; it < 4; ++it) wf[it] = *(const bf16x8*)(Wh + (64 * ih + 16 * it + r) * 128 + 32 * ks + 8 * kq);
#pragma unroll
                for (int dt = 0; dt < 6; ++dt) { const bf16x8 vf = *(const LAS bf16x8*)(lds + (hd * 96 + 16 * dt + r) * 272 + (32 * ks + 8 * kq) * 2);
#pragma unroll
                    for (int it = 0; it < 4; ++it) acc[dt][it] = __builtin_amdgcn_mfma_f32_16x16x32_bf16(vf, wf[it], acc[dt][it], 0, 0, 0); } }
#pragma unroll
            for (int it = 0; it < 4; ++it) { const int i = 64 * ih + 16 * it + r; const float sbv = sb[hd * 128 + i];
#pragma unroll
                for (int dt = 0; dt < 6; ++dt) { const int ch = hd * 96 + 16 * dt + 4 * kq; const u32x2 uu = *(const u32x2*)(z + (R0 + i) * DIN + 768 + ch);
                    const float o0 = gelu_tanh(bf_lo(uu.x)) * (acc[dt][it][0] + sbv), o1 = gelu_tanh(bf_hi(uu.x)) * (acc[dt][it][1] + sbv);
                    const float o2 = gelu_tanh(bf_lo(uu.y)) * (acc[dt][it][2] + sbv), o3 = gelu_tanh(bf_hi(uu.y)) * (acc[dt][it][3] + sbv);
                    u32x2 w2; w2.x = pk_bf16(o0, o1); w2.y = pk_bf16(o2, o3); *(u32x2*)(mixed + (R0 + i) * D + 384 + ch) = w2; } } }
        __syncthreads();
    }
}

__device__ __forceinline__ void attn_unit(ArgsP a, LAS unsigned char* lds, int l, int u, int tid, int lane, int wave) {
    const bf16* Q = (const bf16*)(a->ws + WS_Q); bf16* O = (bf16*)(a->ws + WS_O);
    const bf16* KB = (const bf16*)(a->ws + WS_KB); const bf16* VT = (const bf16*)(a->ws + WS_VT);
    const int qt = u & 15, bh = u >> 4, b = bh >> 2, h = bh & 3;
    { const bf16* kp = KB + (size_t)(b * 256) * 2048 + l * 1024 + h * 256;
        for (int it = tid; it < 256 * 32; it += NTHREADS) { const int row = it >> 5, v = it & 31; *(LAS u32x4*)(lds + row * 528 + v * 16) = *(const u32x4*)(kp + (size_t)row * 2048 + 8 * v); } }
    __syncthreads();
    const int r = lane & 31, h2 = lane >> 5; const size_t qrow = (size_t)b * SEQ + qt * 256 + wave * 32 + r;
    f32x16 sacc[8];
#pragma unroll
    for (int kt = 0; kt < 8; ++kt)
#pragma unroll
        for (int j = 0; j < 16; ++j) sacc[kt][j] = 0.f;
    const bf16* qp = Q + qrow * D + h * 256 + 8 * h2;
#pragma unroll 4
    for (int s = 0; s < 16; ++s) { const bf16x8 qf = *(const bf16x8*)(qp + 16 * s);
#pragma unroll
        for (int kt = 0; kt < 8; ++kt) { const bf16x8 kf = *(const LAS bf16x8*)(lds + (32 * kt + r) * 528 + (16 * s + 8 * h2) * 2);
            sacc[kt] = __builtin_amdgcn_mfma_f32_32x32x16_bf16(kf, qf, sacc[kt], 0, 0, 0); } }
    float mx = -3.0e38f;
#pragma unroll
    for (int kt = 0; kt < 8; ++kt)
#pragma unroll
        for (int j = 0; j < 16; ++j) mx = fmaxf(mx, sacc[kt][j]);
    mx = fmaxf(mx, shfl_xor_f(mx, 32));
    float sum = 0.f; bf16x8 pf[8][2];
#pragma unroll
    for (int kt = 0; kt < 8; ++kt) {
        float p[16];
#pragma unroll
        for (int j = 0; j < 16; ++j) { p[j] = __builtin_amdgcn_exp2f(sacc[kt][j] - mx); sum += p[j]; }
#pragma unroll
        for (int s2 = 0; s2 < 2; ++s2) { u32x4 w; w.x = pk_bf16(p[8 * s2], p[8 * s2 + 1]); w.y = pk_bf16(p[8 * s2 + 2], p[8 * s2 + 3]); w.z = pk_bf16(p[8 * s2 + 4], p[8 * s2 + 5]); w.w = pk_bf16(p[8 * s2 + 6], p[8 * s2 + 7]);
            pf[kt][s2] = __builtin_bit_cast(bf16x8, w); } }
    sum += shfl_xor_f(sum, 32);
    const float inv = 1.0f / sum;
    __syncthreads();
    { const bf16* vp = VT + (size_t)(l * 1024 + h * 256) * 2048 + b * 256;
        for (int it = tid; it < 256 * 32; it += NTHREADS) { const int row = it >> 5, v = it & 31; const u32x4 x = *(const u32x4*)(vp + (size_t)row * 2048 + 8 * v);
            const int grp = v >> 1, odd = v & 1; LAS unsigned char* dst = lds + row * 528 + grp * 32 + odd * 8;
            *(LAS u32x2*)(dst) = (u32x2){x.x, x.y}; *(LAS u32x2*)(dst + 16) = (u32x2){x.z, x.w}; } }
    __syncthreads();
#pragma unroll
    for (int dh = 0; dh < 2; ++dh) {
        f32x16 oacc[4];
#pragma unroll
        for (int dt = 0; dt < 4; ++dt)
#pragma unroll
            for (int j = 0; j < 16; ++j) oacc[dt][j] = 0.f;
#pragma unroll
        for (int kt = 0; kt < 8; ++kt)
#pragma unroll
            for (int s2 = 0; s2 < 2; ++s2)
#pragma unroll
                for (int dt = 0; dt < 4; ++dt) { const bf16x8 vf = *(const LAS bf16x8*)(lds + (dh * 128 + 32 * dt + r) * 528 + (kt * 2 + s2) * 32 + 16 * h2);
                    oacc[dt] = __builtin_amdgcn_mfma_f32_32x32x16_bf16(vf, pf[kt][s2], oacc[dt], 0, 0, 0); }
        bf16* op = O + qrow * D + h * 256 + dh * 128 + 4 * h2;
#pragma unroll
        for (int dt = 0; dt < 4; ++dt)
#pragma unroll
            for (int g4 = 0; g4 < 4; ++g4) { u32x2 w; w.x = pk_bf16(oacc[dt][4 * g4] * inv, oacc[dt][4 * g4 + 1] * inv); w.y = pk_bf16(oacc[dt][4 * g4 + 2] * inv, oacc[dt][4 * g4 + 3] * inv);
                *(u32x2*)(op + 32 * dt + 8 * g4) = w; }
    }
    __syncthreads();
}

__device__ __forceinline__ void phase_router(ArgsP a, LAS unsigned char* lds, int vcu, int G, int tid, int lane, int wave) {
    unsigned char* ws = a->ws;
    LAS float* grw = (LAS float*)lds;
    LAS int* hist = (LAS int*)(lds + 32768);
    const float* gn = a->in[22] + D; const float* rw = a->in[26];
    for (int i = tid; i < D * NE; i += NTHREADS) grw[i] = gn[i >> 3] * rw[i];
    if (tid < 16) hist[tid] = 0;
    __syncthreads();
    const u64* rowss = (const u64*)(ws + OFF_ROWSS) + 5 * T;
    int* sel = (int*)(ws + WS_ROUTE); float* gate = (float*)(ws + WS_ROUTE + 2 * T * 4);
    const int gw = vcu * NWAVES + wave, NGW = G * NWAVES;
    for (int m = gw; m < T; m += NGW) {
        const f32x4* xr = (const f32x4*)(a->out + (size_t)m * D) + lane;
        float p[8];
#pragma unroll
        for (int e = 0; e < 8; ++e) p[e] = 0.f;
#pragma unroll
        for (int j = 0; j < 4; ++j) { const f32x4 x = xr[64 * j]; const int k0 = 4 * (lane + 64 * j);
#pragma unroll
            for (int q = 0; q < 4; ++q) { const f32x4 w0 = *(const LAS f32x4*)(grw + (k0 + q) * 8), w1 = *(const LAS f32x4*)(grw + (k0 + q) * 8 + 4);
                p[0] += x[q] * w0[0]; p[1] += x[q] * w0[1]; p[2] += x[q] * w0[2]; p[3] += x[q] * w0[3]; p[4] += x[q] * w1[0]; p[5] += x[q] * w1[1]; p[6] += x[q] * w1[2]; p[7] += x[q] * w1[3]; } }
        const float rstd = rstd_ss(rowss[m]);
#pragma unroll
        for (int e = 0; e < 8; ++e) p[e] = wave_sum(p[e]) * rstd;
        int i0 = 0; float v0 = p[0];
#pragma unroll
        for (int e = 1; e < 8; ++e) if (p[e] > v0) { v0 = p[e]; i0 = e; }
        int i1 = -1; float v1 = -3.0e38f;
#pragma unroll
        for (int e = 0; e < 8; ++e) if (e != i0 && p[e] > v1) { v1 = p[e]; i1 = e; }
        const float g0 = 1.0f / (1.0f + __expf(v1 - v0)), g1 = 1.0f - g0;
        if (lane == 0) { sel[m] = i0; sel[T + m] = i1; gate[m] = g0; gate[T + m] = g1; __hip_atomic_fetch_add(&hist[i0], 1, __ATOMIC_RELAXED, __HIP_MEMORY_SCOPE_WORKGROUP); __hip_atomic_fetch_add(&hist[8 + i1], 1, __ATOMIC_RELAXED, __HIP_MEMORY_SCOPE_WORKGROUP); }
    }
    __syncthreads();
    { int t3 = tid; OPAQUE(t3); if (t3 < 16) atomicAdd((int*)(ws + OFF_MOECNT) + t3, hist[t3]); }
}
__device__ __forceinline__ void phase_lists(ArgsP a, LAS unsigned char* lds, int vcu, int G, int tid) {
    unsigned char* ws = a->ws;
    const int* cnt = (const int*)(ws + OFF_MOECNT); int* cursor = (int*)(ws + OFF_MOECNT + 256);
    const u64* rowss = (const u64*)(ws + OFF_ROWSS) + 5 * T;
    const int* sel = (const int*)(ws + WS_ROUTE); const float* gate = (const float*)(ws + WS_ROUTE + 2 * T * 4);
    int* perm = (int*)(ws + WS_ROUTE + 4 * T * 4); float* rsp = (float*)(ws + WS_ROUTE + 4 * T * 4 + 2 * PERMROWS * 4); float* gp = (float*)(ws + WS_ROUTE + 4 * T * 4 + 4 * PERMROWS * 4);
    LAS int* lc = (LAS int*)lds;
    LAS int* lb = (LAS int*)(lds + 64);
    for (int chunk = vcu; chunk < T / 128; chunk += G)
        for (int s = 0; s < 2; ++s) {
            __syncthreads();
            if (tid < 8) lc[tid] = 0;
            __syncthreads();
            int e = 0, rnk = 0; const int tok = chunk * 128 + tid;
            if (tid < 128) { e = sel[s * T + tok]; rnk = __hip_atomic_fetch_add(&lc[e], 1, __ATOMIC_RELAXED, __HIP_MEMORY_SCOPE_WORKGROUP); }
            __syncthreads();
            if (tid < 8) lb[tid] = atomicAdd(cursor + s * 8 + tid, lc[tid]);
            __syncthreads();
            if (tid < 128) { int off = 0;
#pragma unroll
                for (int j = 0; j < 8; ++j) { const int tl = (cnt[s * 8 + j] + 255) >> 8; if (j < e) off += tl * 256; }
                const int pos = off + lb[e] + rnk;
                perm[s * PERMROWS + pos] = tok; rsp[s * PERMROWS + pos] = rstd_ss(rowss[tok]); gp[s * PERMROWS + pos] = gate[s * T + tok]; }
        }
    if (vcu < 16) { const int s = vcu >> 3, e = vcu & 7; int off = 0, ce = 0;
#pragma unroll
        for (int j = 0; j < 8; ++j) { const int cj = cnt[s * 8 + j]; const int tl = (cj + 255) >> 8; if (j < e) off += tl * 256; if (j == e) ce = cj; }
        const int end = off + ((ce + 255) >> 8) * 256;
        for (int pos = off + ce + tid; pos < end; pos += NTHREADS) { perm[s * PERMROWS + pos] = -1; rsp[s * PERMROWS + pos] = 0.f; gp[s * PERMROWS + pos] = 0.f; } }
}

__device__ __forceinline__ void phase_final(ArgsP a, int vcu, int G, int lane, int wave) {
    const u64* rowss = (const u64*)(a->ws + OFF_ROWSS) + 6 * T; const float* g = a->in[30];
    const int gw = vcu * NWAVES + wave, NGW = G * NWAVES;
    f32x4 gv[4];
#pragma unroll
    for (int j = 0; j < 4; ++j) gv[j] = ((const f32x4*)g)[lane + 64 * j];
    for (int m = gw; m < T; m += NGW) { f32x4* xr = (f32x4*)(a->out + (size_t)m * D) + lane; const float rstd = rstd_ss(rowss[m]);
#pragma unroll
        for (int j = 0; j < 4; ++j) xr[64 * j] = xr[64 * j] * rstd * gv[j]; }
}

__global__ void __launch_bounds__(NTHREADS, 2) fwd_kernel(Args args_byval) {
    extern __shared__ __attribute__((aligned(16))) unsigned char lds_raw[];
    LAS unsigned char* lds = (LAS unsigned char*)lds_raw;
    const int wave = __builtin_amdgcn_readfirstlane((int)threadIdx.x >> 6);
    const int G = gridDim.x; const int bx = blockIdx.x; const int vcu = (G % 8 == 0) ? (bx % 8) * (G / 8) + bx / 8 : bx;
#define ARGS() ArgsP args = (ArgsP)__builtin_amdgcn_kernarg_segment_ptr(); asm volatile("" : "+s"(args)); unsigned char* ws = args->ws; u64* rowss = (u64*)(ws + OFF_ROWSS); bf16* XB = (bf16*)(ws + WS_XB); (void)rowss; (void)XB
#define TID() (wave * 64 + lane_id())
    volatile LAS unsigned* MISC = (volatile LAS unsigned*)(lds + MISC_OFF);
    if (threadIdx.x < 64) MISC[threadIdx.x] = 0u;
    __syncthreads();
    int lo, hi; XcdBarrier bar;
    { ARGS(); lo = args->ph_lo; hi = args->ph_hi; bar.bar = (unsigned*)ws + CW_BAR; bar.x = 0; bar.st = nullptr;
      if (hi - lo > 1) bar = xcd_barrier_post((unsigned*)ws + CW_BAR, MISC + 8); }
#define IN(k) (lo <= (k) && (k) < hi)
#define SEAM(k) do { if (lo <= (k) && (k) + 1 < hi) xcd_barrier(bar); } while (0)
    constexpr float QSCALE = 0.0625f * 1.4426950408889634f;

    if (EN_PRO && IN(0)) { ARGS(); for (int rep = 0; rep < REP_PRO; ++rep) { int t2 = TID(); OPAQUE(t2); phase_prologue(args, lds, vcu, G, t2, t2 & 63, wave); __syncthreads(); } }
    SEAM(0);
#pragma unroll 1
    for (int l = 0; l < 2; ++l) {
        const int pb = 1 + 8 * l;
        if (EN_GEMM && EN_G1 && IN(pb)) { ARGS();
            if (EN_KV && l == 0 && bx >= 128) {
                if (bx < 192) { pg8::Gemm g{(const bf16*)(ws + WS_MEMB), (const bf16*)(ws + WS_WK), nullptr, MROWS, 2048, D}; pg8::StaticOrder S; S.init(MROWS, 2048, 64, bx - 128);
                    pg8::EpiRowScale<false> E{(bf16*)(ws + WS_KB), 2048, (const void*)(ws + OFF_MEMSS), 1.0f};
                    pg8::gemm_phase<pg8::EpiRowScale<false>, pg8::StaticOrder, true, false>(lds, g, S, E, wave); }
                else { pg8::Gemm g{(const bf16*)(ws + WS_WV), (const bf16*)(ws + WS_MEMB), nullptr, 2048, MROWS, D}; pg8::StaticOrder S; S.init(2048, MROWS, 64, bx - 192);
                    pg8::EpiColScale E{(bf16*)(ws + WS_VT), 2048, (const u64*)(ws + OFF_MEMSS)};
                    pg8::gemm_phase<pg8::EpiColScale, pg8::StaticOrder, true, false>(lds, g, S, E, wave); }
            }
            pg8::Gemm g{XB, (const bf16*)(ws + WS_WIN) + (size_t)l * DIN * D, nullptr, T, DIN, D}; pg8::StaticOrder S; S.init(T, DIN, G, bx);
            pg8::EpiRowScale<false> E{(bf16*)(ws + WS_Z), DIN, rowss + (size_t)(3 * l) * T, 1.0f};
            pg8::gemm_phase<pg8::EpiRowScale<false>, pg8::StaticOrder, true, false>(lds, g, S, E, wave);
        }
        SEAM(pb);
        if (EN_MIX && IN(pb + 1)) { ARGS(); for (int rep = 0; rep < REP_MIX; ++rep) { int t2 = TID(); asm volatile("" : "+v"(t2)); for (int u = vcu; u < 256; u += G) mixer_unit(args, lds, l, u, t2, t2 & 63, wave); } }
        SEAM(pb + 1);
        if (EN_GEMM && EN_G2 && IN(pb + 2)) { ARGS();
            pg8::Gemm g{(const bf16*)(ws + WS_MIXED), (const bf16*)(ws + WS_WOUT) + (size_t)l * D * D, nullptr, T, D, D}; pg8::StaticOrder S; S.init(T, D, G, bx);
            pg8::EpiResid<false, true, true> E{args->out, XB, rowss + (size_t)(3 * l + 1) * T, nullptr, nullptr, 1.0f, false};
            pg8::gemm_phase<pg8::EpiResid<false, true, true>, pg8::StaticOrder, true, false>(lds, g, S, E, wave);
        }
        SEAM(pb + 2);
        if (EN_GEMM && EN_G3 && IN(pb + 3)) { ARGS();
            pg8::Gemm g{XB, (const bf16*)(ws + WS_WQ) + (size_t)l * D * D, nullptr, T, D, D}; pg8::StaticOrder S; S.init(T, D, G, bx);
            pg8::EpiRowScale<false> E{(bf16*)(ws + WS_Q), D, rowss + (size_t)(3 * l + 1) * T, QSCALE};
            for (int rep = 0; rep < REP_Q; ++rep) pg8::gemm_phase<pg8::EpiRowScale<false>, pg8::StaticOrder, true, false>(lds, g, S, E, wave);
        }
        SEAM(pb + 3);
        if (EN_ATT && IN(pb + 4)) { ARGS(); for (int rep = 0; rep < REP_ATT; ++rep) { int t2 = TID(); asm volatile("" : "+v"(t2)); for (int u = vcu; u < 512; u += G) attn_unit(args, lds, l, u, t2, t2 & 63, wave); } }
        SEAM(pb + 4);
        if (EN_GEMM && EN_G2 && IN(pb + 5)) { ARGS();
            pg8::Gemm g{(const bf16*)(ws + WS_O), (const bf16*)(ws + WS_WO) + (size_t)l * D * D, nullptr, T, D, D}; pg8::StaticOrder S; S.init(T, D, G, bx);
            pg8::EpiResid<false, true, true> E{args->out, XB, rowss + (size_t)(3 * l + 2) * T, nullptr, nullptr, 1.0f, l == 1};
            pg8::gemm_phase<pg8::EpiResid<false, true, true>, pg8::StaticOrder, true, false>(lds, g, S, E, wave);
        }
        SEAM(pb + 5);
        if (l == 0) {
            if (EN_GEMM && EN_G4 && IN(7)) { ARGS();
                pg8::Gemm g{XB, (const bf16*)(ws + WS_WGU), nullptr, T, 2 * DFF, D}; pg8::StaticOrder S; S.init(T, 2 * DFF, G, bx);
                pg8::EpiSwiglu<false> E{(bf16*)(ws + WS_H), DFF, rowss + (size_t)2 * T};
                for (int rep = 0; rep < REP_UP; ++rep) pg8::gemm_phase<pg8::EpiSwiglu<false>, pg8::StaticOrder, true, false>(lds, g, S, E, wave);
            }
            SEAM(7);
            if (EN_GEMM && EN_G2 && IN(8)) { ARGS();
                pg8::Gemm g{(const bf16*)(ws + WS_H), (const bf16*)(ws + WS_WD), nullptr, T, D, DFF}; pg8::StaticOrder S; S.init(T, D, G, bx);
                pg8::EpiResid<false, true, true> E{args->out, XB, rowss + (size_t)3 * T, nullptr, nullptr, 1.0f, false};
                pg8::gemm_phase<pg8::EpiResid<false, true, true>, pg8::StaticOrder, true, false>(lds, g, S, E, wave);
            }
            SEAM(8);
        } else {
            if (EN_ROUTE && IN(15)) { ARGS(); int t2 = TID(); OPAQUE(t2); phase_router(args, lds, vcu, G, t2, t2 & 63, wave); }
            SEAM(15);
            if (EN_ROUTE && IN(16)) { ARGS(); int t2 = TID(); OPAQUE(t2); phase_lists(args, lds, vcu, G, t2); }
            SEAM(16);
#pragma unroll 1
            for (int s = 0; s < 2; ++s) {
                if (EN_MOE && EN_MUP && IN(17 + 2 * s)) { ARGS();
                    const int* perm = (const int*)(ws + WS_ROUTE + 4 * T * 4); const float* rsp = (const float*)(ws + WS_ROUTE + 4 * T * 4 + 2 * PERMROWS * 4);
                    pg8::MoeOrder S; S.G = G; S.c = bx; S.tp[0] = 0; S.nN = 2 * DFF / 256;
                    const int* cnt = (const int*)(ws + OFF_MOECNT) + s * 8;
#pragma unroll
                    for (int j = 0; j < 8; ++j) S.tp[j + 1] = S.tp[j] + ((__builtin_amdgcn_readfirstlane(cnt[j]) + 255) >> 8);
                    pg8::Gemm g{XB, (const bf16*)(ws + WS_MWGU), perm + s * PERMROWS, T, 2 * DFF, D / 2};
                    pg8::EpiSwiglu8 E{ws + WS_H, DFF, rsp + s * PERMROWS};
                    pg8::gemm_phase<pg8::EpiSwiglu8, pg8::MoeOrder, true, true, true>(lds, g, S, E, wave);
                }
                SEAM(17 + 2 * s);
                if (EN_MOE && EN_MDN && IN(18 + 2 * s)) { ARGS();
                    const int* perm = (const int*)(ws + WS_ROUTE + 4 * T * 4); const float* gp = (const float*)(ws + WS_ROUTE + 4 * T * 4 + 4 * PERMROWS * 4);
                    pg8::MoeOrder S; S.G = G; S.c = bx; S.tp[0] = 0; S.nN = D / 256;
                    const int* cnt = (const int*)(ws + OFF_MOECNT) + s * 8;
#pragma unroll
                    for (int j = 0; j < 8; ++j) S.tp[j + 1] = S.tp[j] + ((__builtin_amdgcn_readfirstlane(cnt[j]) + 255) >> 8);
                    pg8::Gemm g{(const bf16*)(ws + WS_H), (const bf16*)(ws + WS_MWD), nullptr, T, D, DFF / 2};
                    pg8::EpiResid<true, false, true> E{args->out, nullptr, s ? rowss + (size_t)6 * T : nullptr, perm + s * PERMROWS, gp + s * PERMROWS, 1.0f / S8_DN, false};
                    pg8::gemm_phase<pg8::EpiResid<true, false, true>, pg8::MoeOrder, true, false, true>(lds, g, S, E, wave);
                }
                SEAM(18 + 2 * s);
            }
            if (IN(21)) { ARGS(); int t2 = TID(); OPAQUE(t2); phase_final(args, vcu, G, t2 & 63, wave); }
        }
    }
#undef IN
#undef SEAM
}

extern "C" void kernel_launch(void* const* d_in, const int* in_sizes, int n_in, void* d_out, int out_size, void* d_ws, size_t ws_size, hipStream_t stream) {
    static int grid = 0;
    if (grid == 0) {
        if (n_in != 31 || in_sizes[0] != T * D || out_size != T * D || ws_size < WS_END) { fprintf(stderr, "kernel_launch: unexpected shapes (n_in %d, in0 %d, out %d, ws %zu)\n", n_in, n_in > 0 ? in_sizes[0] : -1, out_size, ws_size); grid = -1; return; }
        int dev = 0, cus = 0;
        if (hipGetDevice(&dev) != hipSuccess || hipDeviceGetAttribute(&cus, hipDeviceAttributeMultiprocessorCount, dev) != hipSuccess) { grid = -1; return; }
        if (hipFuncSetAttribute((const void*)fwd_kernel, hipFuncAttributeMaxDynamicSharedMemorySize, LDS_BYTES) != hipSuccess) { fprintf(stderr, "kernel_launch: hipFuncSetAttribute failed\n"); grid = -1; return; }
        int per_cu = 0;
        if (hipOccupancyMaxActiveBlocksPerMultiprocessor(&per_cu, (const void*)fwd_kernel, NTHREADS, LDS_BYTES) != hipSuccess || per_cu < 1) fprintf(stderr, "kernel_launch: occupancy query reports %d\n", per_cu);
        (void)hipGetLastError();
        grid = cus;
    }
    if (grid < 0) return;
    (void)hipMemsetAsync(d_ws, 0, CTL_ZERO_BYTES, stream);
    Args a{};
    for (int i = 0; i < 31; ++i) a.in[i] = (const float*)d_in[i];
    a.out = (float*)d_out; a.ws = (unsigned char*)d_ws;
#if MK_PER_PHASE
    for (int ph = 0; ph < NPH; ++ph) { a.ph_lo = ph; a.ph_hi = ph + 1; hipLaunchKernelGGL(fwd_kernel, dim3(grid), dim3(NTHREADS), LDS_BYTES, stream, a); }
#else
    a.ph_lo = 0; a.ph_hi = NPH; hipLaunchKernelGGL(fwd_kernel, dim3(grid), dim3(NTHREADS), LDS_BYTES, stream, a);
#endif
}
```

```cpp
#include <hip/hip_runtime.h>
#include <cstdio>
#include <cstdint>

#ifndef MK_PER_PHASE
#define MK_PER_PHASE 0
#endif

#ifndef EN_PRO
#define EN_PRO 1
#endif
#ifndef EN_GEMM
#define EN_GEMM 1
#endif
#ifndef EN_G1
#define EN_G1 1
#endif
#ifndef EN_G2
#define EN_G2 1
#endif
#ifndef EN_G3
#define EN_G3 1
#endif
#ifndef EN_G4
#define EN_G4 1
#endif
#ifndef EN_KV
#define EN_KV 1
#endif
#ifndef REP_PRO
#define REP_PRO 1
#endif
#ifndef REP_MIX
#define REP_MIX 1
#endif
#ifndef REP_ATT
#define REP_ATT 1
#endif
#ifndef REP_Q
#define REP_Q 1
#endif
#ifndef REP_UP
#define REP_UP 1
#endif
#ifndef EN_MUP
#define EN_MUP 1
#endif
#ifndef EN_MDN
#define EN_MDN 1
#endif
#ifndef EN_MIX
#define EN_MIX 1
#endif
#ifndef EN_ATT
#define EN_ATT 1
#endif
#ifndef EN_MOE
#define EN_MOE 1
#endif
#ifndef EN_ROUTE
#define EN_ROUTE 1
#endif
#define LAS __attribute__((address_space(3)))
#define GAS __attribute__((address_space(1)))
typedef unsigned short bf16;
typedef short bf16x8 __attribute__((ext_vector_type(8)));
typedef float f32x2 __attribute__((ext_vector_type(2)));
typedef float f32x4 __attribute__((ext_vector_type(4)));
typedef float f32x16 __attribute__((ext_vector_type(16)));
typedef unsigned u32x2 __attribute__((ext_vector_type(2)));
typedef unsigned u32x4 __attribute__((ext_vector_type(4)));
typedef __bf16 bf16x2_t __attribute__((ext_vector_type(2)));
typedef int i32x4 __attribute__((ext_vector_type(4)));
typedef int i32x8 __attribute__((ext_vector_type(8)));
typedef unsigned long long u64;
typedef unsigned long long u64x2 __attribute__((ext_vector_type(2)));

constexpr int NB = 8, SEQ = 4096, D = 1024, T = NB * SEQ, DIN = 1792, DFF = 2816, NE = 8, MEMLEN = 256, MROWS = NB * MEMLEN;
constexpr float EPS = 1e-6f;
constexpr float S8_UP = 32.0f, S8_DN = 64.0f;
constexpr int NWAVES = 8, NTHREADS = 512;
constexpr int NPH = 22;

constexpr size_t MiB = 1u << 20;
constexpr size_t CTL_ZERO_BYTES = 2 * MiB;
constexpr int CW_BAR = 4096;
constexpr size_t OFF_ROWSS = 64 * 1024;
constexpr size_t OFF_MOECNT = 32 * 1024;
constexpr size_t OFF_MEMSS = 40 * 1024;
constexpr size_t WS_WIN = 2 * MiB;
constexpr size_t WS_WOUT = 9 * MiB;
constexpr size_t WS_WQ = 13 * MiB;
constexpr size_t WS_WO = 17 * MiB;
constexpr size_t WS_WK = 21 * MiB;
constexpr size_t WS_WV = 25 * MiB;
constexpr size_t WS_WGU = 29 * MiB;
constexpr size_t WS_WD = 40 * MiB;
constexpr size_t WS_MWGU = 46 * MiB;
constexpr size_t WS_MWD = 134 * MiB;
constexpr size_t WS_SGUW = 178 * MiB;
constexpr size_t WS_POOLW = 178 * MiB + 512 * 1024;
constexpr size_t WS_XB = 180 * MiB;
constexpr size_t WS_MEMB = 244 * MiB;
constexpr size_t WS_KB = 248 * MiB;
constexpr size_t WS_VT = 256 * MiB;
constexpr size_t WS_ROUTE = 264 * MiB;
constexpr int PERMROWS = 136 * 256;
constexpr size_t WS_ACT = 266 * MiB;
constexpr size_t WS_Z = WS_ACT;
constexpr size_t WS_MIXED = WS_ACT + 112 * MiB;
constexpr size_t WS_Q = WS_ACT;
constexpr size_t WS_O = WS_ACT + 64 * MiB;
constexpr size_t WS_H = WS_ACT;
constexpr size_t WS_END = 512 * MiB;
static_assert(WS_H + (size_t)PERMROWS * DFF * 2 <= WS_END, "ws map");

constexpr int LDS_BYTES = 160 * 1024;
constexpr int MISC_OFF = LDS_BYTES - 256;

__device__ __forceinline__ float bf_lo(unsigned v) { return __uint_as_float(v << 16); }
__device__ __forceinline__ float bf_hi(unsigned v) { return __uint_as_float(v & 0xffff0000u); }
__device__ __forceinline__ unsigned pk_bf16(float lo, float hi) { f32x2 v = {lo, hi}; bf16x2_t b = __builtin_convertvector(v, bf16x2_t); return __builtin_bit_cast(unsigned, b); }
__device__ __forceinline__ bf16 f2bf(float f) { return (bf16)(pk_bf16(f, 0.f) & 0xffffu); }
__device__ __forceinline__ float sigm(float x) { return __builtin_amdgcn_rcpf(1.0f + __expf(-x)); }
__device__ __forceinline__ float silu_f(float x) { return x * sigm(x); }
__device__ __forceinline__ float gelu_tanh(float x) { const float y = 0.7978845608028654f * (x + 0.044715f * x * x * x); return x * sigm(2.0f * y); }
constexpr float SS_FIX = 16777216.0f;
__device__ __forceinline__ u64 ss_to_fix(float ss) { return (u64)(ss * SS_FIX); }
__device__ __forceinline__ float rstd_ss(u64 ssf) { return __builtin_amdgcn_rsqf((float)ssf * (1.0f / (1024.0f * SS_FIX)) + EPS); }
__device__ __forceinline__ unsigned pk_fp8x4(float a, float b, float c, float d) { int p = __builtin_amdgcn_cvt_pk_fp8_f32(a, b, 0, false); p = __builtin_amdgcn_cvt_pk_fp8_f32(c, d, p, true); return (unsigned)p; }
__device__ __forceinline__ int lane_id() { int l; asm volatile("v_mbcnt_lo_u32_b32 %0, -1, 0\n\tv_mbcnt_hi_u32_b32 %0, -1, %0" : "=v"(l)); return l; }
__device__ __forceinline__ float shfl_xor_f(float v, int mask) { const int idx = (lane_id() ^ mask) << 2; return __builtin_bit_cast(float, __builtin_amdgcn_ds_bpermute(idx, __builtin_bit_cast(int, v))); }
#define OPAQUE(x) asm volatile("" : "+v"(x))
template <int CTRL> __device__ __forceinline__ float dpp_f(float v) { return __builtin_bit_cast(float, __builtin_amdgcn_update_dpp(0, __builtin_bit_cast(int, v), CTRL, 0xf, 0xf, true)); }
__device__ __forceinline__ float row16_sum(float v) { v += dpp_f<0xB1>(v); v += dpp_f<0x4E>(v); v += dpp_f<0x141>(v); v += dpp_f<0x140>(v); return v; }
__device__ __forceinline__ float wave_sum(float v) { v = row16_sum(v); v += shfl_xor_f(v, 16); v += shfl_xor_f(v, 32); return v; }

namespace pg8 {
__device__ __forceinline__ void glds_s(const void* sbase, unsigned voff, unsigned lds_dst) {
    asm volatile("s_mov_b32 m0, %2\n\ts_nop 0\n\tglobal_load_lds_dwordx4 %0, %1" : : "v"(voff), "s"(sbase), "s"(lds_dst) : "memory", "m0");
}
constexpr int BM = 256, BK = 64, HALF = 128, HTB = HALF * BK * 2, STAGE_BYTES = 8 * HTB, NXCD = 8, WGM = 8;
__host__ __device__ __forceinline__ int lds_byte(int r, int c) { const int st = (r >> 4) * 2 + (c >> 5), rr = r & 15, cc = c & 31, ob = rr * 64 + cc * 2; return st * 1024 + (ob ^ (((ob >> 9) & 1) << 5)); }
__host__ __device__ __forceinline__ void stage_rc(int b, int& R, int& C) { const int st = b / 1024, sb = b % 1024, swz = sb ^ (((sb >> 9) & 1) << 5); R = (st >> 1) * 16 + swz / 64; C = (st & 1) * 32 + (swz % 64) / 2; }
__host__ __device__ __forceinline__ int perm32(int rho) { const int n = rho >> 4, i = rho & 15; return 8 * (i >> 2) + 4 * n + (i & 3); }

struct Unit { int pm, pn, brow; };
struct Gemm { const bf16* A; const bf16* Bt; const int* perm; int M, N, K; };

struct StaticOrder {
    int nM, nN, nwg, G, c;
    __device__ void init(int M, int N, int G_, int c_) { nM = M / BM; nN = N / BM; nwg = nM * nN; G = G_; c = c_; }
    __device__ bool next(int i, Unit& u) const {
        const long L = (long)i * G + c; if (L >= nwg) return false;
        int wgid = (int)L; { const int q = nwg / NXCD, r = nwg % NXCD, xcd = wgid % NXCD, off = wgid / NXCD; wgid = (xcd < r ? xcd * (q + 1) : r * (q + 1) + (xcd - r) * q) + off; }
        const int nig = WGM * nN, gid = wgid / nig, fm = gid * WGM, gsz = (nM - fm) < WGM ? (nM - fm) : WGM;
        u.pm = fm + ((wgid % nig) % gsz); u.pn = (wgid % nig) / gsz; u.brow = u.pn; return true;
    }
};
struct MoeOrder {
    int nN, G, c; int tp[9];
    __device__ bool next(int i, Unit& u) const {
        const int L = i * G + c; if (L >= tp[8] * nN) return false;
        int e = 0;
#pragma unroll
        for (int j = 1; j < 8; ++j) e += (L >= tp[j] * nN) ? 1 : 0;
        int base = 0, nx = 0;
#pragma unroll
        for (int j = 0; j < 8; ++j) if (e == j) { base = tp[j]; nx = tp[j + 1]; }
        const int te = nx - base, Lp = L - base * nN; u.pn = Lp / te; u.pm = base + Lp % te; u.brow = e * nN + u.pn; return true;
    }
};

typedef f32x4 Acc[2][2][4][2];

template <bool DIRECT> struct EpiRowScale {
    static constexpr bool PERM = true;
    bf16* O; int ldc; const void* rs; float cst;
    __device__ __forceinline__ void operator()(const Acc& acc, const Unit& u, int wr, int wc, int fr, int fq) const {
        { const int ln = lane_id(); fr = ln & 15; fq = ln >> 4; }
        const int row0 = u.pm * BM + wr * 64 + fr, col0 = u.pn * BM + wc * 32 + 8 * fq;
#pragma unroll
        for (int ai = 0; ai < 2; ++ai)
#pragma unroll
            for (int m = 0; m < 4; ++m) { const int row = row0 + ai * HALF + m * 16; const float sc = (DIRECT ? ((const float*)rs)[row] : rstd_ss(((const u64*)rs)[row])) * cst;
                bf16* rowp = O + (size_t)row * ldc + col0;
#pragma unroll
                for (int bj = 0; bj < 2; ++bj) { const f32x4 v0 = acc[ai][bj][m][0] * sc, v1 = acc[ai][bj][m][1] * sc;
                    u32x4 w; w.x = pk_bf16(v0[0], v0[1]); w.y = pk_bf16(v0[2], v0[3]); w.z = pk_bf16(v1[0], v1[1]); w.w = pk_bf16(v1[2], v1[3]);
                    *(u32x4*)(rowp + bj * HALF) = w; } }
    }
};
struct EpiColScale {
    static constexpr bool PERM = true;
    bf16* O; int ldc; const u64* css;
    __device__ __forceinline__ void operator()(const Acc& acc, const Unit& u, int wr, int wc, int fr, int fq) const {
        { const int ln = lane_id(); fr = ln & 15; fq = ln >> 4; }
        const int row0 = u.pm * BM + wr * 64 + fr, col0 = u.pn * BM + wc * 32 + 8 * fq;
#pragma unroll
        for (int bj = 0; bj < 2; ++bj) {
            const u64* cp = css + col0 + bj * HALF;
            const f32x4 c0 = (f32x4){rstd_ss(cp[0]), rstd_ss(cp[1]), rstd_ss(cp[2]), rstd_ss(cp[3])}, c1 = (f32x4){rstd_ss(cp[4]), rstd_ss(cp[5]), rstd_ss(cp[6]), rstd_ss(cp[7])};
#pragma unroll
            for (int ai = 0; ai < 2; ++ai)
#pragma unroll
                for (int m = 0; m < 4; ++m) { bf16* rowp = O + (size_t)(row0 + ai * HALF + m * 16) * ldc + col0 + bj * HALF;
                    const f32x4 v0 = acc[ai][bj][m][0] * c0, v1 = acc[ai][bj][m][1] * c1;
                    u32x4 w; w.x = pk_bf16(v0[0], v0[1]); w.y = pk_bf16(v0[2], v0[3]); w.z = pk_bf16(v1[0], v1[1]); w.w = pk_bf16(v1[2], v1[3]);
                    *(u32x4*)rowp = w; }
            asm volatile("" ::: "memory"); }
    }
};
template <bool DIRECT> struct EpiSwiglu {
    static constexpr bool PERM = true;
    bf16* O; int ldc; const void* rs;
    __device__ __forceinline__ void operator()(const Acc& acc, const Unit& u, int wr, int wc, int fr, int fq) const {
        { const int ln = lane_id(); fr = ln & 15; fq = ln >> 4; }
        const int row0 = u.pm * BM + wr * 64 + fr, col0 = u.pn * HALF + wc * 32 + 8 * fq;
#pragma unroll
        for (int ai = 0; ai < 2; ++ai)
#pragma unroll
            for (int m = 0; m < 4; ++m) { const int row = row0 + ai * HALF + m * 16; const float sc = DIRECT ? ((const float*)rs)[row] : rstd_ss(((const u64*)rs)[row]);
                u32x4 w;
#pragma unroll
                for (int n = 0; n < 2; ++n) { const f32x4 g = acc[ai][0][m][n] * sc, uu = acc[ai][1][m][n] * sc;
                    const float o0 = silu_f(g[0]) * uu[0], o1 = silu_f(g[1]) * uu[1], o2 = silu_f(g[2]) * uu[2], o3 = silu_f(g[3]) * uu[3];
                    w[2 * n] = pk_bf16(o0, o1); w[2 * n + 1] = pk_bf16(o2, o3); }
                *(u32x4*)(O + (size_t)row * ldc + col0) = w;
                asm volatile("" ::: "memory"); }
    }
};
struct EpiSwiglu8 {
    static constexpr bool PERM = true;
    unsigned char* O; int ldc; const float* rs;
    __device__ __forceinline__ void operator()(const Acc& acc, const Unit& u, int wr, int wc, int fr, int fq) const {
        { const int ln = lane_id(); fr = ln & 15; fq = ln >> 4; }
        const int row0 = u.pm * BM + wr * 64 + fr, col0 = u.pn * HALF + wc * 32 + 8 * fq;
#pragma unroll
        for (int ai = 0; ai < 2; ++ai)
#pragma unroll
            for (int m = 0; m < 4; ++m) { const int row = row0 + ai * HALF + m * 16; const float sc = rs[row] * (1.0f / S8_UP);
                u32x2 w;
#pragma unroll
                for (int n = 0; n < 2; ++n) { const f32x4 g = acc[ai][0][m][n] * sc, uu = acc[ai][1][m][n] * sc;
                    w[n] = pk_fp8x4(silu_f(g[0]) * uu[0], silu_f(g[1]) * uu[1], silu_f(g[2]) * uu[2], silu_f(g[3]) * uu[3]); }
                *(u32x2*)(O + (size_t)row * ldc + col0) = w;
                asm volatile("" ::: "memory"); }
    }
};
template <bool SCATTER, bool WRITE_XB, bool ACC_SS> struct EpiResid {
    static constexpr bool PERM = true;
    const float* Xin; float* X; bf16* XB; u64* ss_out; const int* perm; const float* gp; float gscale; bool xb8;
    __device__ __forceinline__ void operator()(const Acc& acc, const Unit& u, int wr, int wc, int fr, int fq) const {
        { const int ln = lane_id(); fr = ln & 15; fq = ln >> 4; }
        const int row0 = u.pm * BM + wr * 64 + fr, col0 = u.pn * BM + wc * 32 + 8 * fq;
#pragma unroll
        for (int ai = 0; ai < 2; ++ai)
#pragma unroll
            for (int m = 0; m < 4; ++m) { int row = row0 + ai * HALF + m * 16; float gate = 1.0f; bool valid = true;
                if (SCATTER) { const int tok = perm[row]; gate = gp[row] * gscale; valid = tok >= 0; row = valid ? tok : 0; }
                float ss = 0.f;
                if (valid) {
#pragma unroll
                    for (int bj = 0; bj < 2; ++bj) { float* xp = X + (size_t)row * D + col0 + bj * HALF; const float* xi = Xin + (size_t)row * D + col0 + bj * HALF;
                        f32x4 n0 = *(const f32x4*)xi, n1 = *(const f32x4*)(xi + 4);
                        n0 += acc[ai][bj][m][0] * gate; n1 += acc[ai][bj][m][1] * gate;
                        *(f32x4*)xp = n0; *(f32x4*)(xp + 4) = n1;
                        if (WRITE_XB) {
                            if (xb8) { u32x2 w; w.x = pk_fp8x4(n0[0], n0[1], n0[2], n0[3]); w.y = pk_fp8x4(n1[0], n1[1], n1[2], n1[3]); *(u32x2*)((unsigned char*)XB + (size_t)row * D + col0 + bj * HALF) = w; }
                            else { u32x4 w; w.x = pk_bf16(n0[0], n0[1]); w.y = pk_bf16(n0[2], n0[3]); w.z = pk_bf16(n1[0], n1[1]); w.w = pk_bf16(n1[2], n1[3]);
                                *(u32x4*)(XB + (size_t)row * D + col0 + bj * HALF) = w; } }
                        if (ACC_SS) ss += (n0[0] * n0[0] + n0[1] * n0[1]) + (n0[2] * n0[2] + n0[3] * n0[3]) + (n1[0] * n1[0] + n1[1] * n1[1]) + (n1[2] * n1[2] + n1[3] * n1[3]);
                        asm volatile("" ::: "memory"); }
                }
                if (ACC_SS) { ss += shfl_xor_f(ss, 16); ss += shfl_xor_f(ss, 32);
                    if (fq == 0 && valid && ss_out) (void)__hip_atomic_fetch_add(ss_out + row, ss_to_fix(ss), __ATOMIC_RELAXED, __HIP_MEMORY_SCOPE_AGENT); }
                asm volatile("" ::: "memory"); }
    }
};

__device__ __forceinline__ void load_offs(const Gemm& g, const Unit& u, const int (&Rr)[2], const int (&Cc)[2], unsigned (&o)[2][2]) {
#pragma unroll
    for (int h = 0; h < 2; ++h)
#pragma unroll
        for (int i = 0; i < 2; ++i) { int row = g.perm[u.pm * BM + h * HALF + Rr[i]]; row = row < 0 ? 0 : row; o[h][i] = (unsigned)(row * g.K + Cc[i]) * 2u; }
}

template <class Epi, class Sched, bool ALIGN_EPI, bool GATHER, bool FP8 = false>
__device__ __forceinline__ void gemm_phase(LAS unsigned char* lds, const Gemm g, const Sched& S, const Epi& E, int wave_id) {
    int tid_ = wave_id * 64 + lane_id(); asm volatile("" : "+v"(tid_));
    const int tid = tid_, wid = __builtin_amdgcn_readfirstlane(tid >> 6), lane = tid & 63, wr = wid >> 2, wc = wid & 3, fr = lane & 15, fq = lane >> 4;
    const int K = g.K, nt = K / BK;
    int Rr[2], Cc[2]; unsigned voffA[2], voffB[2];
#pragma unroll
    for (int i = 0; i < 2; ++i) { int R, C; stage_rc(tid * 16 + i * 8192, R, C); Rr[i] = R; Cc[i] = C; const int Rb = Epi::PERM ? ((R & ~31) + perm32(R & 31)) : R;
        voffA[i] = (unsigned)(R * K + C) * 2u; voffB[i] = (unsigned)(Rb * K + C) * 2u; }
    const size_t kstep = (size_t)(BK * 2);
    const size_t hstep = (size_t)HALF * K * 2;
    const size_t tstep = 2 * hstep;
    const unsigned ldsw = (unsigned)wid * 1024u, ldsbase = (unsigned)(size_t)lds;
    const int aoff = lds_byte(wr * 64 + fr, fq * 8), boff = lds_byte(wc * 32 + fr, fq * 8);
#define PG8_SA(b, h) (((b) * 2 + (h)) * HTB)
#define PG8_SB(b, h) ((4 + (b) * 2 + (h)) * HTB)
#define PG8_STAGE(bufoff, gbase, voff) do { _Pragma("unroll") for (int _i = 0; _i < 2; ++_i) glds_s((const void*)(gbase), (voff)[_i], ldsbase + (unsigned)(bufoff) + ldsw + _i * 8192u); } while (0)
#define PG8_STAGE_A(bufoff, gbase, h) do { if constexpr (GATHER) PG8_STAGE(bufoff, gbase, offA[h]); else PG8_STAGE(bufoff, (gbase) + (h) * hstep, voffA); } while (0)
#define PG8_LDA(dst, b, h) do { _Pragma("unroll") for (int m = 0; m < 4; ++m) _Pragma("unroll") for (int k = 0; k < 2; ++k) dst[m][k] = *(const LAS bf16x8*)(lds + PG8_SA(b, h) + aoff + m * 2048 + k * 1024); } while (0)
#define PG8_LDB(dst, b, h) do { _Pragma("unroll") for (int n = 0; n < 2; ++n) _Pragma("unroll") for (int k = 0; k < 2; ++k) dst[n][k] = *(const LAS bf16x8*)(lds + PG8_SB(b, h) + boff + n * 2048 + k * 1024); } while (0)
#define PG8_CAT8(x) __builtin_shufflevector(__builtin_bit_cast(i32x4, (x)[0]), __builtin_bit_cast(i32x4, (x)[1]), 0, 1, 2, 3, 4, 5, 6, 7)
#define PG8_MMA(ai, bj, At, Bt) do { __builtin_amdgcn_s_setprio(1); \
        if constexpr (FP8) { _Pragma("unroll") for (int m = 0; m < 4; ++m) _Pragma("unroll") for (int n = 0; n < 2; ++n) \
            acc[ai][bj][m][n] = __builtin_amdgcn_mfma_scale_f32_16x16x128_f8f6f4(PG8_CAT8(Bt[n]), PG8_CAT8(At[m]), acc[ai][bj][m][n], 0, 0, 0, 0x7F7F7F7F, 0, 0x7F7F7F7F); } \
        else { _Pragma("unroll") for (int m = 0; m < 4; ++m) _Pragma("unroll") for (int n = 0; n < 2; ++n) _Pragma("unroll") for (int k = 0; k < 2; ++k) \
            acc[ai][bj][m][n] = __builtin_amdgcn_mfma_f32_16x16x32_bf16(Bt[n][k], At[m][k], acc[ai][bj][m][n], 0, 0, 0); } \
        __builtin_amdgcn_s_setprio(0); } while (0)
#define PG8_WAIT_V(n) asm volatile("s_waitcnt vmcnt(" #n ")" ::: "memory")
#define PG8_WAIT_L(n) asm volatile("s_waitcnt lgkmcnt(" #n ")" ::: "memory")
#define PG8_BAR __builtin_amdgcn_s_barrier()
#define PG8_SCHED __builtin_amdgcn_sched_barrier(0)
    Unit cur, nxt; int ui = 0;
    if (!S.next(0, cur)) return;
    Acc acc;
#pragma unroll
    for (int a = 0; a < 2; ++a)
#pragma unroll
        for (int b = 0; b < 2; ++b)
#pragma unroll
            for (int m = 0; m < 4; ++m)
#pragma unroll
                for (int n = 0; n < 2; ++n) acc[a][b][m][n] = (f32x4){0.f, 0.f, 0.f, 0.f};
    bf16x8 At[4][2], B0[2][2], B1[2][2];
    unsigned offA[2][2], offN[2][2];
    if constexpr (GATHER) load_offs(g, cur, Rr, Cc, offA);
    const char* cA = GATHER ? (const char*)g.A : (const char*)g.A + (size_t)cur.pm * tstep; const char* cB = (const char*)g.Bt + (size_t)cur.brow * tstep;
    PG8_STAGE(PG8_SB(0, 0), cB, voffB); PG8_STAGE(PG8_SB(0, 1), cB + hstep, voffB); PG8_STAGE_A(PG8_SA(0, 0), cA, 0); PG8_STAGE_A(PG8_SA(0, 1), cA, 1);
    if (wr == 1) PG8_BAR;
    PG8_WAIT_V(2); PG8_BAR;
    PG8_STAGE(PG8_SB(1, 0), cB + kstep, voffB); PG8_STAGE_A(PG8_SA(1, 0), cA + kstep, 0); PG8_STAGE(PG8_SB(1, 1), cB + hstep + kstep, voffB);
    PG8_WAIT_V(6); PG8_BAR;
    for (;;) {
        const bool has_next = S.next(ui + 1, nxt);
        if constexpr (GATHER) { if (has_next) load_offs(g, nxt, Rr, Cc, offN); else {
#pragma unroll
            for (int h = 0; h < 2; ++h)
#pragma unroll
                for (int i = 0; i < 2; ++i) offN[h][i] = offA[h][i]; } }
        const char* nA = has_next ? (GATHER ? (const char*)g.A : (const char*)g.A + (size_t)nxt.pm * tstep) : cA; const char* nB = has_next ? (const char*)g.Bt + (size_t)nxt.brow * tstep : cB;
        for (int t = 0; t < nt; t += 2) {
            const bool last = (t == nt - 2);
            const char* a1 = cA + (size_t)(t + 1) * kstep;
            const char* a2 = last ? nA : cA + (size_t)(t + 2) * kstep; const char* b2 = last ? nB : cB + (size_t)(t + 2) * kstep;
            const char* a3 = a2 + kstep; const char* b3 = b2 + kstep;
            PG8_LDB(B0, 0, 0); PG8_LDB(B1, 0, 1); PG8_SCHED; PG8_LDA(At, 0, 0); PG8_STAGE_A(PG8_SA(1, 1), a1, 1);
            if constexpr (GATHER) { if (last) {
#pragma unroll
                for (int h = 0; h < 2; ++h)
#pragma unroll
                    for (int i = 0; i < 2; ++i) offA[h][i] = offN[h][i]; } }
            PG8_WAIT_V(8); PG8_WAIT_L(0); PG8_BAR; PG8_MMA(0, 0, At, B0); PG8_MMA(0, 1, At, B1); PG8_BAR; PG8_SCHED;
            PG8_LDA(At, 0, 1); PG8_STAGE(PG8_SB(0, 0), b2, voffB); PG8_STAGE(PG8_SB(0, 1), b2 + hstep, voffB); PG8_STAGE_A(PG8_SA(0, 0), a2, 0);
            PG8_WAIT_V(8); PG8_WAIT_L(0); PG8_BAR; PG8_MMA(1, 0, At, B0); PG8_MMA(1, 1, At, B1); PG8_BAR; PG8_SCHED;
            PG8_LDB(B0, 1, 0); PG8_LDB(B1, 1, 1); PG8_SCHED; PG8_LDA(At, 1, 0); PG8_STAGE_A(PG8_SA(0, 1), a2, 1);
            PG8_WAIT_V(8); PG8_WAIT_L(0); PG8_BAR; PG8_MMA(0, 0, At, B0); PG8_MMA(0, 1, At, B1); PG8_BAR; PG8_SCHED;
            PG8_LDA(At, 1, 1); PG8_STAGE(PG8_SB(1, 0), b3, voffB); PG8_STAGE(PG8_SB(1, 1), b3 + hstep, voffB); PG8_STAGE_A(PG8_SA(1, 0), a3, 0);
            PG8_WAIT_V(8); PG8_WAIT_L(0); PG8_BAR; PG8_MMA(1, 0, At, B0); PG8_MMA(1, 1, At, B1); PG8_BAR; PG8_SCHED;
        }
        if constexpr (ALIGN_EPI) { if (wr == 0) PG8_BAR; }
        E(acc, cur, wr, wc, fr, fq);
        if (!has_next) break;
#pragma unroll
        for (int a = 0; a < 2; ++a)
#pragma unroll
            for (int b = 0; b < 2; ++b)
#pragma unroll
                for (int m = 0; m < 4; ++m)
#pragma unroll
                    for (int n = 0; n < 2; ++n) acc[a][b][m][n] = (f32x4){0.f, 0.f, 0.f, 0.f};
        cur = nxt; cA = nA; cB = nB; ++ui;
        if constexpr (ALIGN_EPI) { if (wr == 1) PG8_BAR; }
    }
    PG8_WAIT_V(0);
    if constexpr (!ALIGN_EPI) { if (wr == 0) PG8_BAR; }
    PG8_BAR;
#undef PG8_SA
#undef PG8_SB
#undef PG8_STAGE
#undef PG8_STAGE_A
#undef PG8_LDA
#undef PG8_LDB
#undef PG8_MMA
#undef PG8_CAT8
#undef PG8_WAIT_V
#undef PG8_WAIT_L
#undef PG8_BAR
#undef PG8_SCHED
}
}

#define XB_TMO      128
#define XB_XCNT(j)  (256  + 64 * (j))
#define XB_XSUB(j)  (1280 + 64 * (j))
#define XB_XGEN(j)  (2304 + 64 * (j))
#define XB_TOP      3328
#define XB_TOPGEN   3392
#define XCD_BAR_WORDS 3456
#define XB_SPIN_CAP (1u << 18)
__device__ __forceinline__ unsigned xb_ld(unsigned* p)              { return __hip_atomic_load(p, __ATOMIC_RELAXED, __HIP_MEMORY_SCOPE_AGENT); }
__device__ __forceinline__ unsigned xb_add(unsigned* p, unsigned v) { return __hip_atomic_fetch_add(p, v, __ATOMIC_RELAXED, __HIP_MEMORY_SCOPE_AGENT); }
__device__ __forceinline__ unsigned xb_xcc_id() { return (unsigned)__builtin_amdgcn_s_getreg((3 << 11) | 20) & 0xFu; }
#define XB_SPIN(cond, bar) do { unsigned _sp = 0; while (cond) { __builtin_amdgcn_s_sleep(1); \
    if ((++_sp & 255u) == 0u) { if (xb_ld(&(bar)[XB_TMO])) break; if (_sp > XB_SPIN_CAP) { atomicAdd(&(bar)[XB_TMO], 1u); break; } } } } while (0)
struct XcdBarrier { unsigned* bar; unsigned x; volatile LAS unsigned* st; };
__device__ __forceinline__ XcdBarrier xcd_barrier_post(unsigned* bar, volatile LAS unsigned* st) {
    XcdBarrier b; b.bar = bar; b.x = xb_xcc_id(); b.st = st;
    if (threadIdx.x == 0) (void)xb_add(&bar[XB_XCNT(b.x)], 1u);
    return b;
}
__device__ __forceinline__ void xcd_barrier_complete(unsigned* bar, unsigned x, unsigned& nloc, unsigned& nx) {
    const unsigned G = gridDim.x * gridDim.y * gridDim.z;
    unsigned sum, cnt, mine, sp = 0u;
    for (;;) {
        sum = 0u; cnt = 0u; mine = 0u;
#pragma unroll
        for (unsigned j = 0; j < 16; ++j) { const unsigned c = xb_ld(&bar[XB_XCNT(j)]); sum += c; cnt += (c > 0u) ? 1u : 0u; mine = (j == x) ? c : mine; }
        if (sum == G) break;
        __builtin_amdgcn_s_sleep(1);
        if ((++sp & 255u) == 0u) { if (xb_ld(&bar[XB_TMO])) break; if (sp > XB_SPIN_CAP) { atomicAdd(&bar[XB_TMO], 1u); break; } }
    }
    nloc = mine > 0u ? mine : 1u; nx = cnt > 0u ? cnt : 1u;
}
__device__ __forceinline__ void xcd_barrier(const XcdBarrier& b) {
    asm volatile("s_waitcnt vmcnt(0)" ::: "memory");
    __syncthreads();
    if (threadIdx.x == 0) {
        unsigned* bar = b.bar;
        __builtin_amdgcn_s_waitcnt(0);
        unsigned nloc = b.st[0], nx = b.st[1];
        if (nloc == 0u) { xcd_barrier_complete(bar, b.x, nloc, nx); b.st[0] = nloc; b.st[1] = nx; }
        const unsigned old = xb_add(&bar[XB_XSUB(b.x)], 1u);
        const unsigned gen = old / nloc;
        if (old + 1u == (gen + 1u) * nloc) {
            __builtin_amdgcn_fence(__ATOMIC_RELEASE, "agent");
            asm volatile("s_waitcnt vmcnt(0)" ::: "memory");
            const unsigned og = xb_add(&bar[XB_TOP], 1u);
            const unsigned tg = og / nx;
            if (og + 1u == (tg + 1u) * nx) xb_add(&bar[XB_TOPGEN], 1u);
            else XB_SPIN(xb_ld(&bar[XB_TOPGEN]) == tg, bar);
            __builtin_amdgcn_fence(__ATOMIC_ACQUIRE, "agent");
            xb_add(&bar[XB_XGEN(b.x)], 1u);
            asm volatile("s_waitcnt vmcnt(0)" ::: "memory");
        } else {
            XB_SPIN(xb_ld(&bar[XB_XGEN(b.x)]) == gen, bar);
            __builtin_amdgcn_fence(__ATOMIC_ACQUIRE, "agent");
            asm volatile("s_waitcnt vmcnt(0)" ::: "memory");
        }
    }
    __syncthreads();
}

struct Args { const float* in[31]; float* out; unsigned char* ws; int ph_lo, ph_hi; };
typedef const __attribute__((address_space(4))) Args* ArgsP;

struct CvtDesc { const float* W; const float* gain; unsigned char* WT; int N, Kd, k0, n0, drow0; float qs; };
__device__ __forceinline__ CvtDesc cvt_decode(ArgsP a, int it) {
    constexpr int I_IN = 16 * 56, I_SQ = 16 * 32, I_UP = 16 * 88, I_DN = 44 * 32, I_LAYER = I_IN + 5 * I_SQ, I_FFN = 2 * I_UP + I_DN;
    unsigned char* ws = a->ws; CvtDesc d; d.gain = nullptr; d.qs = 0.f;
    if (it < 2 * I_LAYER) {
        const int l = it / I_LAYER; int r = it - l * I_LAYER;
        if (r < I_IN) { d.W = a->in[3] + (size_t)l * D * DIN; d.N = DIN; d.gain = a->in[2] + l * D; d.WT = ws + WS_WIN + (size_t)l * DIN * D * 2; d.Kd = D; d.k0 = 64 * (r / 56); d.n0 = 32 * (r % 56); d.drow0 = d.n0; }
        else { r -= I_IN; const int m = r / I_SQ; r -= m * I_SQ; d.N = D; d.Kd = D; d.k0 = 64 * (r / 32); d.n0 = 32 * (r % 32); d.drow0 = d.n0; const size_t lo = (size_t)l * D * D;
            if (m == 0)      { d.W = a->in[15] + lo; d.WT = ws + WS_WOUT + lo * 2; }
            else if (m == 1) { d.W = a->in[18] + lo; d.gain = a->in[16] + l * D; d.WT = ws + WS_WQ + lo * 2; }
            else if (m == 2) { d.W = a->in[19] + lo; d.gain = a->in[17] + l * D; d.WT = ws + WS_WK + lo * 2; }
            else if (m == 3) { d.W = a->in[20] + lo; d.gain = a->in[17] + l * D; d.WT = ws + WS_WV + lo * 2; }
            else             { d.W = a->in[21] + lo; d.WT = ws + WS_WO + lo * 2; } }
    } else {
        it -= 2 * I_LAYER; const int ex = it / I_FFN; int r = it - ex * I_FFN;
        const float *wg, *wu, *wd, *gn;
        if (ex == 0) { wg = a->in[23]; wu = a->in[24]; wd = a->in[25]; gn = a->in[22]; }
        else { const size_t e = ex - 1; wg = a->in[27] + e * D * DFF; wu = a->in[28] + e * D * DFF; wd = a->in[29] + e * DFF * D; gn = a->in[22] + D; }
        const bool up = r < 2 * I_UP;
        if (up) { const int isu = r >= I_UP; r -= isu * I_UP; d.W = isu ? wu : wg; d.N = DFF; d.gain = gn; d.Kd = D; d.k0 = 64 * (r / 88); d.n0 = 32 * (r % 88); d.drow0 = (d.n0 >> 7) * 256 + (d.n0 & 127) + (isu ? 128 : 0); }
        else { r -= 2 * I_UP; d.W = wd; d.N = D; d.Kd = DFF; d.k0 = 64 * (r / 32); d.n0 = 32 * (r % 32); d.drow0 = d.n0; }
        if (ex == 0) d.WT = up ? ws + WS_WGU : ws + WS_WD;
        else { const size_t e = ex - 1; d.WT = up ? ws + WS_MWGU + e * 2 * DFF * D : ws + WS_MWD + e * D * DFF; d.qs = up ? S8_UP : S8_DN; }
    }
    return d;
}
__device__ __forceinline__ void cvt_load(const CvtDesc& d, int lane, f32x4 (&v)[8], float (&g)[8]) {
    const float* p = d.W + (size_t)(d.k0 + (lane >> 3)) * d.N + d.n0 + 4 * (lane & 7);
#pragma unroll
    for (int j = 0; j < 8; ++j) { v[j] = *(const f32x4*)(p + (size_t)(8 * j) * d.N); g[j] = d.gain ? d.gain[d.k0 + (lane >> 3) + 8 * j] : 1.0f; }
}
__device__ __forceinline__ void cvt_store(const CvtDesc& d, int lane, const f32x4 (&v)[8], const float (&g)[8], LAS float* scr) {
    const float qm = d.qs != 0.f ? d.qs : 1.0f;
#pragma unroll
    for (int j = 0; j < 8; ++j) { LAS float* sp = scr + ((lane >> 3) + 8 * j) * 33 + 4 * (lane & 7); const float m = g[j] * qm;
        sp[0] = v[j][0] * m; sp[1] = v[j][1] * m; sp[2] = v[j][2] * m; sp[3] = v[j][3] * m; }
    asm volatile("s_waitcnt lgkmcnt(0)" ::: "memory");
    if (d.qs == 0.f) { const int c = lane & 7;
#pragma unroll
        for (int j = 0; j < 4; ++j) { const int n = (lane >> 3) + 8 * j; const LAS float* s = scr + (8 * c) * 33 + n;
            u32x4 o; o.x = pk_bf16(s[0 * 33], s[1 * 33]); o.y = pk_bf16(s[2 * 33], s[3 * 33]); o.z = pk_bf16(s[4 * 33], s[5 * 33]); o.w = pk_bf16(s[6 * 33], s[7 * 33]);
            *(u32x4*)(d.WT + ((size_t)(d.drow0 + n) * d.Kd + d.k0 + 8 * c) * 2) = o; }
    } else { const int c = lane & 3;
#pragma unroll
        for (int j = 0; j < 2; ++j) { const int n = (lane >> 2) + 16 * j; const LAS float* s = scr + (16 * c) * 33 + n;
            u32x4 o; o.x = pk_fp8x4(s[0 * 33], s[1 * 33], s[2 * 33], s[3 * 33]); o.y = pk_fp8x4(s[4 * 33], s[5 * 33], s[6 * 33], s[7 * 33]);
            o.z = pk_fp8x4(s[8 * 33], s[9 * 33], s[10 * 33], s[11 * 33]); o.w = pk_fp8x4(s[12 * 33], s[13 * 33], s[14 * 33], s[15 * 33]);
            *(u32x4*)(d.WT + (size_t)(d.drow0 + n) * d.Kd + d.k0 + 16 * c) = o; }
    }
    asm volatile("s_waitcnt lgkmcnt(0)" ::: "memory");
}

__device__ __forceinline__ void phase_prologue(ArgsP a, LAS unsigned char* lds, int vcu, int G, int tid, int lane, int wave) {
    unsigned char* ws = a->ws;
    LAS float* scr = (LAS float*)(lds + wave * 16384);
    const int gw = vcu * NWAVES + wave, NGW = G * NWAVES;
    constexpr int NITEMS = 2 * (16 * 56 + 5 * 16 * 32) + 9 * (2 * 16 * 88 + 44 * 32);
    {
        u64* rowss0 = (u64*)(ws + OFF_ROWSS);
        for (int m0 = 2 * gw; m0 < T + MROWS; m0 += 2 * NGW) {
            f32x4 v[2][4];
#pragma unroll
            for (int q = 0; q < 2; ++q) { const int m = m0 + q; const bool isx = m < T; const int r = isx ? m : m - T;
                const f32x4* xr = (const f32x4*)((isx ? a->in[0] : a->in[1]) + (size_t)r * D) + lane;
#pragma unroll
                for (int j = 0; j < 4; ++j) v[q][j] = xr[64 * j]; }
#pragma unroll
            for (int q = 0; q < 2; ++q) { const int m = m0 + q; const bool isx = m < T; const int r = isx ? m : m - T; float s = 0.f;
#pragma unroll
                for (int j = 0; j < 4; ++j) s += (v[q][j][0] * v[q][j][0] + v[q][j][1] * v[q][j][1]) + (v[q][j][2] * v[q][j][2] + v[q][j][3] * v[q][j][3]);
                s = wave_sum(s);
                u32x2* o8 = (u32x2*)((isx ? (bf16*)(ws + WS_XB) : (bf16*)(ws + WS_MEMB)) + (size_t)r * D) + lane;
#pragma unroll
                for (int j = 0; j < 4; ++j) { u32x2 w; w.x = pk_bf16(v[q][j][0], v[q][j][1]); w.y = pk_bf16(v[q][j][2], v[q][j][3]); o8[64 * j] = w; }
                if (lane == 0) { if (isx) rowss0[r] = ss_to_fix(s); else ((u64*)(ws + OFF_MEMSS))[r] = ss_to_fix(s); } }
        }
    }
    if (gw < NITEMS) {
        CvtDesc d0 = cvt_decode(a, gw); f32x4 v[8]; float g[8]; cvt_load(d0, lane, v, g);
        for (int it = gw; it < NITEMS; it += NGW) {
            const int itn = it + NGW; const bool hn = itn < NITEMS;
            CvtDesc dn = d0; f32x4 w[8]; float gn[8];
            if (hn) { dn = cvt_decode(a, itn); cvt_load(dn, lane, w, gn); }
            cvt_store(d0, lane, v, g, scr);
            if (hn) { d0 = dn;
#pragma unroll
                for (int j = 0; j < 8; ++j) { v[j] = w[j]; g[j] = gn[j]; } }
        }
    }
    const int gt = vcu * NTHREADS + tid, NGT = G * NTHREADS;
    for (int i = gt; i < 2 * 4 * 128 * 128; i += NGT) { const int ii = (i >> 7) & 127, jj = i & 127; const float v = a->in[10][i]; ((bf16*)(ws + WS_SGUW))[i] = f2bf(((ii >> 6) >= (jj >> 6)) ? v : 0.f); }
    for (int i = gt; i < 2 * 4 * 64 * 64; i += NGT) { const int lg = i >> 12, o = (i >> 6) & 63, ii = i & 63; ((bf16*)(ws + WS_POOLW))[i] = f2bf(a->in[12][(lg << 12) + ii * 64 + o]); }
}

__device__ __forceinline__ void mixer_unit(ArgsP a, LAS unsigned char* lds, int l, int u, int tid_in, int lane_in, int wave) {
    int tid = tid_in, lane = lane_in;
    const bf16* z = (const bf16*)(a->ws + WS_Z); bf16* mixed = (bf16*)(a->ws + WS_MIXED);
    const int b = u >> 5, c = u & 31, t0 = c * 128; const size_t R0 = (size_t)b * SEQ + t0;
    {
        const float* cw = a->in[4] + l * 31 * 384; const float* cb = a->in[5] + l * 384; const float* lg = a->in[6] + l * 384; const float* lb = a->in[7] + l * 384;
        for (int it = tid; it < 158 * 48; it += NTHREADS) { const int j = it / 48, v = it - j * 48; u32x4 o = {0u, 0u, 0u, 0u};
            if (t0 - 30 + j >= 0) { const bf16* rp = z + (R0 + j - 30) * DIN + 8 * v; const u32x4 av = *(const u32x4*)rp, gv = *(const u32x4*)(rp + 384);
#pragma unroll
                for (int q = 0; q < 4; ++q) o[q] = pk_bf16(bf_lo(av[q]) * sigm(bf_lo(gv[q])), bf_hi(av[q]) * sigm(bf_hi(gv[q]))); }
            *(LAS u32x4*)(lds + j * 768 + v * 16) = o; }
        __syncthreads();
        LAS float* part = (LAS float*)(lds + 122880);
        OPAQUE(tid); lane = tid & 63;
#pragma unroll 1
        for (int jt = 0; jt < 3; ++jt) { const int item = tid + NTHREADS * jt, rg = item / 192, p = item - rg * 192, q3 = p >> 6;
            f32x2 w[31];
#pragma unroll
            for (int k = 0; k < 31; ++k) w[k] = *(const f32x2*)(cw + k * 384 + 2 * p);
            const f32x2 bias = *(const f32x2*)(cb + 2 * p);
            float y0[16], y1[16];
#pragma unroll
            for (int i = 0; i < 16; ++i) { y0[i] = bias.x; y1[i] = bias.y; }
            const LAS unsigned* hp = (const LAS unsigned*)lds + (rg * 16) * 192 + p;
#pragma unroll
            for (int jj = 0; jj < 46; ++jj) { const unsigned hv = hp[jj * 192]; const float h0 = bf_lo(hv), h1 = bf_hi(hv);
#pragma unroll
                for (int i = 0; i < 16; ++i) { const int k = jj - i; if (k >= 0 && k <= 30) { y0[i] += w[k].x * h0; y1[i] += w[k].y * h1; } } }
#pragma unroll
            for (int i = 0; i < 16; ++i) { float s1 = y0[i] + y1[i], s2 = y0[i] * y0[i] + y1[i] * y1[i];
                s1 = wave_sum(s1); s2 = wave_sum(s2);
                if (lane == 0) { part[((rg * 16 + i) * 3 + q3) * 2] = s1; part[((rg * 16 + i) * 3 + q3) * 2 + 1] = s2; }
                *(unsigned*)(mixed + (R0 + rg * 16 + i) * D + 2 * p) = pk_bf16(y0[i], y1[i]); }
        }
        __syncthreads();
        OPAQUE(tid);
#pragma unroll 1
        for (int jt = 0; jt < 3; ++jt) { const int item = tid + NTHREADS * jt, rg = item / 192, p = item - rg * 192;
            const f32x2 g2 = *(const f32x2*)(lg + 2 * p), b2 = *(const f32x2*)(lb + 2 * p);
#pragma unroll
            for (int i = 0; i < 16; ++i) { const int row = rg * 16 + i; const LAS float* pr = part + row * 6;
                const float S1 = pr[0] + pr[2] + pr[4], S2 = pr[1] + pr[3] + pr[5];
                const float mean = S1 * (1.0f / 384.0f), var = S2 * (1.0f / 384.0f) - mean * mean, rstd = __builtin_amdgcn_rsqf(var + EPS);
                unsigned* mp = (unsigned*)(mixed + (R0 + row) * D + 2 * p); const unsigned yv = *mp;
                const float o0 = (bf_lo(yv) - mean) * rstd * g2.x + b2.x, o1 = (bf_hi(yv) - mean) * rstd * g2.y + b2.y;
                *mp = pk_bf16(silu_f(o0), silu_f(o1)); } }
    }
    {
        OPAQUE(tid); lane = tid & 63;
        const bf16* pwT = (const bf16*)(a->ws + WS_POOLW) + l * 4 * 64 * 64; const float* pb = a->in[13] + l * 256; const float* psc = a->in[14] + l * 256;
        for (int it = tid; it < 143 * 32; it += NTHREADS) { const int j = it >> 5, v = it & 31; u32x4 o = {0u, 0u, 0u, 0u};
            if (t0 - 15 + j >= 0) o = *(const u32x4*)(z + (R0 + j - 15) * DIN + 1536 + 8 * v);
            *(LAS u32x4*)(lds + j * 512 + v * 16) = o; }
        __syncthreads();
        OPAQUE(tid);
        { const int pp = tid & 127, rq = tid >> 7; const int w = 2 << (pp >> 5); const LAS unsigned* cp = (const LAS unsigned*)lds + pp; const int i0 = rq * 32;
            float s0 = 0.f, s1 = 0.f;
#pragma unroll
            for (int kk = 0; kk < 16; ++kk) if (kk < w) { const unsigned v = cp[(i0 + 15 - kk) * 128]; s0 += bf_lo(v); s1 += bf_hi(v); }
            for (int ii = 0; ii < 32; ++ii) { const int i = i0 + ii; const unsigned cv = cp[(i + 15) * 128];
                const int tpos = t0 + i + 1; const float inv = 1.0f / (float)(tpos < w ? tpos : w);
                *(LAS unsigned*)(lds + 73728 + i * 528 + pp * 4) = pk_bf16(s0 * inv - bf_lo(cv), s1 * inv - bf_hi(cv));
                if (ii < 31) { const unsigned vn = cp[(i + 16) * 128], vo = cp[(i + 16 - w) * 128]; s0 += bf_lo(vn) - bf_lo(vo); s1 += bf_hi(vn) - bf_hi(vo); } } }
        __syncthreads();
        OPAQUE(tid); lane = tid & 63;
        { const int r = lane & 15, kq = lane >> 4; f32x4 acc[4][4];
#pragma unroll
            for (int g = 0; g < 4; ++g)
#pragma unroll
                for (int n = 0; n < 4; ++n) acc[g][n] = (f32x4){0.f, 0.f, 0.f, 0.f};
#pragma unroll
            for (int g = 0; g < 4; ++g)
#pragma unroll
                for (int ks = 0; ks < 2; ++ks) { const bf16x8 af = *(const LAS bf16x8*)(lds + 73728 + (16 * wave + r) * 528 + (g * 64 + 32 * ks + 8 * kq) * 2);
#pragma unroll
                    for (int n = 0; n < 4; ++n) { const bf16x8 bfr = *(const bf16x8*)(pwT + ((g * 64 + 16 * n + r) * 64 + 32 * ks + 8 * kq));
                        acc[g][n] = __builtin_amdgcn_mfma_f32_16x16x32_bf16(bfr, af, acc[g][n], 0, 0, 0); } }
            const int row = 16 * wave + r;
#pragma unroll
            for (int g = 0; g < 4; ++g)
#pragma unroll
                for (int n = 0; n < 4; ++n) { const int ch = g * 64 + 16 * n + 4 * kq; const f32x4 b4 = *(const f32x4*)(pb + ch), s4 = *(const f32x4*)(psc + ch); const f32x4 o = (acc[g][n] + b4) * s4;
                    u32x2 w2; w2.x = pk_bf16(o[0], o[1]); w2.y = pk_bf16(o[2], o[3]); *(u32x2*)(mixed + (R0 + row) * D + 768 + ch) = w2; } }
        __syncthreads();
    }
    {
        OPAQUE(tid); lane = tid & 63;
        const float* lg = a->in[8] + l * 384; const float* lb = a->in[9] + l * 384; const float* sb = a->in[11] + l * 4 * 128;
        const bf16* Wm = (const bf16*)(a->ws + WS_SGUW) + (size_t)l * 4 * 128 * 128;
        for (int it = tid; it < 128 * 48; it += NTHREADS) { const int j = it / 48, v = it - j * 48; *(LAS u32x4*)(lds + j * 784 + v * 16) = *(const u32x4*)(z + (R0 + j) * DIN + 1152 + 8 * v); }
        __syncthreads();
        OPAQUE(tid);
        { const int j = tid & 127, qd = __builtin_amdgcn_readfirstlane(tid >> 7); float vv[96]; float s1 = 0.f, s2 = 0.f;
#pragma unroll
            for (int k = 0; k < 12; ++k) { const u32x4 x = *(const LAS u32x4*)(lds + j * 784 + qd * 192 + 16 * k);
#pragma unroll
                for (int q = 0; q < 4; ++q) { const float e0 = gelu_tanh(bf_lo(x[q])), e1 = gelu_tanh(bf_hi(x[q])); vv[8 * k + 2 * q] = e0; vv[8 * k + 2 * q + 1] = e1; s1 += e0 + e1; s2 += e0 * e0 + e1 * e1; } }
            LAS float* st = (LAS float*)(lds + 122880);
            st[(j * 4 + qd) * 2] = s1; st[(j * 4 + qd) * 2 + 1] = s2;
            __syncthreads();
            const float S1 = st[j * 8] + st[j * 8 + 2] + st[j * 8 + 4] + st[j * 8 + 6], S2 = st[j * 8 + 1] + st[j * 8 + 3] + st[j * 8 + 5] + st[j * 8 + 7];
            const float mean = S1 * (1.0f / 384.0f), var = S2 * (1.0f / 384.0f) - mean * mean, rstd = __builtin_amdgcn_rsqf(var + EPS);
#pragma unroll
            for (int cidx = 0; cidx < 96; ++cidx) { const float o = (vv[cidx] - mean) * rstd * lg[qd * 96 + cidx] + lb[qd * 96 + cidx];
                *(LAS bf16*)(lds + (qd * 96 + cidx) * 272 + j * 2) = f2bf(o); } }
        __syncthreads();
        OPAQUE(tid); lane = tid & 63;
        { const int hd = wave >> 1, ih = wave & 1, r = lane & 15, kq = lane >> 4; f32x4 acc[6][4];
#pragma unroll
            for (int dt = 0; dt < 6; ++dt)
#pragma unroll
                for (int it = 0; it < 4; ++it) acc[dt][it] = (f32x4){0.f, 0.f, 0.f, 0.f};
            const bf16* Wh = Wm + (size_t)hd * 128 * 128; const int nks = ih ? 4 : 2;
            for (int ks = 0; ks < nks; ++ks) { bf16x8 wf[4];
#pragma unroll
                for (int it = 0; it < 4; ++it) wf[it] = *(const bf16x8*)(Wh + (64 * ih + 16 * it + r) * 128 + 32 * ks + 8 * kq);
#pragma unroll
                for (int dt = 0; dt < 6; ++dt) { const bf16x8 vf = *(const LAS bf16x8*)(lds + (hd * 96 + 16 * dt + r) * 272 + (32 * ks + 8 * kq) * 2);
#pragma unroll
                    for (int it = 0; it < 4; ++it) acc[dt][it] = __builtin_amdgcn_mfma_f32_16x16x32_bf16(vf, wf[it], acc[dt][it], 0, 0, 0); } }
#pragma unroll
            for (int it = 0; it < 4; ++it) { const int i = 64 * ih + 16 * it + r; const float sbv = sb[hd * 128 + i];
#pragma unroll
                for (int dt = 0; dt < 6; ++dt) { const int ch = hd * 96 + 16 * dt + 4 * kq; const u32x2 uu = *(const u32x2*)(z + (R0 + i) * DIN + 768 + ch);
                    const float o0 = gelu_tanh(bf_lo(uu.x)) * (acc[dt][it][0] + sbv), o1 = gelu_tanh(bf_hi(uu.x)) * (acc[dt][it][1] + sbv);
                    const float o2 = gelu_tanh(bf_lo(uu.y)) * (acc[dt][it][2] + sbv), o3 = gelu_tanh(bf_hi(uu.y)) * (acc[dt][it][3] + sbv);
                    u32x2 w2; w2.x = pk_bf16(o0, o1); w2.y = pk_bf16(o2, o3); *(u32x2*)(mixed + (R0 + i) * D + 384 + ch) = w2; } } }
        __syncthreads();
    }
}

__device__ __forceinline__ void attn_unit(ArgsP a, LAS unsigned char* lds, int l, int u, int tid, int lane, int wave) {
    const bf16* Q = (const bf16*)(a->ws + WS_Q); bf16* O = (bf16*)(a->ws + WS_O);
    const bf16* KB = (const bf16*)(a->ws + WS_KB); const bf16* VT = (const bf16*)(a->ws + WS_VT);
    const int qt = u & 15, bh = u >> 4, b = bh >> 2, h = bh & 3;
    { const bf16* kp = KB + (size_t)(b * 256) * 2048 + l * 1024 + h * 256;
        for (int it = tid; it < 256 * 32; it += NTHREADS) { const int row = it >> 5, v = it & 31; *(LAS u32x4*)(lds + row * 528 + v * 16) = *(const u32x4*)(kp + (size_t)row * 2048 + 8 * v); } }
    __syncthreads();
    const int r = lane & 31, h2 = lane >> 5; const size_t qrow = (size_t)b * SEQ + qt * 256 + wave * 32 + r;
    f32x16 sacc[8];
#pragma unroll
    for (int kt = 0; kt < 8; ++kt)
#pragma unroll
        for (int j = 0; j < 16; ++j) sacc[kt][j] = 0.f;
    const bf16* qp = Q + qrow * D + h * 256 + 8 * h2;
#pragma unroll 4
    for (int s = 0; s < 16; ++s) { const bf16x8 qf = *(const bf16x8*)(qp + 16 * s);
#pragma unroll
        for (int kt = 0; kt < 8; ++kt) { const bf16x8 kf = *(const LAS bf16x8*)(lds + (32 * kt + r) * 528 + (16 * s + 8 * h2) * 2);
            sacc[kt] = __builtin_amdgcn_mfma_f32_32x32x16_bf16(kf, qf, sacc[kt], 0, 0, 0); } }
    float mx = -3.0e38f;
#pragma unroll
    for (int kt = 0; kt < 8; ++kt)
#pragma unroll
        for (int j = 0; j < 16; ++j) mx = fmaxf(mx, sacc[kt][j]);
    mx = fmaxf(mx, shfl_xor_f(mx, 32));
    float sum = 0.f; bf16x8 pf[8][2];
#pragma unroll
    for (int kt = 0; kt < 8; ++kt) {
        float p[16];
#pragma unroll
        for (int j = 0; j < 16; ++j) { p[j] = __builtin_amdgcn_exp2f(sacc[kt][j] - mx); sum += p[j]; }
#pragma unroll
        for (int s2 = 0; s2 < 2; ++s2) { u32x4 w; w.x = pk_bf16(p[8 * s2], p[8 * s2 + 1]); w.y = pk_bf16(p[8 * s2 + 2], p[8 * s2 + 3]); w.z = pk_bf16(p[8 * s2 + 4], p[8 * s2 + 5]); w.w = pk_bf16(p[8 * s2 + 6], p[8 * s2 + 7]);
            pf[kt][s2] = __builtin_bit_cast(bf16x8, w); } }
    sum += shfl_xor_f(sum, 32);
    const float inv = 1.0f / sum;
    __syncthreads();
    { const bf16* vp = VT + (size_t)(l * 1024 + h * 256) * 2048 + b * 256;
        for (int it = tid; it < 256 * 32; it += NTHREADS) { const int row = it >> 5, v = it & 31; const u32x4 x = *(const u32x4*)(vp + (size_t)row * 2048 + 8 * v);
            const int grp = v >> 1, odd = v & 1; LAS unsigned char* dst = lds + row * 528 + grp * 32 + odd * 8;
            *(LAS u32x2*)(dst) = (u32x2){x.x, x.y}; *(LAS u32x2*)(dst + 16) = (u32x2){x.z, x.w}; } }
    __syncthreads();
#pragma unroll
    for (int dh = 0; dh < 2; ++dh) {
        f32x16 oacc[4];
#pragma unroll
        for (int dt = 0; dt < 4; ++dt)
#pragma unroll
            for (int j = 0; j < 16; ++j) oacc[dt][j] = 0.f;
#pragma unroll
        for (int kt = 0; kt < 8; ++kt)
#pragma unroll
            for (int s2 = 0; s2 < 2; ++s2)
#pragma unroll
                for (int dt = 0; dt < 4; ++dt) { const bf16x8 vf = *(const LAS bf16x8*)(lds + (dh * 128 + 32 * dt + r) * 528 + (kt * 2 + s2) * 32 + 16 * h2);
                    oacc[dt] = __builtin_amdgcn_mfma_f32_32x32x16_bf16(vf, pf[kt][s2], oacc[dt], 0, 0, 0); }
        bf16* op = O + qrow * D + h * 256 + dh * 128 + 4 * h2;
#pragma unroll
        for (int dt = 0; dt < 4; ++dt)
#pragma unroll
            for (int g4 = 0; g4 < 4; ++g4) { u32x2 w; w.x = pk_bf16(oacc[dt][4 * g4] * inv, oacc[dt][4 * g4 + 1] * inv); w.y = pk_bf16(oacc[dt][4 * g4 + 2] * inv, oacc[dt][4 * g4 + 3] * inv);
                *(u32x2*)(op + 32 * dt + 8 * g4) = w; }
    }
    __syncthreads();
}

__device__ __forceinline__ void phase_router(ArgsP a, LAS unsigned char* lds, int vcu, int G, int tid, int lane, int wave) {
    unsigned char* ws = a->ws;
    LAS float* grw = (LAS float*)lds;
    LAS int* hist = (LAS int*)(lds + 32768);
    const float* gn = a->in[22] + D; const float* rw = a->in[26];
    for (int i = tid; i < D * NE; i += NTHREADS) grw[i] = gn[i >> 3] * rw[i];
    if (tid < 16) hist[tid] = 0;
    __syncthreads();
    const u64* rowss = (const u64*)(ws + OFF_ROWSS) + 5 * T;
    int* sel = (int*)(ws + WS_ROUTE); float* gate = (float*)(ws + WS_ROUTE + 2 * T * 4);
    const int gw = vcu * NWAVES + wave, NGW = G * NWAVES;
    for (int m = gw; m < T; m += NGW) {
        const f32x4* xr = (const f32x4*)(a->out + (size_t)m * D) + lane;
        float p[8];
#pragma unroll
        for (int e = 0; e < 8; ++e) p[e] = 0.f;
#pragma unroll
        for (int j = 0; j < 4; ++j) { const f32x4 x = xr[64 * j]; const int k0 = 4 * (lane + 64 * j);
#pragma unroll
            for (int q = 0; q < 4; ++q) { const f32x4 w0 = *(const LAS f32x4*)(grw + (k0 + q) * 8), w1 = *(const LAS f32x4*)(grw + (k0 + q) * 8 + 4);
                p[0] += x[q] * w0[0]; p[1] += x[q] * w0[1]; p[2] += x[q] * w0[2]; p[3] += x[q] * w0[3]; p[4] += x[q] * w1[0]; p[5] += x[q] * w1[1]; p[6] += x[q] * w1[2]; p[7] += x[q] * w1[3]; } }
        const float rstd = rstd_ss(rowss[m]);
#pragma unroll
        for (int e = 0; e < 8; ++e) p[e] = wave_sum(p[e]) * rstd;
        int i0 = 0; float v0 = p[0];
#pragma unroll
        for (int e = 1; e < 8; ++e) if (p[e] > v0) { v0 = p[e]; i0 = e; }
        int i1 = -1; float v1 = -3.0e38f;
#pragma unroll
        for (int e = 0; e < 8; ++e) if (e != i0 && p[e] > v1) { v1 = p[e]; i1 = e; }
        const float g0 = 1.0f / (1.0f + __expf(v1 - v0)), g1 = 1.0f - g0;
        if (lane == 0) { sel[m] = i0; sel[T + m] = i1; gate[m] = g0; gate[T + m] = g1; __hip_atomic_fetch_add(&hist[i0], 1, __ATOMIC_RELAXED, __HIP_MEMORY_SCOPE_WORKGROUP); __hip_atomic_fetch_add(&hist[8 + i1], 1, __ATOMIC_RELAXED, __HIP_MEMORY_SCOPE_WORKGROUP); }
    }
    __syncthreads();
    { int t3 = tid; OPAQUE(t3); if (t3 < 16) atomicAdd((int*)(ws + OFF_MOECNT) + t3, hist[t3]); }
}
__device__ __forceinline__ void phase_lists(ArgsP a, LAS unsigned char* lds, int vcu, int G, int tid) {
    unsigned char* ws = a->ws;
    const int* cnt = (const int*)(ws + OFF_MOECNT); int* cursor = (int*)(ws + OFF_MOECNT + 256);
    const u64* rowss = (const u64*)(ws + OFF_ROWSS) + 5 * T;
    const int* sel = (const int*)(ws + WS_ROUTE); const float* gate = (const float*)(ws + WS_ROUTE + 2 * T * 4);
    int* perm = (int*)(ws + WS_ROUTE + 4 * T * 4); float* rsp = (float*)(ws + WS_ROUTE + 4 * T * 4 + 2 * PERMROWS * 4); float* gp = (float*)(ws + WS_ROUTE + 4 * T * 4 + 4 * PERMROWS * 4);
    LAS int* lc = (LAS int*)lds;
    LAS int* lb = (LAS int*)(lds + 64);
    for (int chunk = vcu; chunk < T / 128; chunk += G)
        for (int s = 0; s < 2; ++s) {
            __syncthreads();
            if (tid < 8) lc[tid] = 0;
            __syncthreads();
            int e = 0, rnk = 0; const int tok = chunk * 128 + tid;
            if (tid < 128) { e = sel[s * T + tok]; rnk = __hip_atomic_fetch_add(&lc[e], 1, __ATOMIC_RELAXED, __HIP_MEMORY_SCOPE_WORKGROUP); }
            __syncthreads();
            if (tid < 8) lb[tid] = atomicAdd(cursor + s * 8 + tid, lc[tid]);
            __syncthreads();
            if (tid < 128) { int off = 0;
#pragma unroll
                for (int j = 0; j < 8; ++j) { const int tl = (cnt[s * 8 + j] + 255) >> 8; if (j < e) off += tl * 256; }
                const int pos = off + lb[e] + rnk;
                perm[s * PERMROWS + pos] = tok; rsp[s * PERMROWS + pos] = rstd_ss(rowss[tok]); gp[s * PERMROWS + pos] = gate[s * T + tok]; }
        }
    if (vcu < 16) { const int s = vcu >> 3, e = vcu & 7; int off = 0, ce = 0;
#pragma unroll
        for (int j = 0; j < 8; ++j) { const int cj = cnt[s * 8 + j]; const int tl = (cj + 255) >> 8; if (j < e) off += tl * 256; if (j == e) ce = cj; }
        const int end = off + ((ce + 255) >> 8) * 256;
        for (int pos = off + ce + tid; pos < end; pos += NTHREADS) { perm[s * PERMROWS + pos] = -1; rsp[s * PERMROWS + pos] = 0.f; gp[s * PERMROWS + pos] = 0.f; } }
}

__device__ __forceinline__ void phase_final(ArgsP a, int vcu, int G, int lane, int wave) {
    const u64* rowss = (const u64*)(a->ws + OFF_ROWSS) + 6 * T; const float* g = a->in[30];
    const int gw = vcu * NWAVES + wave, NGW = G * NWAVES;
    f32x4 gv[4];
#pragma unroll
    for (int j = 0; j < 4; ++j) gv[j] = ((const f32x4*)g)[lane + 64 * j];
    for (int m = gw; m < T; m += NGW) { f32x4* xr = (f32x4*)(a->out + (size_t)m * D) + lane; const float rstd = rstd_ss(rowss[m]);
#pragma unroll
        for (int j = 0; j < 4; ++j) xr[64 * j] = xr[64 * j] * rstd * gv[j]; }
}

__global__ void __launch_bounds__(NTHREADS, 2) fwd_kernel(Args args_byval) {
    extern __shared__ __attribute__((aligned(16))) unsigned char lds_raw[];
    LAS unsigned char* lds = (LAS unsigned char*)lds_raw;
    const int wave = __builtin_amdgcn_readfirstlane((int)threadIdx.x >> 6);
    const int G = gridDim.x; const int bx = blockIdx.x; const int vcu = (G % 8 == 0) ? (bx % 8) * (G / 8) + bx / 8 : bx;
#define ARGS() ArgsP args = (ArgsP)__builtin_amdgcn_kernarg_segment_ptr(); asm volatile("" : "+s"(args)); unsigned char* ws = args->ws; u64* rowss = (u64*)(ws + OFF_ROWSS); bf16* XB = (bf16*)(ws + WS_XB); (void)rowss; (void)XB
#define TID() (wave * 64 + lane_id())
    volatile LAS unsigned* MISC = (volatile LAS unsigned*)(lds + MISC_OFF);
    if (threadIdx.x < 64) MISC[threadIdx.x] = 0u;
    __syncthreads();
    int lo, hi; XcdBarrier bar;
    { ARGS(); lo = args->ph_lo; hi = args->ph_hi; bar.bar = (unsigned*)ws + CW_BAR; bar.x = 0; bar.st = nullptr;
      if (hi - lo > 1) bar = xcd_barrier_post((unsigned*)ws + CW_BAR, MISC + 8); }
#define IN(k) (lo <= (k) && (k) < hi)
#define SEAM(k) do { if (lo <= (k) && (k) + 1 < hi) xcd_barrier(bar); } while (0)
    constexpr float QSCALE = 0.0625f * 1.4426950408889634f;

    if (EN_PRO && IN(0)) { ARGS(); for (int rep = 0; rep < REP_PRO; ++rep) { int t2 = TID(); OPAQUE(t2); phase_prologue(args, lds, vcu, G, t2, t2 & 63, wave); __syncthreads(); } }
    SEAM(0);
#pragma unroll 1
    for (int l = 0; l < 2; ++l) {
        const int pb = 1 + 8 * l;
        if (EN_GEMM && EN_G1 && IN(pb)) { ARGS();
            if (EN_KV && l == 0 && bx >= 128) {
                if (bx < 192) { pg8::Gemm g{(const bf16*)(ws + WS_MEMB), (const bf16*)(ws + WS_WK), nullptr, MROWS, 2048, D}; pg8::StaticOrder S; S.init(MROWS, 2048, 64, bx - 128);
                    pg8::EpiRowScale<false> E{(bf16*)(ws + WS_KB), 2048, (const void*)(ws + OFF_MEMSS), 1.0f};
                    pg8::gemm_phase<pg8::EpiRowScale<false>, pg8::StaticOrder, true, false>(lds, g, S, E, wave); }
                else { pg8::Gemm g{(const bf16*)(ws + WS_WV), (const bf16*)(ws + WS_MEMB), nullptr, 2048, MROWS, D}; pg8::StaticOrder S; S.init(2048, MROWS, 64, bx - 192);
                    pg8::EpiColScale E{(bf16*)(ws + WS_VT), 2048, (const u64*)(ws + OFF_MEMSS)};
                    pg8::gemm_phase<pg8::EpiColScale, pg8::StaticOrder, true, false>(lds, g, S, E, wave); }
            }
            pg8::Gemm g{XB, (const bf16*)(ws + WS_WIN) + (size_t)l * DIN * D, nullptr, T, DIN, D}; pg8::StaticOrder S; S.init(T, DIN, G, bx);
            pg8::EpiRowScale<false> E{(bf16*)(ws + WS_Z), DIN, rowss + (size_t)(3 * l) * T, 1.0f};
            pg8::gemm_phase<pg8::EpiRowScale<false>, pg8::StaticOrder, true, false>(lds, g, S, E, wave);
        }
        SEAM(pb);
        if (EN_MIX && IN(pb + 1)) { ARGS(); for (int rep = 0; rep < REP_MIX; ++rep) { int t2 = TID(); asm volatile("" : "+v"(t2)); for (int u = vcu; u < 256; u += G) mixer_unit(args, lds, l, u, t2, t2 & 63, wave); } }
        SEAM(pb + 1);
        if (EN_GEMM && EN_G2 && IN(pb + 2)) { ARGS();
            pg8::Gemm g{(const bf16*)(ws + WS_MIXED), (const bf16*)(ws + WS_WOUT) + (size_t)l * D * D, nullptr, T, D, D}; pg8::StaticOrder S; S.init(T, D, G, bx);
            pg8::EpiResid<false, true, true> E{l == 0 ? args->in[0] : (const float*)args->out, args->out, XB, rowss + (size_t)(3 * l + 1) * T, nullptr, nullptr, 1.0f, false};
            pg8::gemm_phase<pg8::EpiResid<false, true, true>, pg8::StaticOrder, true, false>(lds, g, S, E, wave);
        }
        SEAM(pb + 2);
        if (EN_GEMM && EN_G3 && IN(pb + 3)) { ARGS();
            pg8::Gemm g{XB, (const bf16*)(ws + WS_WQ) + (size_t)l * D * D, nullptr, T, D, D}; pg8::StaticOrder S; S.init(T, D, G, bx);
            pg8::EpiRowScale<false> E{(bf16*)(ws + WS_Q), D, rowss + (size_t)(3 * l + 1) * T, QSCALE};
            for (int rep = 0; rep < REP_Q; ++rep) pg8::gemm_phase<pg8::EpiRowScale<false>, pg8::StaticOrder, true, false>(lds, g, S, E, wave);
        }
        SEAM(pb + 3);
        if (EN_ATT && IN(pb + 4)) { ARGS(); for (int rep = 0; rep < REP_ATT; ++rep) { int t2 = TID(); asm volatile("" : "+v"(t2)); for (int u = vcu; u < 512; u += G) attn_unit(args, lds, l, u, t2, t2 & 63, wave); } }
        SEAM(pb + 4);
        if (EN_GEMM && EN_G2 && IN(pb + 5)) { ARGS();
            pg8::Gemm g{(const bf16*)(ws + WS_O), (const bf16*)(ws + WS_WO) + (size_t)l * D * D, nullptr, T, D, D}; pg8::StaticOrder S; S.init(T, D, G, bx);
            pg8::EpiResid<false, true, true> E{args->out, args->out, XB, rowss + (size_t)(3 * l + 2) * T, nullptr, nullptr, 1.0f, l == 1};
            pg8::gemm_phase<pg8::EpiResid<false, true, true>, pg8::StaticOrder, true, false>(lds, g, S, E, wave);
        }
        SEAM(pb + 5);
        if (l == 0) {
            if (EN_GEMM && EN_G4 && IN(7)) { ARGS();
                pg8::Gemm g{XB, (const bf16*)(ws + WS_WGU), nullptr, T, 2 * DFF, D}; pg8::StaticOrder S; S.init(T, 2 * DFF, G, bx);
                pg8::EpiSwiglu<false> E{(bf16*)(ws + WS_H), DFF, rowss + (size_t)2 * T};
                for (int rep = 0; rep < REP_UP; ++rep) pg8::gemm_phase<pg8::EpiSwiglu<false>, pg8::StaticOrder, true, false>(lds, g, S, E, wave);
            }
            SEAM(7);
            if (EN_GEMM && EN_G2 && IN(8)) { ARGS();
                pg8::Gemm g{(const bf16*)(ws + WS_H), (const bf16*)(ws + WS_WD), nullptr, T, D, DFF}; pg8::StaticOrder S; S.init(T, D, G, bx);
                pg8::EpiResid<false, true, true> E{args->out, args->out, XB, rowss + (size_t)3 * T, nullptr, nullptr, 1.0f, false};
                pg8::gemm_phase<pg8::EpiResid<false, true, true>, pg8::StaticOrder, true, false>(lds, g, S, E, wave);
            }
            SEAM(8);
        } else {
            if (EN_ROUTE && IN(15)) { ARGS(); int t2 = TID(); OPAQUE(t2); phase_router(args, lds, vcu, G, t2, t2 & 63, wave); }
            SEAM(15);
            if (EN_ROUTE && IN(16)) { ARGS(); int t2 = TID(); OPAQUE(t2); phase_lists(args, lds, vcu, G, t2); }
            SEAM(16);
#pragma unroll 1
            for (int s = 0; s < 2; ++s) {
                if (EN_MOE && EN_MUP && IN(17 + 2 * s)) { ARGS();
                    const int* perm = (const int*)(ws + WS_ROUTE + 4 * T * 4); const float* rsp = (const float*)(ws + WS_ROUTE + 4 * T * 4 + 2 * PERMROWS * 4);
                    pg8::MoeOrder S; S.G = G; S.c = bx; S.tp[0] = 0; S.nN = 2 * DFF / 256;
                    const int* cnt = (const int*)(ws + OFF_MOECNT) + s * 8;
#pragma unroll
                    for (int j = 0; j < 8; ++j) S.tp[j + 1] = S.tp[j] + ((__builtin_amdgcn_readfirstlane(cnt[j]) + 255) >> 8);
                    pg8::Gemm g{XB, (const bf16*)(ws + WS_MWGU), perm + s * PERMROWS, T, 2 * DFF, D / 2};
                    pg8::EpiSwiglu8 E{ws + WS_H, DFF, rsp + s * PERMROWS};
                    pg8::gemm_phase<pg8::EpiSwiglu8, pg8::MoeOrder, true, true, true>(lds, g, S, E, wave);
                }
                SEAM(17 + 2 * s);
                if (EN_MOE && EN_MDN && IN(18 + 2 * s)) { ARGS();
                    const int* perm = (const int*)(ws + WS_ROUTE + 4 * T * 4); const float* gp = (const float*)(ws + WS_ROUTE + 4 * T * 4 + 4 * PERMROWS * 4);
                    pg8::MoeOrder S; S.G = G; S.c = bx; S.tp[0] = 0; S.nN = D / 256;
                    const int* cnt = (const int*)(ws + OFF_MOECNT) + s * 8;
#pragma unroll
                    for (int j = 0; j < 8; ++j) S.tp[j + 1] = S.tp[j] + ((__builtin_amdgcn_readfirstlane(cnt[j]) + 255) >> 8);
                    pg8::Gemm g{(const bf16*)(ws + WS_H), (const bf16*)(ws + WS_MWD), nullptr, T, D, DFF / 2};
                    pg8::EpiResid<true, false, true> E{args->out, args->out, nullptr, s ? rowss + (size_t)6 * T : nullptr, perm + s * PERMROWS, gp + s * PERMROWS, 1.0f / S8_DN, false};
                    pg8::gemm_phase<pg8::EpiResid<true, false, true>, pg8::MoeOrder, true, false, true>(lds, g, S, E, wave);
                }
                SEAM(18 + 2 * s);
            }
            if (IN(21)) { ARGS(); int t2 = TID(); OPAQUE(t2); phase_final(args, vcu, G, t2 & 63, wave); }
        }
    }
#undef IN
#undef SEAM
}

extern "C" void kernel_launch(void* const* d_in, const int* in_sizes, int n_in, void* d_out, int out_size, void* d_ws, size_t ws_size, hipStream_t stream) {
    static int grid = 0;
    if (grid == 0) {
        if (n_in != 31 || in_sizes[0] != T * D || out_size != T * D || ws_size < WS_END) { fprintf(stderr, "kernel_launch: unexpected shapes (n_in %d, in0 %d, out %d, ws %zu)\n", n_in, n_in > 0 ? in_sizes[0] : -1, out_size, ws_size); grid = -1; return; }
        int dev = 0, cus = 0;
        if (hipGetDevice(&dev) != hipSuccess || hipDeviceGetAttribute(&cus, hipDeviceAttributeMultiprocessorCount, dev) != hipSuccess) { grid = -1; return; }
        if (hipFuncSetAttribute((const void*)fwd_kernel, hipFuncAttributeMaxDynamicSharedMemorySize, LDS_BYTES) != hipSuccess) { fprintf(stderr, "kernel_launch: hipFuncSetAttribute failed\n"); grid = -1; return; }
        int per_cu = 0;
        if (hipOccupancyMaxActiveBlocksPerMultiprocessor(&per_cu, (const void*)fwd_kernel, NTHREADS, LDS_BYTES) != hipSuccess || per_cu < 1) fprintf(stderr, "kernel_launch: occupancy query reports %d\n", per_cu);
        (void)hipGetLastError();
        grid = cus;
    }
    if (grid < 0) return;
    (void)hipMemsetAsync(d_ws, 0, CTL_ZERO_BYTES, stream);
    Args a{};
    for (int i = 0; i < 31; ++i) a.in[i] = (const float*)d_in[i];
    a.out = (float*)d_out; a.ws = (unsigned char*)d_ws;
#if MK_PER_PHASE
    for (int ph = 0; ph < NPH; ++ph) { a.ph_lo = ph; a.ph_hi = ph + 1; hipLaunchKernelGGL(fwd_kernel, dim3(grid), dim3(NTHREADS), LDS_BYTES, stream, a); }
#else
    a.ph_lo = 0; a.ph_hi = NPH; hipLaunchKernelGGL(fwd_kernel, dim3(grid), dim3(NTHREADS), LDS_BYTES, stream, a);
#endif
}
```

```cpp
#include <hip/hip_runtime.h>
#include <cstdio>
#include <cstdint>

#ifndef MK_PER_PHASE
#define MK_PER_PHASE 0
#endif

#ifndef EN_PRO
#define EN_PRO 1
#endif
#ifndef EN_GEMM
#define EN_GEMM 1
#endif
#ifndef EN_G1
#define EN_G1 1
#endif
#ifndef EN_G2
#define EN_G2 1
#endif
#ifndef EN_G3
#define EN_G3 1
#endif
#ifndef EN_G4
#define EN_G4 1
#endif
#ifndef EN_KV
#define EN_KV 1
#endif
#ifndef REP_PRO
#define REP_PRO 1
#endif
#ifndef REP_MIX
#define REP_MIX 1
#endif
#ifndef REP_ATT
#define REP_ATT 1
#endif
#ifndef REP_Q
#define REP_Q 1
#endif
#ifndef REP_UP
#define REP_UP 1
#endif
#ifndef EN_MUP
#define EN_MUP 1
#endif
#ifndef EN_MDN
#define EN_MDN 1
#endif
#ifndef PROBE_MASK
#define ATT_QPRE 1
#define PROBE_MLO -1
#define PROBE_MHI -1
#define PROBE_MWG 100
#define MSEC(k) do { if (PROBE_MLO >= 0 && blockIdx.x == PROBE_MWG && threadIdx.x == 0) { volatile LAS unsigned* _m = (volatile LAS unsigned*)(lds + MISC_OFF) + 40; const unsigned _t = (unsigned)__builtin_amdgcn_s_memrealtime(); if ((k) == PROBE_MLO) *_m -= _t; if ((k) == PROBE_MHI) *_m += _t; } } while (0)
#define PROBE_MASK 0u
#endif
#ifndef PROBE_K
#define PROBE_K 0
#endif
#ifndef STAG_TICKS
#define STAG_TICKS 0
#endif
#ifndef EN_MIX
#define EN_MIX 1
#endif
#ifndef EN_ATT
#define EN_ATT 1
#endif
#ifndef EN_MOE
#define EN_MOE 1
#endif
#ifndef EN_ROUTE
#define EN_ROUTE 1
#endif
#define LAS __attribute__((address_space(3)))
#define GAS __attribute__((address_space(1)))
typedef unsigned short bf16;
typedef short bf16x8 __attribute__((ext_vector_type(8)));
typedef float f32x2 __attribute__((ext_vector_type(2)));
typedef float f32x4 __attribute__((ext_vector_type(4)));
typedef float f32x16 __attribute__((ext_vector_type(16)));
typedef unsigned u32x2 __attribute__((ext_vector_type(2)));
typedef unsigned u32x4 __attribute__((ext_vector_type(4)));
typedef __bf16 bf16x2_t __attribute__((ext_vector_type(2)));
typedef int i32x4 __attribute__((ext_vector_type(4)));
typedef int i32x8 __attribute__((ext_vector_type(8)));
typedef unsigned long long u64;
typedef unsigned long long u64x2 __attribute__((ext_vector_type(2)));

constexpr int NB = 8, SEQ = 4096, D = 1024, T = NB * SEQ, DIN = 1792, DFF = 2816, NE = 8, MEMLEN = 256, MROWS = NB * MEMLEN;
constexpr float EPS = 1e-6f;
constexpr float S8_UP = 32.0f, S8_DN = 64.0f;
constexpr int NWAVES = 8, NTHREADS = 512;
constexpr int NPH = 20;

constexpr size_t MiB = 1u << 20;
constexpr size_t CTL_ZERO_BYTES = 64 * 1024;
constexpr int CW_BAR = 4096;
constexpr size_t WS_ROWSS = 124 * MiB;
constexpr size_t OFF_MOECNT = 32 * 1024;
constexpr size_t OFF_MEMSS = 40 * 1024;
constexpr size_t WS_WIN = 2 * MiB;
constexpr size_t WS_WOUT = 9 * MiB;
constexpr size_t WS_WQ = 13 * MiB;
constexpr size_t WS_WO = 17 * MiB;
constexpr size_t WS_WK = 21 * MiB;
constexpr size_t WS_WV = 25 * MiB;
constexpr size_t WS_WGU = 29 * MiB;
constexpr size_t WS_WD = 40 * MiB;
constexpr size_t WS_MWGU = 46 * MiB;
constexpr size_t WS_MWD = 134 * MiB;
constexpr size_t WS_SGUW = 178 * MiB;
constexpr size_t WS_POOLW = 178 * MiB + 512 * 1024;
constexpr size_t WS_XB = 180 * MiB;
constexpr size_t WS_MEMB = 244 * MiB;
constexpr size_t WS_KB = 248 * MiB;
constexpr size_t WS_VT = 256 * MiB;
constexpr size_t WS_ROUTE = 264 * MiB;
constexpr int PERMROWS = 264 * 256;
constexpr size_t WS_Y1 = 448 * MiB;
constexpr size_t WS_XB8 = 90 * MiB;
constexpr size_t WS_ACT = 266 * MiB;
constexpr size_t WS_Z = WS_ACT;
constexpr size_t WS_MIXED = WS_ACT + 112 * MiB;
constexpr size_t WS_Q = WS_ACT;
constexpr size_t WS_O = WS_ACT + 64 * MiB;
constexpr size_t WS_H = WS_ACT;
constexpr size_t WS_END = 512 * MiB;
static_assert(WS_H + (size_t)PERMROWS * DFF <= WS_Y1 && WS_Y1 + (size_t)T * D * 2 <= WS_END && WS_MWGU + (size_t)NE * 2 * DFF * D <= WS_XB8 && WS_XB8 + (size_t)T * D <= WS_ROWSS && WS_ROWSS + 7 * (size_t)T * 16 <= WS_MWD && WS_ROUTE + 4 * (size_t)T * 4 + 3 * (size_t)PERMROWS * 4 + 8192 <= WS_ACT, "ws map");

constexpr int LDS_BYTES = 160 * 1024;
constexpr int MISC_OFF = LDS_BYTES - 256;

__device__ __forceinline__ float bf_lo(unsigned v) { return __uint_as_float(v << 16); }
__device__ __forceinline__ float bf_hi(unsigned v) { return __uint_as_float(v & 0xffff0000u); }
__device__ __forceinline__ unsigned pk_bf16(float lo, float hi) { f32x2 v = {lo, hi}; bf16x2_t b = __builtin_convertvector(v, bf16x2_t); return __builtin_bit_cast(unsigned, b); }
__device__ __forceinline__ unsigned pk_bf16_v(float lo, float hi) { unsigned r; asm volatile("v_cvt_pk_bf16_f32 %0, %1, %2" : "=v"(r) : "v"(lo), "v"(hi)); return r; }
__device__ __forceinline__ bf16 f2bf(float f) { return (bf16)(pk_bf16(f, 0.f) & 0xffffu); }
__device__ __forceinline__ float sigm(float x) { return __builtin_amdgcn_rcpf(1.0f + __expf(-x)); }
__device__ __forceinline__ float silu_f(float x) { return x * sigm(x); }
__device__ __forceinline__ float gelu_tanh(float x) { const float t = x * __builtin_fmaf(x * x, -0.10294324f, -2.3022082f); return x * __builtin_amdgcn_rcpf(1.0f + __builtin_amdgcn_exp2f(t)); }
constexpr float SS_FIX = 16777216.0f;
__device__ __forceinline__ u64 ss_to_fix(float ss) { return (u64)(ss * SS_FIX); }
__device__ __forceinline__ float rstd_ss(u64 ssf) { return __builtin_amdgcn_rsqf((float)ssf * (1.0f / (1024.0f * SS_FIX)) + EPS); }
__device__ __forceinline__ float rstd4(f32x4 p) { return __builtin_amdgcn_rsqf(((p[0] + p[1]) + (p[2] + p[3])) * (1.0f / 1024.0f) + EPS); }
__device__ __forceinline__ unsigned pk_fp8x4(float a, float b, float c, float d) { int p = __builtin_amdgcn_cvt_pk_fp8_f32(a, b, 0, false); p = __builtin_amdgcn_cvt_pk_fp8_f32(c, d, p, true); return (unsigned)p; }
__device__ __forceinline__ int lane_id() { int l; asm volatile("v_mbcnt_lo_u32_b32 %0, -1, 0\n\tv_mbcnt_hi_u32_b32 %0, -1, %0" : "=v"(l)); return l; }
__device__ __forceinline__ float shfl_xor_f(float v, int mask) { const int idx = (lane_id() ^ mask) << 2; return __builtin_bit_cast(float, __builtin_amdgcn_ds_bpermute(idx, __builtin_bit_cast(int, v))); }
#define OPAQUE(x) asm volatile("" : "+v"(x))
template <int CTRL> __device__ __forceinline__ float dpp_f(float v) { return __builtin_bit_cast(float, __builtin_amdgcn_update_dpp(0, __builtin_bit_cast(int, v), CTRL, 0xf, 0xf, true)); }
__device__ __forceinline__ float row16_sum(float v) { v += dpp_f<0xB1>(v); v += dpp_f<0x4E>(v); v += dpp_f<0x141>(v); v += dpp_f<0x140>(v); return v; }
__device__ __forceinline__ float wave_sum(float v) { v = row16_sum(v); v += shfl_xor_f(v, 16); v += shfl_xor_f(v, 32); return v; }

namespace pg8 {
__device__ __forceinline__ void glds_s(const void* sbase, unsigned voff, unsigned lds_dst) {
    asm volatile("s_mov_b32 m0, %2\n\ts_nop 0\n\tglobal_load_lds_dwordx4 %0, %1" : : "v"(voff), "s"(sbase), "s"(lds_dst) : "memory", "m0");
}
constexpr int BM = 256, BK = 64, HALF = 128, HTB = HALF * BK * 2, STAGE_BYTES = 8 * HTB, NXCD = 8, WGM = 8;
__host__ __device__ __forceinline__ int lds_byte(int r, int c) { const int st = (r >> 4) * 2 + (c >> 5), rr = r & 15, cc = c & 31, ob = rr * 64 + cc * 2; return st * 1024 + (ob ^ (((ob >> 9) & 1) << 5)); }
__host__ __device__ __forceinline__ void stage_rc(int b, int& R, int& C) { const int st = b / 1024, sb = b % 1024, swz = sb ^ (((sb >> 9) & 1) << 5); R = (st >> 1) * 16 + swz / 64; C = (st & 1) * 32 + (swz % 64) / 2; }
__host__ __device__ __forceinline__ int perm32(int rho) { const int n = rho >> 4, i = rho & 15; return 8 * (i >> 2) + 4 * n + (i & 3); }

struct Unit { int pm, pn, brow; };
struct Gemm { const bf16* A; const bf16* Bt; const int* perm; int M, N, K; const float* aux = nullptr; };

struct StaticOrder {
    int nM, nN, nwg, G, c;
    __device__ void init(int M, int N, int G_, int c_) { nM = M / BM; nN = N / BM; nwg = nM * nN; G = G_; c = c_; }
    __device__ bool next(int i, Unit& u) const {
        const long L = (long)i * G + c; if (L >= nwg) return false;
        int wgid = (int)L; { const int q = nwg / NXCD, r = nwg % NXCD, xcd = wgid % NXCD, off = wgid / NXCD; wgid = (xcd < r ? xcd * (q + 1) : r * (q + 1) + (xcd - r) * q) + off; }
        const int nig = WGM * nN, gid = wgid / nig, fm = gid * WGM, gsz = (nM - fm) < WGM ? (nM - fm) : WGM;
        u.pm = fm + ((wgid % nig) % gsz); u.pn = (wgid % nig) / gsz; u.brow = u.pn; return true;
    }
};
struct MoeOrder {
    int nN, G, c; int tp[9];
    __device__ bool next(int i, Unit& u) const {
        const int L = i * G + c; if (L >= tp[8] * nN) return false;
        int e = 0;
#pragma unroll
        for (int j = 1; j < 8; ++j) e += (L >= tp[j] * nN) ? 1 : 0;
        int base = 0, nx = 0;
#pragma unroll
        for (int j = 0; j < 8; ++j) if (e == j) { base = tp[j]; nx = tp[j + 1]; }
        const int te = nx - base, Lp = L - base * nN; u.pn = Lp / te; u.pm = base + Lp % te; u.brow = e * nN + u.pn; return true;
    }
};

typedef f32x4 Acc[2][2][4][2];

constexpr int EPI_R0 = 3 * HTB, EPI_R1 = STAGE_BYTES;
constexpr int SLOT_OFF = STAGE_BYTES + 16384, SLOT_BYTES = 4096;
__device__ __forceinline__ void glds4_s(const void* sbase, unsigned voff, unsigned lds_dst) {
    asm volatile("s_mov_b32 m0, %2\n\ts_nop 0\n\tglobal_load_lds_dword %0, %1" : : "v"(voff), "s"(sbase), "s"(lds_dst) : "memory", "m0");
}
#define EPI_BAR() do { asm volatile("s_waitcnt lgkmcnt(0)" ::: "memory"); __builtin_amdgcn_s_barrier(); asm volatile("" ::: "memory"); } while (0)

template <bool DIRECT, bool SLOT = false> struct EpiRowScale {
    static constexpr bool PERM = true;
    bf16* O; int ldc; const void* rs; float cst;
    __device__ __forceinline__ void operator()(const Acc& acc, const Unit& u, int wr, int wc, LAS unsigned char* lds, int ui) const {
        const int ln = lane_id(), fr = ln & 15, fq = ln >> 4;
        const int row0 = u.pm * BM + wr * 64 + fr;
        float sc[2][4];
        if (DIRECT) {
#pragma unroll
            for (int ai = 0; ai < 2; ++ai)
#pragma unroll
                for (int m = 0; m < 4; ++m) sc[ai][m] = ((const float*)rs)[row0 + ai * HALF + m * 16] * cst;
        } else if (SLOT) { f32x4 sv[2][4];
#pragma unroll
            for (int ai = 0; ai < 2; ++ai)
#pragma unroll
                for (int m = 0; m < 4; ++m) sv[ai][m] = ((const LAS f32x4*)(lds + SLOT_OFF + (ui & 1) * SLOT_BYTES))[wr * 64 + fr + ai * HALF + m * 16];
#pragma unroll
            for (int ai = 0; ai < 2; ++ai)
#pragma unroll
                for (int m = 0; m < 4; ++m) sc[ai][m] = rstd4(sv[ai][m]) * cst;
        } else { u64 sv[2][4];
#pragma unroll
            for (int ai = 0; ai < 2; ++ai)
#pragma unroll
                for (int m = 0; m < 4; ++m) sv[ai][m] = ((const u64*)rs)[row0 + ai * HALF + m * 16];
#pragma unroll
            for (int ai = 0; ai < 2; ++ai)
#pragma unroll
                for (int m = 0; m < 4; ++m) sc[ai][m] = rstd_ss(sv[ai][m]) * cst; }
        LAS unsigned char* reg = lds + (wr ? EPI_R1 : EPI_R0);
#pragma unroll
        for (int ai = 0; ai < 2; ++ai)
#pragma unroll
            for (int mh = 0; mh < 2; ++mh) {
#pragma unroll
                for (int mm = 0; mm < 2; ++mm) { const int m = 2 * mh + mm, lr = mm * 16 + fr; const float s1 = sc[ai][m];
#pragma unroll
                    for (int bj = 0; bj < 2; ++bj) { const f32x4 v0 = acc[ai][bj][m][0] * s1, v1 = acc[ai][bj][m][1] * s1;
                        u32x4 w; w.x = pk_bf16(v0[0], v0[1]); w.y = pk_bf16(v0[2], v0[3]); w.z = pk_bf16(v1[0], v1[1]); w.w = pk_bf16(v1[2], v1[3]);
                        *(LAS u32x4*)(reg + lr * 512 + (((bj * 16 + wc * 4 + fq) ^ (lr & 7)) * 16)) = w; } }
                EPI_BAR();
                bf16* ob = O + (size_t)(u.pm * BM + ai * HALF + wr * 64 + mh * 32) * ldc + u.pn * BM;
#pragma unroll
                for (int j = 0; j < 4; ++j) { const int lr = wc * 8 + 2 * j + (ln >> 5), c = ln & 31;
                    const u32x4 w = *(const LAS u32x4*)(reg + lr * 512 + ((c ^ (lr & 7)) * 16));
                    *(u32x4*)(ob + (size_t)lr * ldc + c * 8) = w; }
                EPI_BAR();
            }
    }
};
struct EpiColScale {
    static constexpr bool PERM = true;
    bf16* O; int ldc; const u64* css;
    __device__ __forceinline__ void operator()(const Acc& acc, const Unit& u, int wr, int wc, LAS unsigned char* lds, int ui) const {
        const int ln = lane_id(), fr = ln & 15, fq = ln >> 4;
        const int row0 = u.pm * BM + wr * 64 + fr, col0 = u.pn * BM + wc * 32 + 8 * fq;
#pragma unroll
        for (int bj = 0; bj < 2; ++bj) {
            const u64* cp = css + col0 + bj * HALF;
            const f32x4 c0 = (f32x4){rstd_ss(cp[0]), rstd_ss(cp[1]), rstd_ss(cp[2]), rstd_ss(cp[3])}, c1 = (f32x4){rstd_ss(cp[4]), rstd_ss(cp[5]), rstd_ss(cp[6]), rstd_ss(cp[7])};
#pragma unroll
            for (int ai = 0; ai < 2; ++ai)
#pragma unroll
                for (int m = 0; m < 4; ++m) { bf16* rowp = O + (size_t)(row0 + ai * HALF + m * 16) * ldc + ((col0 + bj * HALF) & ~15) + 4 * (fq & 1);
                    const f32x4 v0 = acc[ai][bj][m][0] * c0, v1 = acc[ai][bj][m][1] * c1;
                    u32x2 wa, wb; wa.x = pk_bf16(v0[0], v0[1]); wa.y = pk_bf16(v0[2], v0[3]); wb.x = pk_bf16(v1[0], v1[1]); wb.y = pk_bf16(v1[2], v1[3]);
                    *(u32x2*)rowp = wa; *(u32x2*)(rowp + 8) = wb; }
            asm volatile("" ::: "memory"); }
    }
};
template <bool DIRECT, bool SLOT = false> struct EpiSwiglu {
    static constexpr bool PERM = true;
    bf16* O; int ldc; const void* rs;
    __device__ __forceinline__ void operator()(const Acc& acc, const Unit& u, int wr, int wc, LAS unsigned char* lds, int ui) const {
        const int ln = lane_id(), fr = ln & 15, fq = ln >> 4;
        const int row0 = u.pm * BM + wr * 64 + fr;
        float sc[2][4];
        if (DIRECT) {
#pragma unroll
            for (int ai = 0; ai < 2; ++ai)
#pragma unroll
                for (int m = 0; m < 4; ++m) sc[ai][m] = ((const float*)rs)[row0 + ai * HALF + m * 16];
        } else { f32x4 sv[2][4];
#pragma unroll
            for (int ai = 0; ai < 2; ++ai)
#pragma unroll
                for (int m = 0; m < 4; ++m) sv[ai][m] = SLOT ? ((const LAS f32x4*)(lds + SLOT_OFF + (ui & 1) * SLOT_BYTES))[wr * 64 + fr + ai * HALF + m * 16] : ((const f32x4*)rs)[row0 + ai * HALF + m * 16];
#pragma unroll
            for (int ai = 0; ai < 2; ++ai)
#pragma unroll
                for (int m = 0; m < 4; ++m) sc[ai][m] = rstd4(sv[ai][m]); }
        LAS unsigned char* reg = lds + (wr ? EPI_R1 : EPI_R0);
#pragma unroll
        for (int ai = 0; ai < 2; ++ai) {
#pragma unroll
            for (int m = 0; m < 4; ++m) { const int lr = m * 16 + fr; const float s1 = sc[ai][m], s2 = s1 * s1, sneg = s1 * -1.4426950408889634f;
                u32x4 w;
#pragma unroll
                for (int n = 0; n < 2; ++n) { const f32x4 a = acc[ai][0][m][n], b = acc[ai][1][m][n];
                    const f32x4 p = (a * b) * s2, t = a * sneg;
                    const f32x4 o = (f32x4){p[0] * __builtin_amdgcn_rcpf(1.0f + __builtin_amdgcn_exp2f(t[0])), p[1] * __builtin_amdgcn_rcpf(1.0f + __builtin_amdgcn_exp2f(t[1])),
                                            p[2] * __builtin_amdgcn_rcpf(1.0f + __builtin_amdgcn_exp2f(t[2])), p[3] * __builtin_amdgcn_rcpf(1.0f + __builtin_amdgcn_exp2f(t[3]))};
                    w[2 * n] = pk_bf16(o[0], o[1]); w[2 * n + 1] = pk_bf16(o[2], o[3]); }
                *(LAS u32x4*)(reg + lr * 256 + (((wc * 4 + fq) ^ (lr & 7)) * 16)) = w; }
            EPI_BAR();
            bf16* ob = O + (size_t)(u.pm * BM + ai * HALF + wr * 64) * ldc + u.pn * HALF;
#pragma unroll
            for (int j = 0; j < 4; ++j) { const int lr = wc * 16 + 4 * j + (ln >> 4), c = ln & 15;
                const u32x4 w = *(const LAS u32x4*)(reg + lr * 256 + ((c ^ (lr & 7)) * 16));
                *(u32x4*)(ob + (size_t)lr * ldc + c * 8) = w; }
            EPI_BAR();
        }
    }
};
struct EpiSwiglu8 {
    static constexpr bool PERM = true;
    unsigned char* O; int ldc; const float* rs;
    __device__ __forceinline__ void operator()(const Acc& acc, const Unit& u, int wr, int wc, LAS unsigned char* lds, int ui) const {
        const int ln = lane_id(), fr = ln & 15, fq = ln >> 4;
        const int row0 = u.pm * BM + wr * 64 + fr;
        float sc[2][4];
#pragma unroll
        for (int ai = 0; ai < 2; ++ai)
#pragma unroll
            for (int m = 0; m < 4; ++m) sc[ai][m] = ((const LAS float*)(lds + SLOT_OFF + (ui & 1) * SLOT_BYTES + 1024))[wr * 64 + fr + ai * HALF + m * 16] * (1.0f / S8_UP);
        (void)row0;
        LAS unsigned char* reg = lds + (wr ? EPI_R1 : EPI_R0);
#pragma unroll
        for (int ai = 0; ai < 2; ++ai) {
#pragma unroll
            for (int m = 0; m < 4; ++m) { const int lr = ai * 64 + m * 16 + fr; const float s1 = sc[ai][m], s2 = s1 * s1, sneg = s1 * -1.4426950408889634f;
                u32x2 w;
#pragma unroll
                for (int n = 0; n < 2; ++n) { const f32x4 a = acc[ai][0][m][n], b = acc[ai][1][m][n];
                    const f32x4 p = (a * b) * s2, t = a * sneg;
                    w[n] = pk_fp8x4(p[0] * __builtin_amdgcn_rcpf(1.0f + __builtin_amdgcn_exp2f(t[0])), p[1] * __builtin_amdgcn_rcpf(1.0f + __builtin_amdgcn_exp2f(t[1])),
                                    p[2] * __builtin_amdgcn_rcpf(1.0f + __builtin_amdgcn_exp2f(t[2])), p[3] * __builtin_amdgcn_rcpf(1.0f + __builtin_amdgcn_exp2f(t[3]))); }
                const int c8 = wc * 4 + fq;
                *(LAS u32x2*)(reg + lr * 128 + ((((c8 >> 1) ^ (lr & 7)) * 16) + (c8 & 1) * 8)) = w; } }
        EPI_BAR();
#pragma unroll
        for (int j = 0; j < 4; ++j) { const int lr = wc * 32 + 8 * j + (ln >> 3), c = ln & 7;
            const u32x4 w = *(const LAS u32x4*)(reg + lr * 128 + ((c ^ (lr & 7)) * 16));
            unsigned char* ob = O + (size_t)(u.pm * BM + (lr >> 6) * HALF + wr * 64 + (lr & 63)) * ldc + u.pn * HALF;
            *(u32x4*)(ob + c * 16) = w; }
        EPI_BAR();
    }
};
template <bool SCATTER, bool ACC_SS> struct EpiResid {
    static constexpr bool PERM = true;
    bf16* X; unsigned char* X8; float* ss_out; float gscale; bf16* Y1;
    __device__ __forceinline__ void operator()(const Acc& acc, const Unit& u, int wr, int wc, LAS unsigned char* lds, int ui) const {
        static_assert(!(ACC_SS && SCATTER), "dense rows only");
        const int ln = lane_id(), fr = ln & 15, fq = ln >> 4;
        LAS unsigned char* reg = lds + (wr ? EPI_R1 : EPI_R0);
        const LAS int* sl = (const LAS int*)(lds + SLOT_OFF + (ui & 1) * SLOT_BYTES);
        const int colb = u.pn * BM;
#pragma unroll
        for (int ai = 0; ai < 2; ++ai) {
            u32x4 xv[4][2]; float gate[4];
#pragma unroll
            for (int m = 0; m < 4; ++m) { const int rl = ai * HALF + wr * 64 + m * 16 + fr; int row; bool take = true;
                if (SCATTER) { row = sl[rl]; gate[m] = ((const LAS float*)sl)[256 + rl] * gscale; take = (unsigned)row < 65536u; }
                else { row = u.pm * BM + rl; gate[m] = 1.0f; }
                const bf16* xp = X + (size_t)(take ? row : 0) * D + colb + wc * 32 + fq * 8;
#pragma unroll
                for (int bj = 0; bj < 2; ++bj) { if (take) xv[m][bj] = *(const u32x4*)(xp + bj * HALF); else xv[m][bj] = (u32x4){0u, 0u, 0u, 0u}; } }
#pragma unroll
            for (int mh = 0; mh < 2; ++mh) {
#pragma unroll
                for (int mm = 0; mm < 2; ++mm) { const int m = 2 * mh + mm, lr = mm * 16 + fr; const float gt = gate[m];
#pragma unroll
                    for (int bj = 0; bj < 2; ++bj) { const f32x4 a0 = acc[ai][bj][m][0], a1 = acc[ai][bj][m][1]; const u32x4 x = xv[m][bj];
                        u32x4 w; w.x = pk_bf16(bf_lo(x.x) + a0[0] * gt, bf_hi(x.x) + a0[1] * gt); w.y = pk_bf16(bf_lo(x.y) + a0[2] * gt, bf_hi(x.y) + a0[3] * gt);
                        w.z = pk_bf16(bf_lo(x.z) + a1[0] * gt, bf_hi(x.z) + a1[1] * gt); w.w = pk_bf16(bf_lo(x.w) + a1[2] * gt, bf_hi(x.w) + a1[3] * gt);
                        *(LAS u32x4*)(reg + lr * 512 + (((bj * 16 + wc * 4 + fq) ^ (lr & 7)) * 16)) = w; } }
                EPI_BAR();
#pragma unroll
                for (int j = 0; j < 4; ++j) { const int lr = wc * 8 + 2 * j + (ln >> 5), c = ln & 31, rl = ai * HALF + wr * 64 + mh * 32 + lr;
                    const u32x4 w = *(const LAS u32x4*)(reg + lr * 512 + ((c ^ (lr & 7)) * 16));
                    if (SCATTER) { const int re = sl[rl];
                        if (re >= 0) { bf16* dst = (re >= 65536 ? Y1 : X) + (size_t)(re & 65535) * D + colb + c * 8; *(u32x4*)dst = w; } }
                    else { const size_t row = (size_t)(u.pm * BM + rl);
                        *(u32x4*)(X + row * D + colb + c * 8) = w;
                        if (X8) { u32x2 q; q.x = pk_fp8x4(bf_lo(w.x), bf_hi(w.x), bf_lo(w.y), bf_hi(w.y)); q.y = pk_fp8x4(bf_lo(w.z), bf_hi(w.z), bf_lo(w.w), bf_hi(w.w)); *(u32x2*)(X8 + row * D + colb + c * 8) = q; }
                        if (ACC_SS) { const float r0 = bf_lo(w.x), r1 = bf_hi(w.x), r2 = bf_lo(w.y), r3 = bf_hi(w.y), r4 = bf_lo(w.z), r5 = bf_hi(w.z), r6 = bf_lo(w.w), r7 = bf_hi(w.w);
                            float ss = ((r0 * r0 + r1 * r1) + (r2 * r2 + r3 * r3)) + ((r4 * r4 + r5 * r5) + (r6 * r6 + r7 * r7));
                            ss = row16_sum(ss); ss += shfl_xor_f(ss, 16);
                            if (c == 0) ss_out[row * 4 + u.pn] = ss; } } }
                EPI_BAR();
            }
        }
    }
};

__device__ __forceinline__ void load_offs(const Gemm& g, const Unit& u, const int (&Rr)[2], const int (&Cc)[2], unsigned (&o)[2][2]) {
#pragma unroll
    for (int h = 0; h < 2; ++h)
#pragma unroll
        for (int i = 0; i < 2; ++i) { int row = g.perm[u.pm * BM + h * HALF + Rr[i]]; row = row < 0 ? 0 : (row & 65535); o[h][i] = (unsigned)(row * g.K + Cc[i]) * 2u; }
}

template <class Epi, class Sched, bool ALIGN_EPI, bool GATHER, bool FP8 = false, int SLOTS = 0>
__device__ __forceinline__ void gemm_phase(LAS unsigned char* lds, const Gemm g, const Sched& S, const Epi& E, int wave_id) {
    int tid_ = wave_id * 64 + lane_id(); asm volatile("" : "+v"(tid_));
    const int tid = tid_, wid = __builtin_amdgcn_readfirstlane(tid >> 6), lane = tid & 63, wr = wid >> 2, wc = wid & 3, fr = lane & 15, fq = lane >> 4;
    const int K = g.K, nt = K / BK;
    int Rr[2], Cc[2]; unsigned voffA[2], voffB[2];
#pragma unroll
    for (int i = 0; i < 2; ++i) { int R, C; stage_rc(tid * 16 + i * 8192, R, C); Rr[i] = R; Cc[i] = C; const int Rb = Epi::PERM ? ((R & ~31) + perm32(R & 31)) : R;
        voffA[i] = (unsigned)(R * K + C) * 2u; voffB[i] = (unsigned)(Rb * K + C) * 2u; }
    const size_t kstep = (size_t)(BK * 2);
    const size_t hstep = (size_t)HALF * K * 2;
    const size_t tstep = 2 * hstep;
    const unsigned ldsw = (unsigned)wid * 1024u, ldsbase = (unsigned)(size_t)lds;
    const int aoff = lds_byte(wr * 64 + fr, fq * 8), boff = lds_byte(wc * 32 + fr, fq * 8);
#define PG8_SA(b, h) (((b) * 2 + (h)) * HTB)
#define PG8_SB(b, h) ((4 + (b) * 2 + (h)) * HTB)
#define PG8_STAGE(bufoff, gbase, voff) do { _Pragma("unroll") for (int _i = 0; _i < 2; ++_i) glds_s((const void*)(gbase), (voff)[_i], ldsbase + (unsigned)(bufoff) + ldsw + _i * 8192u); } while (0)
#define PG8_STAGE_A(bufoff, gbase, h) do { if constexpr (GATHER) PG8_STAGE(bufoff, gbase, offA[h]); else PG8_STAGE(bufoff, (gbase) + (h) * hstep, voffA); } while (0)
#define PG8_LDA(dst, b, h) do { _Pragma("unroll") for (int m = 0; m < 4; ++m) _Pragma("unroll") for (int k = 0; k < 2; ++k) dst[m][k] = *(const LAS bf16x8*)(lds + PG8_SA(b, h) + aoff + m * 2048 + k * 1024); } while (0)
#define PG8_LDB(dst, b, h) do { _Pragma("unroll") for (int n = 0; n < 2; ++n) _Pragma("unroll") for (int k = 0; k < 2; ++k) dst[n][k] = *(const LAS bf16x8*)(lds + PG8_SB(b, h) + boff + n * 2048 + k * 1024); } while (0)
#define PG8_CAT8(x) __builtin_shufflevector(__builtin_bit_cast(i32x4, (x)[0]), __builtin_bit_cast(i32x4, (x)[1]), 0, 1, 2, 3, 4, 5, 6, 7)
#define PG8_MMA(ai, bj, At, Bt) do { __builtin_amdgcn_s_setprio(1); \
        if constexpr (FP8) { _Pragma("unroll") for (int m = 0; m < 4; ++m) _Pragma("unroll") for (int n = 0; n < 2; ++n) \
            acc[ai][bj][m][n] = __builtin_amdgcn_mfma_scale_f32_16x16x128_f8f6f4(PG8_CAT8(Bt[n]), PG8_CAT8(At[m]), acc[ai][bj][m][n], 0, 0, 0, 0x7F7F7F7F, 0, 0x7F7F7F7F); } \
        else { _Pragma("unroll") for (int m = 0; m < 4; ++m) _Pragma("unroll") for (int n = 0; n < 2; ++n) _Pragma("unroll") for (int k = 0; k < 2; ++k) \
            acc[ai][bj][m][n] = __builtin_amdgcn_mfma_f32_16x16x32_bf16(Bt[n][k], At[m][k], acc[ai][bj][m][n], 0, 0, 0); } \
        __builtin_amdgcn_s_setprio(0); } while (0)
#define PG8_WAIT_V(n) asm volatile("s_waitcnt vmcnt(" #n ")" ::: "memory")
#define PG8_WAIT_L(n) asm volatile("s_waitcnt lgkmcnt(" #n ")" ::: "memory")
#define PG8_BAR __builtin_amdgcn_s_barrier()
#define PG8_SCHED __builtin_amdgcn_sched_barrier(0)
    Unit cur, nxt; int ui = 0;
    if (!S.next(0, cur)) return;
    if (STAG_TICKS) { const unsigned long long dly = (unsigned long long)((blockIdx.x >> 3) & 3) * STAG_TICKS, t0 = __builtin_amdgcn_s_memrealtime(); while (__builtin_amdgcn_s_memrealtime() - t0 < dly) __builtin_amdgcn_s_sleep(8); }
    Acc acc;
#pragma unroll
    for (int a = 0; a < 2; ++a)
#pragma unroll
        for (int b = 0; b < 2; ++b)
#pragma unroll
            for (int m = 0; m < 4; ++m)
#pragma unroll
                for (int n = 0; n < 2; ++n) acc[a][b][m][n] = (f32x4){0.f, 0.f, 0.f, 0.f};
    bf16x8 At[4][2], B0[2][2], B1[2][2];
    unsigned offA[2][2], offN[2][2];
#define PG8_SLOT_DMA(unit, par) do { if constexpr (SLOTS == 2) {   \
            if (wid < 4) glds_s((const void*)((const char*)g.aux + (size_t)(unit).pm * (BM * 16) + wid * 1024), (unsigned)lane_id() * 16u, ldsbase + SLOT_OFF + (par) * SLOT_BYTES + wid * 1024); } \
        else { const void* _b = wid < 4 ? (const void*)(g.perm + (unit).pm * BM + (wid & 3) * 64) : (const void*)(g.aux + (unit).pm * BM + (wid & 3) * 64); \
            glds4_s(_b, (unsigned)lane_id() * 4u, ldsbase + SLOT_OFF + (par) * SLOT_BYTES + wid * 256); } } while (0)
#define PG8_SLOT_OFFS(par, o) do { const LAS int* _sl = (const LAS int*)(lds + SLOT_OFF + (par) * SLOT_BYTES); _Pragma("unroll") for (int _h = 0; _h < 2; ++_h) _Pragma("unroll") for (int _i = 0; _i < 2; ++_i) { \
        int _r = _sl[_h * HALF + Rr[_i]]; _r = _r < 0 ? 0 : (_r & 65535); (o)[_h][_i] = (unsigned)(_r * K + Cc[_i]) * 2u; } } while (0)
    if constexpr (SLOTS) { PG8_SLOT_DMA(cur, 0); asm volatile("s_waitcnt vmcnt(0)" ::: "memory"); __builtin_amdgcn_s_barrier(); asm volatile("" ::: "memory");
        if constexpr (GATHER) PG8_SLOT_OFFS(0, offA); }
    else if constexpr (GATHER) load_offs(g, cur, Rr, Cc, offA);
    const char* cA = GATHER ? (const char*)g.A : (const char*)g.A + (size_t)cur.pm * tstep; const char* cB = (const char*)g.Bt + (size_t)cur.brow * tstep;
    PG8_STAGE(PG8_SB(0, 0), cB, voffB); PG8_STAGE(PG8_SB(0, 1), cB + hstep, voffB); PG8_STAGE_A(PG8_SA(0, 0), cA, 0); PG8_STAGE_A(PG8_SA(0, 1), cA, 1);
    if (wr == 1) PG8_BAR;
    PG8_WAIT_V(2); PG8_BAR;
    PG8_STAGE(PG8_SB(1, 0), cB + kstep, voffB); PG8_STAGE_A(PG8_SA(1, 0), cA + kstep, 0); PG8_STAGE(PG8_SB(1, 1), cB + hstep + kstep, voffB);
    PG8_WAIT_V(6); PG8_BAR;
    for (;;) {
        const bool has_next = S.next(ui + 1, nxt);
        if constexpr (SLOTS) { if (has_next) PG8_SLOT_DMA(nxt, (ui + 1) & 1); }
        if constexpr (GATHER && SLOTS == 0) { if (has_next) load_offs(g, nxt, Rr, Cc, offN); else {
#pragma unroll
            for (int h = 0; h < 2; ++h)
#pragma unroll
                for (int i = 0; i < 2; ++i) offN[h][i] = offA[h][i]; } }
        const char* nA = has_next ? (GATHER ? (const char*)g.A : (const char*)g.A + (size_t)nxt.pm * tstep) : cA; const char* nB = has_next ? (const char*)g.Bt + (size_t)nxt.brow * tstep : cB;
        for (int t = 0; t < nt; t += 2) {
            const bool last = (t == nt - 2);
            const char* a1 = cA + (size_t)(t + 1) * kstep;
            const char* a2 = last ? nA : cA + (size_t)(t + 2) * kstep; const char* b2 = last ? nB : cB + (size_t)(t + 2) * kstep;
            const char* a3 = a2 + kstep; const char* b3 = b2 + kstep;
            PG8_LDB(B0, 0, 0); PG8_LDB(B1, 0, 1); PG8_SCHED; PG8_LDA(At, 0, 0); PG8_STAGE_A(PG8_SA(1, 1), a1, 1);
            if constexpr (GATHER && SLOTS != 0) { if (last) { if (has_next) PG8_SLOT_OFFS((ui + 1) & 1, offN); else {
#pragma unroll
                for (int h = 0; h < 2; ++h)
#pragma unroll
                    for (int i = 0; i < 2; ++i) offN[h][i] = offA[h][i]; } } }
            if constexpr (GATHER) { if (last) {
#pragma unroll
                for (int h = 0; h < 2; ++h)
#pragma unroll
                    for (int i = 0; i < 2; ++i) offA[h][i] = offN[h][i]; } }
            PG8_WAIT_V(8); PG8_WAIT_L(0); PG8_BAR; PG8_MMA(0, 0, At, B0); PG8_MMA(0, 1, At, B1); PG8_BAR; PG8_SCHED;
            PG8_LDA(At, 0, 1); PG8_STAGE(PG8_SB(0, 0), b2, voffB); PG8_STAGE(PG8_SB(0, 1), b2 + hstep, voffB); PG8_STAGE_A(PG8_SA(0, 0), a2, 0);
            PG8_WAIT_V(8); PG8_WAIT_L(0); PG8_BAR; PG8_MMA(1, 0, At, B0); PG8_MMA(1, 1, At, B1); PG8_BAR; PG8_SCHED;
            PG8_LDB(B0, 1, 0); PG8_LDB(B1, 1, 1); PG8_SCHED; PG8_LDA(At, 1, 0); PG8_STAGE_A(PG8_SA(0, 1), a2, 1);
            PG8_WAIT_V(8); PG8_WAIT_L(0); PG8_BAR; PG8_MMA(0, 0, At, B0); PG8_MMA(0, 1, At, B1); PG8_BAR; PG8_SCHED;
            PG8_LDA(At, 1, 1); PG8_STAGE(PG8_SB(1, 0), b3, voffB); PG8_STAGE(PG8_SB(1, 1), b3 + hstep, voffB); PG8_STAGE_A(PG8_SA(1, 0), a3, 0);
            PG8_WAIT_V(8); PG8_WAIT_L(0); PG8_BAR; PG8_MMA(1, 0, At, B0); PG8_MMA(1, 1, At, B1); PG8_BAR; PG8_SCHED;
        }
        if constexpr (ALIGN_EPI) { if (wr == 0) PG8_BAR; }
        E(acc, cur, wr, wc, lds, ui);
        if (!has_next) break;
#pragma unroll
        for (int a = 0; a < 2; ++a)
#pragma unroll
            for (int b = 0; b < 2; ++b)
#pragma unroll
                for (int m = 0; m < 4; ++m)
#pragma unroll
                    for (int n = 0; n < 2; ++n) acc[a][b][m][n] = (f32x4){0.f, 0.f, 0.f, 0.f};
        cur = nxt; cA = nA; cB = nB; ++ui;
        if constexpr (ALIGN_EPI) { if (wr == 1) PG8_BAR; }
    }
    PG8_WAIT_V(0);
    if constexpr (!ALIGN_EPI) { if (wr == 0) PG8_BAR; }
    PG8_BAR;
#undef PG8_SA
#undef PG8_SB
#undef PG8_STAGE
#undef PG8_STAGE_A
#undef PG8_SLOT_DMA
#undef PG8_SLOT_OFFS
#undef PG8_LDA
#undef PG8_LDB
#undef PG8_MMA
#undef PG8_CAT8
#undef PG8_WAIT_V
#undef PG8_WAIT_L
#undef PG8_BAR
#undef PG8_SCHED
}
}

#define XB_TMO      128
#define XB_XCNT(j)  (256  + 64 * (j))
#define XB_XSUB(j)  (1280 + 64 * (j))
#define XB_XGEN(j)  (2304 + 64 * (j))
#define XB_TOP      3328
#define XB_TOPGEN   3392
#define XCD_BAR_WORDS 3456
#define XB_SPIN_CAP (1u << 18)
__device__ __forceinline__ unsigned xb_ld(unsigned* p)              { return __hip_atomic_load(p, __ATOMIC_RELAXED, __HIP_MEMORY_SCOPE_AGENT); }
__device__ __forceinline__ unsigned xb_add(unsigned* p, unsigned v) { return __hip_atomic_fetch_add(p, v, __ATOMIC_RELAXED, __HIP_MEMORY_SCOPE_AGENT); }
__device__ __forceinline__ unsigned xb_xcc_id() { return (unsigned)__builtin_amdgcn_s_getreg((3 << 11) | 20) & 0xFu; }
#define XB_SPIN(cond, bar) do { unsigned _sp = 0; while (cond) { __builtin_amdgcn_s_sleep(1); \
    if ((++_sp & 255u) == 0u) { if (xb_ld(&(bar)[XB_TMO])) break; if (_sp > XB_SPIN_CAP) { atomicAdd(&(bar)[XB_TMO], 1u); break; } } } } while (0)
struct XcdBarrier { unsigned* bar; unsigned x; volatile LAS unsigned* st; };
__device__ __forceinline__ XcdBarrier xcd_barrier_post(unsigned* bar, volatile LAS unsigned* st) {
    XcdBarrier b; b.bar = bar; b.x = xb_xcc_id(); b.st = st;
    if (threadIdx.x == 0) (void)xb_add(&bar[XB_XCNT(b.x)], 1u);
    return b;
}
__device__ __forceinline__ void xcd_barrier_complete(unsigned* bar, unsigned x, unsigned& nloc, unsigned& nx) {
    const unsigned G = gridDim.x * gridDim.y * gridDim.z;
    unsigned sum, cnt, mine, sp = 0u;
    for (;;) {
        sum = 0u; cnt = 0u; mine = 0u;
#pragma unroll
        for (unsigned j = 0; j < 16; ++j) { const unsigned c = xb_ld(&bar[XB_XCNT(j)]); sum += c; cnt += (c > 0u) ? 1u : 0u; mine = (j == x) ? c : mine; }
        if (sum == G) break;
        __builtin_amdgcn_s_sleep(1);
        if ((++sp & 255u) == 0u) { if (xb_ld(&bar[XB_TMO])) break; if (sp > XB_SPIN_CAP) { atomicAdd(&bar[XB_TMO], 1u); break; } }
    }
    nloc = mine > 0u ? mine : 1u; nx = cnt > 0u ? cnt : 1u;
}
__device__ __forceinline__ void xcd_barrier(const XcdBarrier& b) {
    asm volatile("s_waitcnt vmcnt(0)" ::: "memory");
    __syncthreads();
    if (threadIdx.x == 0) {
        unsigned* bar = b.bar;
        __builtin_amdgcn_s_waitcnt(0);
        unsigned nloc = b.st[0], nx = b.st[1];
        if (nloc == 0u) { xcd_barrier_complete(bar, b.x, nloc, nx); b.st[0] = nloc; b.st[1] = nx; }
        const unsigned old = xb_add(&bar[XB_XSUB(b.x)], 1u);
        const unsigned gen = old / nloc;
        if (old + 1u == (gen + 1u) * nloc) {
            __builtin_amdgcn_fence(__ATOMIC_RELEASE, "agent");
            asm volatile("s_waitcnt vmcnt(0)" ::: "memory");
            const unsigned og = xb_add(&bar[XB_TOP], 1u);
            const unsigned tg = og / nx;
            if (og + 1u == (tg + 1u) * nx) xb_add(&bar[XB_TOPGEN], 1u);
            else XB_SPIN(xb_ld(&bar[XB_TOPGEN]) == tg, bar);
            __builtin_amdgcn_fence(__ATOMIC_ACQUIRE, "agent");
            xb_add(&bar[XB_XGEN(b.x)], 1u);
            asm volatile("s_waitcnt vmcnt(0)" ::: "memory");
        } else {
            XB_SPIN(xb_ld(&bar[XB_XGEN(b.x)]) == gen, bar);
            __builtin_amdgcn_fence(__ATOMIC_ACQUIRE, "agent");
            asm volatile("s_waitcnt vmcnt(0)" ::: "memory");
        }
    }
    __syncthreads();
}

struct Args { const float* in[31]; float* out; unsigned char* ws; int ph_lo, ph_hi; };
typedef const __attribute__((address_space(4))) Args* ArgsP;

struct CvtDesc { const float* W; const float* gain; unsigned char* WT; int N, Kd, k0, n0, drow0; float qs; };
__device__ __forceinline__ CvtDesc cvt_decode(ArgsP a, int it) {
    constexpr int I_IN = 16 * 56, I_SQ = 16 * 32, I_UP = 16 * 88, I_DN = 44 * 32, I_LAYER = I_IN + 5 * I_SQ, I_FFN = 2 * I_UP + I_DN;
    unsigned char* ws = a->ws; CvtDesc d; d.gain = nullptr; d.qs = 0.f;
    if (it < 2 * I_LAYER) {
        const int l = it / I_LAYER; int r = it - l * I_LAYER;
        if (r < I_IN) { d.W = a->in[3] + (size_t)l * D * DIN; d.N = DIN; d.gain = a->in[2] + l * D; d.WT = ws + WS_WIN + (size_t)l * DIN * D * 2; d.Kd = D; d.k0 = 64 * (r / 56); d.n0 = 32 * (r % 56); d.drow0 = d.n0; }
        else { r -= I_IN; const int m = r / I_SQ; r -= m * I_SQ; d.N = D; d.Kd = D; d.k0 = 64 * (r / 32); d.n0 = 32 * (r % 32); d.drow0 = d.n0; const size_t lo = (size_t)l * D * D;
            if (m == 0)      { d.W = a->in[15] + lo; d.WT = ws + WS_WOUT + lo * 2; }
            else if (m == 1) { d.W = a->in[18] + lo; d.gain = a->in[16] + l * D; d.WT = ws + WS_WQ + lo * 2; }
            else if (m == 2) { d.W = a->in[19] + lo; d.gain = a->in[17] + l * D; d.WT = ws + WS_WK + lo * 2; }
            else if (m == 3) { d.W = a->in[20] + lo; d.gain = a->in[17] + l * D; d.WT = ws + WS_WV + lo * 2; }
            else             { d.W = a->in[21] + lo; d.WT = ws + WS_WO + lo * 2; } }
    } else {
        it -= 2 * I_LAYER; const int ex = it / I_FFN; int r = it - ex * I_FFN;
        const float *wg, *wu, *wd, *gn;
        if (ex == 0) { wg = a->in[23]; wu = a->in[24]; wd = a->in[25]; gn = a->in[22]; }
        else { const size_t e = ex - 1; wg = a->in[27] + e * D * DFF; wu = a->in[28] + e * D * DFF; wd = a->in[29] + e * DFF * D; gn = a->in[22] + D; }
        const bool up = r < 2 * I_UP;
        if (up) { const int isu = r >= I_UP; r -= isu * I_UP; d.W = isu ? wu : wg; d.N = DFF; d.gain = gn; d.Kd = D; d.k0 = 64 * (r / 88); d.n0 = 32 * (r % 88); d.drow0 = (d.n0 >> 7) * 256 + (d.n0 & 127) + (isu ? 128 : 0); }
        else { r -= 2 * I_UP; d.W = wd; d.N = D; d.Kd = DFF; d.k0 = 64 * (r / 32); d.n0 = 32 * (r % 32); d.drow0 = d.n0; }
        if (ex == 0) d.WT = up ? ws + WS_WGU : ws + WS_WD;
        else { const size_t e = ex - 1; d.WT = up ? ws + WS_MWGU + e * 2 * DFF * D : ws + WS_MWD + e * D * DFF; d.qs = up ? S8_UP : S8_DN; }
    }
    return d;
}
__device__ __forceinline__ void cvt_load(const CvtDesc& d, int lane, f32x4 (&v)[8], float (&g)[8]) {
    const float* p = d.W + (size_t)(d.k0 + (lane >> 3)) * d.N + d.n0 + 4 * (lane & 7);
#pragma unroll
    for (int j = 0; j < 8; ++j) { v[j] = *(const f32x4*)(p + (size_t)(8 * j) * d.N); g[j] = d.gain ? d.gain[d.k0 + (lane >> 3) + 8 * j] : 1.0f; }
}
__device__ __forceinline__ void cvt_store(const CvtDesc& d, int lane, const f32x4 (&v)[8], const float (&g)[8], LAS float* scr) {
    const float qm = d.qs != 0.f ? d.qs : 1.0f;
#pragma unroll
    for (int j = 0; j < 8; ++j) { LAS float* sp = scr + ((lane >> 3) + 8 * j) * 33 + 4 * (lane & 7); const float m = g[j] * qm;
        sp[0] = v[j][0] * m; sp[1] = v[j][1] * m; sp[2] = v[j][2] * m; sp[3] = v[j][3] * m; }
    asm volatile("s_waitcnt lgkmcnt(0)" ::: "memory");
    if (d.qs == 0.f) { const int c = lane & 7;
#pragma unroll
        for (int j = 0; j < 4; ++j) { const int n = (lane >> 3) + 8 * j; const LAS float* s = scr + (8 * c) * 33 + n;
            u32x4 o; o.x = pk_bf16(s[0 * 33], s[1 * 33]); o.y = pk_bf16(s[2 * 33], s[3 * 33]); o.z = pk_bf16(s[4 * 33], s[5 * 33]); o.w = pk_bf16(s[6 * 33], s[7 * 33]);
            *(u32x4*)(d.WT + ((size_t)(d.drow0 + n) * d.Kd + d.k0 + 8 * c) * 2) = o; }
    } else { const int c = lane & 3;
#pragma unroll
        for (int j = 0; j < 2; ++j) { const int n = (lane >> 2) + 16 * j; const LAS float* s = scr + (16 * c) * 33 + n;
            u32x4 o; o.x = pk_fp8x4(s[0 * 33], s[1 * 33], s[2 * 33], s[3 * 33]); o.y = pk_fp8x4(s[4 * 33], s[5 * 33], s[6 * 33], s[7 * 33]);
            o.z = pk_fp8x4(s[8 * 33], s[9 * 33], s[10 * 33], s[11 * 33]); o.w = pk_fp8x4(s[12 * 33], s[13 * 33], s[14 * 33], s[15 * 33]);
            *(u32x4*)(d.WT + (size_t)(d.drow0 + n) * d.Kd + d.k0 + 16 * c) = o; }
    }
    asm volatile("s_waitcnt lgkmcnt(0)" ::: "memory");
}

__device__ __forceinline__ void phase_prologue(ArgsP a, LAS unsigned char* lds, int vcu, int G, int tid, int lane, int wave) {
    unsigned char* ws = a->ws;
    LAS float* scr = (LAS float*)(lds + wave * 16384);
    const int gw = vcu * NWAVES + wave, NGW = G * NWAVES;
    constexpr int NITEMS = 2 * (16 * 56 + 5 * 16 * 32) + 9 * (2 * 16 * 88 + 44 * 32);
    {
        f32x4* rowss0 = (f32x4*)(ws + WS_ROWSS);
        for (int m0 = 4 * gw; m0 < T + MROWS; m0 += 4 * NGW) {
            f32x4 v[4][4];
#pragma unroll
            for (int q = 0; q < 4; ++q) { const int m = m0 + q; const bool isx = m < T; const int r = isx ? m : m - T;
                const f32x4* xr = (const f32x4*)((isx ? a->in[0] : a->in[1]) + (size_t)r * D) + lane;
#pragma unroll
                for (int j = 0; j < 4; ++j) v[q][j] = xr[64 * j]; }
#pragma unroll
            for (int q = 0; q < 4; ++q) { const int m = m0 + q; const bool isx = m < T; const int r = isx ? m : m - T; float s = 0.f;
#pragma unroll
                for (int j = 0; j < 4; ++j) s += (v[q][j][0] * v[q][j][0] + v[q][j][1] * v[q][j][1]) + (v[q][j][2] * v[q][j][2] + v[q][j][3] * v[q][j][3]);
                s = wave_sum(s);
                u32x2* o8 = (u32x2*)((isx ? (bf16*)(ws + WS_XB) : (bf16*)(ws + WS_MEMB)) + (size_t)r * D) + lane;
#pragma unroll
                for (int j = 0; j < 4; ++j) { u32x2 w; w.x = pk_bf16(v[q][j][0], v[q][j][1]); w.y = pk_bf16(v[q][j][2], v[q][j][3]); o8[64 * j] = w; }
                if (lane == 0) { if (isx) rowss0[r] = (f32x4){s, 0.f, 0.f, 0.f}; else ((u64*)(ws + OFF_MEMSS))[r] = ss_to_fix(s); } }
        }
    }
    if (gw < NITEMS) {
        CvtDesc d0 = cvt_decode(a, gw); f32x4 v[8]; float g[8]; cvt_load(d0, lane, v, g);
        for (int it = gw; it < NITEMS; it += NGW) {
            const int itn = it + NGW; const bool hn = itn < NITEMS;
            CvtDesc dn = d0; f32x4 w[8]; float gn[8];
            if (hn) { dn = cvt_decode(a, itn); cvt_load(dn, lane, w, gn); }
            cvt_store(d0, lane, v, g, scr);
            if (hn) { d0 = dn;
#pragma unroll
                for (int j = 0; j < 8; ++j) { v[j] = w[j]; g[j] = gn[j]; } }
        }
    }
    const int gt = vcu * NTHREADS + tid, NGT = G * NTHREADS;
    for (int i = gt; i < 2 * 4 * 128 * 128; i += NGT) { const int ii = (i >> 7) & 127, jj = i & 127; const float v = a->in[10][i]; ((bf16*)(ws + WS_SGUW))[i] = f2bf(((ii >> 6) >= (jj >> 6)) ? v : 0.f); }
    for (int i = gt; i < 2 * 4 * 64 * 64; i += NGT) { const int lg = i >> 12, o = (i >> 6) & 63, ii = i & 63; ((bf16*)(ws + WS_POOLW))[i] = f2bf(a->in[12][(lg << 12) + ii * 64 + o]); }
}

__device__ __forceinline__ void mixer_unit(ArgsP a, LAS unsigned char* lds, int l, int u, int tid_in, int lane_in, int wave) {
    int tid = tid_in, lane = lane_in;
    const bf16* z = (const bf16*)(a->ws + WS_Z); bf16* mixed = (bf16*)(a->ws + WS_MIXED);
    const int b = u >> 5, c = u & 31, t0 = c * 128; const size_t R0 = (size_t)b * SEQ + t0;
    u32x4 cvp[9], rv[12]; float sgl, sgb;
    MSEC(0);
    {
        const float* cw = a->in[4] + l * 31 * 384; const float* cb = a->in[5] + l * 384; const float* lg = a->in[6] + l * 384; const float* lb = a->in[7] + l * 384;
        LAS unsigned* wl = (LAS unsigned*)(lds + 135168);
        OPAQUE(tid);
        f32x2 cbv[3], lgv[3], lbv[3];
#pragma unroll
        for (int jt = 0; jt < 3; ++jt) { const unsigned p2 = (unsigned)((tid + NTHREADS * jt) % 192) * 8u; cbv[jt] = *(const f32x2*)((const char*)cb + p2); lgv[jt] = *(const f32x2*)((const char*)lg + p2); lbv[jt] = *(const f32x2*)((const char*)lb + p2); }
#pragma unroll 1
        for (int hb = 0; hb < 2; ++hb) { f32x2 wst[6];
#pragma unroll
          for (int q = 0; q < 6; ++q) { const unsigned idx = (unsigned)tid + (unsigned)(hb * 6 + q) * NTHREADS; wst[q] = (f32x2){0.f, 0.f}; if (idx < 31u * 192u) wst[q] = *(const f32x2*)((const char*)cw + idx * 8u); }
#pragma unroll
          for (int q = 0; q < 6; ++q) { const unsigned idx = (unsigned)tid + (unsigned)(hb * 6 + q) * NTHREADS; if (idx < 31u * 192u) wl[idx] = pk_bf16(wst[q].x, wst[q].y); } }
#pragma unroll 1
        for (int it0 = tid; it0 < 158 * 48; it0 += 5 * NTHREADS) {
            u32x4 av[5], gv[5];
#pragma unroll
            for (int q5 = 0; q5 < 5; ++q5) { const int it = it0 + q5 * NTHREADS, j = it / 48, v = it - j * 48; av[q5] = (u32x4){0u, 0u, 0u, 0u}; gv[q5] = av[q5];
                if (it < 158 * 48 && t0 - 30 + j >= 0) { const bf16* rp = z + (R0 + j - 30) * DIN + 8 * v; av[q5] = *(const u32x4*)rp; gv[q5] = *(const u32x4*)(rp + 384); } }
#pragma unroll
            for (int q5 = 0; q5 < 5; ++q5) { const int it = it0 + q5 * NTHREADS, j = it / 48, v = it - j * 48; u32x4 o;
#pragma unroll
                for (int q = 0; q < 4; ++q) o[q] = pk_bf16(bf_lo(av[q5][q]) * sigm(bf_lo(gv[q5][q])), bf_hi(av[q5][q]) * sigm(bf_hi(gv[q5][q])));
                if (it < 158 * 48) *(LAS u32x4*)(lds + j * 768 + v * 16) = o; }
        }
        __syncthreads();
        MSEC(1);
        LAS float* part = (LAS float*)(lds + 122880);
        LAS float* fin = (LAS float*)(lds + 159744);
        OPAQUE(tid); lane = tid & 63;
#pragma unroll 1
        for (int jt = 0; jt < 3; ++jt) { const int item = tid + NTHREADS * jt, rg = item / 192, p = item - rg * 192, q3 = p >> 6;
            f32x2 w[31];
#pragma unroll
            for (int k = 0; k < 31; ++k) { const unsigned wq = wl[k * 192 + p]; w[k] = (f32x2){bf_lo(wq), bf_hi(wq)}; }
            const f32x2 bias = jt == 0 ? cbv[0] : jt == 1 ? cbv[1] : cbv[2];
            float y0[16], y1[16];
#pragma unroll
            for (int i = 0; i < 16; ++i) { y0[i] = bias.x; y1[i] = bias.y; }
            const LAS unsigned* hp = (const LAS unsigned*)lds + (rg * 16) * 192 + p;
#pragma unroll
            for (int jj = 0; jj < 46; ++jj) { const unsigned hv = hp[jj * 192]; const float h0 = bf_lo(hv), h1 = bf_hi(hv);
#pragma unroll
                for (int i = 0; i < 16; ++i) { const int k = jj - i; if (k >= 0 && k <= 30) { y0[i] += w[k].x * h0; y1[i] += w[k].y * h1; } } }
#pragma unroll
            for (int i = 0; i < 16; ++i) { float s1 = y0[i] + y1[i], s2 = y0[i] * y0[i] + y1[i] * y1[i];
                s1 = row16_sum(s1); s2 = row16_sum(s2);
                if ((lane & 15) == 0) { const int pi = ((rg * 16 + i) * 12 + q3 * 4 + (lane >> 4)) * 2; part[pi] = s1; part[pi + 1] = s2; }
                *(unsigned*)(mixed + (R0 + rg * 16 + i) * D + 2 * p) = pk_bf16(y0[i], y1[i]); }
        }
        __syncthreads();
        MSEC(2);
        OPAQUE(tid);
#pragma unroll
        for (int q9 = 0; q9 < 9; ++q9) { const int it = tid + q9 * NTHREADS, j = it >> 5, v = it & 31; cvp[q9] = (u32x4){0u, 0u, 0u, 0u};
            if (it < 143 * 32 && t0 - 15 + j >= 0) cvp[q9] = *(const u32x4*)(z + (R0 + j - 15) * DIN + 1536 + 8 * v); }
        if (tid < 256) { const LAS float* pr = part + (tid >> 1) * 24 + (tid & 1); float sm = 0.f;
#pragma unroll
            for (int k = 0; k < 12; ++k) sm += pr[2 * k];
            fin[tid] = sm; }
        __syncthreads();
        OPAQUE(tid);
#pragma unroll 1
        for (int jt = 0; jt < 3; ++jt) { const int item = tid + NTHREADS * jt, rg = item / 192, p = item - rg * 192;
            const f32x2 g2 = jt == 0 ? lgv[0] : jt == 1 ? lgv[1] : lgv[2], b2 = jt == 0 ? lbv[0] : jt == 1 ? lbv[1] : lbv[2];
#pragma unroll
            for (int i = 0; i < 16; ++i) { const int row = rg * 16 + i;
                const float S1 = fin[row * 2], S2 = fin[row * 2 + 1];
                const float mean = S1 * (1.0f / 384.0f), var = S2 * (1.0f / 384.0f) - mean * mean, rstd = __builtin_amdgcn_rsqf(var + EPS);
                unsigned* mp = (unsigned*)(mixed + (R0 + row) * D + 2 * p); const unsigned yv = *mp;
                const float o0 = (bf_lo(yv) - mean) * rstd * g2.x + b2.x, o1 = (bf_hi(yv) - mean) * rstd * g2.y + b2.y;
                *mp = pk_bf16(silu_f(o0), silu_f(o1)); } }
    }
    {
        MSEC(3);
        OPAQUE(tid); lane = tid & 63;
        const bf16* pwT = (const bf16*)(a->ws + WS_POOLW) + l * 4 * 64 * 64; const float* pb = a->in[13] + l * 256; const float* psc = a->in[14] + l * 256;
        {
#pragma unroll
            for (int q9 = 0; q9 < 9; ++q9) { const int it = tid + q9 * NTHREADS, j = it >> 5, v = it & 31; if (it < 143 * 32) *(LAS u32x4*)(lds + j * 512 + v * 16) = cvp[q9]; } }
        __syncthreads();
        OPAQUE(tid);
        bf16x8 pwf[2][4]; f32x4 pbv[4], pscv[4];
        { const int l2 = tid & 63, r = l2 & 15, kq = l2 >> 4, g = wave & 3;
#pragma unroll
            for (int ks = 0; ks < 2; ++ks)
#pragma unroll
                for (int n = 0; n < 4; ++n) pwf[ks][n] = *(const bf16x8*)(pwT + ((g * 64 + 16 * n + r) * 64 + 32 * ks + 8 * kq));
#pragma unroll
            for (int n = 0; n < 4; ++n) { const int ch = g * 64 + 16 * n + 4 * kq; pbv[n] = *(const f32x4*)(pb + ch); pscv[n] = *(const f32x4*)(psc + ch); } }
        sgl = 0.f; sgb = 0.f; if (tid < 384) { sgl = a->in[8][l * 384 + tid]; sgb = a->in[9][l * 384 + tid]; }
#pragma unroll
        for (int q12 = 0; q12 < 12; ++q12) rv[q12] = *(const u32x4*)(z + (R0 + (tid & 127)) * DIN + 1152 + (tid >> 7) * 96 + 8 * q12);
        { const int pp = tid & 127, rq = tid >> 7; const int w = 2 << (pp >> 5); const LAS unsigned* cp = (const LAS unsigned*)lds + pp; const int i0 = rq * 32;
            float s0 = 0.f, s1 = 0.f;
#pragma unroll
            for (int kk = 0; kk < 16; ++kk) if (kk < w) { const unsigned v = cp[(i0 + 15 - kk) * 128]; s0 += bf_lo(v); s1 += bf_hi(v); }
#pragma unroll 8
            for (int ii = 0; ii < 32; ++ii) { const int i = i0 + ii; const unsigned cv = cp[(i + 15) * 128];
                const int tpos = t0 + i + 1; const float inv = 1.0f / (float)(tpos < w ? tpos : w);
                *(LAS unsigned*)(lds + 73728 + i * 528 + pp * 4) = pk_bf16(s0 * inv - bf_lo(cv), s1 * inv - bf_hi(cv));
                if (ii < 31) { const unsigned vn = cp[(i + 16) * 128], vo = cp[(i + 16 - w) * 128]; s0 += bf_lo(vn) - bf_lo(vo); s1 += bf_hi(vn) - bf_hi(vo); } } }
        __syncthreads();
        OPAQUE(tid); lane = tid & 63;
        { const int r = lane & 15, kq = lane >> 4, g = wave & 3, rh = wave >> 2; f32x4 acc[4][4];
#pragma unroll
            for (int rt = 0; rt < 4; ++rt)
#pragma unroll
                for (int n = 0; n < 4; ++n) acc[rt][n] = (f32x4){0.f, 0.f, 0.f, 0.f};
#pragma unroll
            for (int ks = 0; ks < 2; ++ks)
#pragma unroll
                for (int rt = 0; rt < 4; ++rt) { const bf16x8 af = *(const LAS bf16x8*)(lds + 73728 + (64 * rh + 16 * rt + r) * 528 + (g * 64 + 32 * ks + 8 * kq) * 2);
#pragma unroll
                    for (int n = 0; n < 4; ++n) acc[rt][n] = __builtin_amdgcn_mfma_f32_16x16x32_bf16(pwf[ks][n], af, acc[rt][n], 0, 0, 0); }
#pragma unroll
            for (int n = 0; n < 4; ++n) { const int ch = g * 64 + 16 * n + 4 * kq; const f32x4 b4 = pbv[n], s4 = pscv[n];
#pragma unroll
                for (int rt = 0; rt < 4; ++rt) { const int row = 64 * rh + 16 * rt + r; const f32x4 o = (acc[rt][n] + b4) * s4;
                    u32x2 w2; w2.x = pk_bf16(o[0], o[1]); w2.y = pk_bf16(o[2], o[3]); *(u32x2*)(mixed + (R0 + row) * D + 768 + ch) = w2; } } }
        __syncthreads();
    }
    {
        MSEC(4);
        OPAQUE(tid); lane = tid & 63;
        const float* lg = a->in[8] + l * 384; const float* lb = a->in[9] + l * 384; const float* sb = a->in[11] + l * 4 * 128;
        const bf16* Wm = (const bf16*)(a->ws + WS_SGUW) + (size_t)l * 4 * 128 * 128;
        LAS float* prm = (LAS float*)(lds + 126976);
        if (tid < 384) { prm[tid] = sgl; prm[384 + tid] = sgb; }
        { const int j = tid & 127, qd = __builtin_amdgcn_readfirstlane(tid >> 7); float vv[96]; float s1 = 0.f, s2 = 0.f;
#pragma unroll
            for (int k = 0; k < 12; ++k) { const u32x4 x = rv[k];
#pragma unroll
                for (int q = 0; q < 4; ++q) { const float e0 = gelu_tanh(bf_lo(x[q])), e1 = gelu_tanh(bf_hi(x[q])); vv[8 * k + 2 * q] = e0; vv[8 * k + 2 * q + 1] = e1; s1 += e0 + e1; s2 += e0 * e0 + e1 * e1; } }
            LAS float* st = (LAS float*)(lds + 122880);
            st[(j * 4 + qd) * 2] = s1; st[(j * 4 + qd) * 2 + 1] = s2;
            __syncthreads();
            const float S1 = st[j * 8] + st[j * 8 + 2] + st[j * 8 + 4] + st[j * 8 + 6], S2 = st[j * 8 + 1] + st[j * 8 + 3] + st[j * 8 + 5] + st[j * 8 + 7];
            const float mean = S1 * (1.0f / 384.0f), var = S2 * (1.0f / 384.0f) - mean * mean, rstd = __builtin_amdgcn_rsqf(var + EPS);
#pragma unroll
            for (int cidx = 0; cidx < 96; ++cidx) { const float o = (vv[cidx] - mean) * rstd * prm[qd * 96 + cidx] + prm[384 + qd * 96 + cidx];
                *(LAS bf16*)(lds + (qd * 96 + cidx) * 272 + j * 2) = f2bf(o); } }
        __syncthreads();
        MSEC(5);
        OPAQUE(tid); lane = tid & 63;
        { const int hd = wave >> 1, ih = wave & 1, r = lane & 15, kq = lane >> 4; f32x4 acc[6][4];
#pragma unroll
            for (int dt = 0; dt < 6; ++dt)
#pragma unroll
                for (int it = 0; it < 4; ++it) acc[dt][it] = (f32x4){0.f, 0.f, 0.f, 0.f};
            bf16x8 wf[4][4]; u32x2 uu[4][6];
            const bf16* Wh = Wm + (size_t)hd * 128 * 128;
#pragma unroll
            for (int ks = 0; ks < 4; ++ks)
#pragma unroll
                for (int it = 0; it < 4; ++it) wf[ks][it] = *(const bf16x8*)(Wh + (64 * ih + 16 * it + r) * 128 + 32 * ks + 8 * kq);
#pragma unroll
            for (int it = 0; it < 4; ++it)
#pragma unroll
                for (int dt = 0; dt < 6; ++dt) uu[it][dt] = *(const u32x2*)(z + (R0 + 64 * ih + 16 * it + r) * DIN + 768 + hd * 96 + 16 * dt + 4 * kq);
#pragma unroll
            for (int ks = 0; ks < 4; ++ks) { if (ks >= 2 && ih == 0) continue;
#pragma unroll
                for (int dt = 0; dt < 6; ++dt) { const bf16x8 vf = *(const LAS bf16x8*)(lds + (hd * 96 + 16 * dt + r) * 272 + (32 * ks + 8 * kq) * 2);
#pragma unroll
                    for (int it = 0; it < 4; ++it) acc[dt][it] = __builtin_amdgcn_mfma_f32_16x16x32_bf16(vf, wf[ks][it], acc[dt][it], 0, 0, 0); } }
#pragma unroll
            for (int it = 0; it < 4; ++it) { const int i = 64 * ih + 16 * it + r; const float sbv = sb[hd * 128 + i];
#pragma unroll
                for (int dt = 0; dt < 6; ++dt) { const int ch = hd * 96 + 16 * dt + 4 * kq; const u32x2 u2 = uu[it][dt];
                    const float o0 = gelu_tanh(bf_lo(u2.x)) * (acc[dt][it][0] + sbv), o1 = gelu_tanh(bf_hi(u2.x)) * (acc[dt][it][1] + sbv);
                    const float o2 = gelu_tanh(bf_lo(u2.y)) * (acc[dt][it][2] + sbv), o3 = gelu_tanh(bf_hi(u2.y)) * (acc[dt][it][3] + sbv);
                    u32x2 w2; w2.x = pk_bf16(o0, o1); w2.y = pk_bf16(o2, o3); *(u32x2*)(mixed + (R0 + i) * D + 384 + ch) = w2; } } }
        __syncthreads();
        MSEC(6);
    }
}

__device__ __forceinline__ void attn_dma_k(const bf16* Kbase, int t, unsigned ldsbase, int wave, int lane) {
#pragma unroll
    for (int i = 0; i < 4; ++i) { const int pi = wave * 4 + i, rowt = 2 * pi + (lane >> 5), cl = (lane & 31) ^ (rowt & 31);
        pg8::glds_s((const void*)Kbase, (unsigned)((64 * t + rowt) * 2048 + cl * 8) * 2u, ldsbase + (unsigned)t * 32768u + (unsigned)pi * 1024u); }
}
__device__ __forceinline__ void attn_dma_v(const bf16* Vbase, int t, unsigned ldsbase, int wave, int lane) {
#pragma unroll
    for (int i = 0; i < 4; ++i) { const int pi = wave * 4 + i, row = 8 * pi + (lane >> 3), cl = (lane & 7) ^ (row & 7);
        pg8::glds_s((const void*)Vbase, (unsigned)(row * 2048 + 64 * t + cl * 8) * 2u, ldsbase + (unsigned)t * 32768u + (unsigned)pi * 1024u); }
}
__device__ __forceinline__ void attn_phase(ArgsP a, LAS unsigned char* lds, int l, int vcu, int G, int tid, int wave) {
    const bf16* Q = (const bf16*)(a->ws + WS_Q); bf16* O = (bf16*)(a->ws + WS_O);
    const bf16* KB = (const bf16*)(a->ws + WS_KB); const bf16* VT = (const bf16*)(a->ws + WS_VT);
    const unsigned ldsbase = (unsigned)(size_t)lds;
    int lane = tid & 63;
    bool first = true;
    bf16x8 qf[16];
#define ATT_LOADQ(uu, s0, s1) do { const int _bh = (uu) >> 4; const bf16* _qp = Q + ((size_t)(_bh >> 2) * SEQ + ((uu) & 15) * 256 + wave * 32 + (lane & 31)) * D + (_bh & 3) * 256 + 8 * (lane >> 5); \
        _Pragma("unroll") for (int s = s0; s < s1; ++s) qf[s] = *(const bf16x8*)(_qp + 16 * s); } while (0)
    constexpr int QPRE_N = 6;
    if (ATT_QPRE && vcu < 512) ATT_LOADQ(vcu, 0, QPRE_N);
    for (int u = vcu; u < 512; u += G) {
        const int qt = u & 15, bh = u >> 4, b = bh >> 2, h = bh & 3;
        const int un = u + G; const bool has_next = un < 512;
        const bf16* Kbase = KB + (size_t)(b * 256) * 2048 + l * 1024 + h * 256;
        const bf16* Vbase = VT + (size_t)(l * 1024 + h * 256) * 2048 + b * 256;
        const bf16* Knext = KB + (size_t)(((un >> 4) >> 2) * 256) * 2048 + l * 1024 + ((un >> 4) & 3) * 256;
        OPAQUE(lane);
        if (first) {
#pragma unroll
            for (int t = 0; t < 4; ++t) attn_dma_k(Kbase, t, ldsbase, wave, lane); }
        first = false;
        const int r = lane & 31, h2 = lane >> 5;
        if (!ATT_QPRE) ATT_LOADQ(u, 0, 16);
        asm volatile("s_waitcnt vmcnt(0)" ::: "memory");
        __syncthreads();
        if (ATT_QPRE) ATT_LOADQ(u, QPRE_N, 16);
        f32x16 sacc[8];
#pragma unroll
        for (int kt = 0; kt < 8; ++kt)
#pragma unroll
            for (int j = 0; j < 16; ++j) sacc[kt][j] = 0.f;
#define ATT_LDK(i) (*(const LAS bf16x8*)(lds + ((i) >> 5) * 32768 + (32 * ((i) & 1) + r) * 512 + (((2 * (((i) >> 1) & 15) + h2) ^ r) * 16)))
        { bf16x8 kb[4];
#pragma unroll
          for (int i = 0; i < 4; ++i) kb[i] = ATT_LDK(i);
#pragma unroll
          for (int idx = 0; idx < 128; ++idx) { const int t = idx >> 5, sq = (idx >> 1) & 15, k2 = idx & 1;
              sacc[2 * t + k2] = __builtin_amdgcn_mfma_f32_32x32x16_bf16(kb[idx & 3], qf[sq], sacc[2 * t + k2], 0, 0, 0);
              if (idx + 4 < 128) kb[idx & 3] = ATT_LDK(idx + 4);
              __builtin_amdgcn_sched_barrier(0);
              if ((idx & 31) == 31) {
                  asm volatile("" ::: "memory"); __builtin_amdgcn_s_barrier(); asm volatile("" ::: "memory");
                  OPAQUE(lane); attn_dma_v(Vbase, t, ldsbase, wave, lane); __builtin_amdgcn_sched_barrier(0); } } }
#undef ATT_LDK
        float mx = -3.0e38f;
#pragma unroll
        for (int kt = 0; kt < 8; ++kt)
#pragma unroll
            for (int j = 0; j < 16; ++j) mx = fmaxf(mx, sacc[kt][j]);
        mx = fmaxf(mx, shfl_xor_f(mx, 32));
        float sum = 0.f; bf16x8 pf[8][2];
#pragma unroll
        for (int kt = 0; kt < 8; ++kt) {
            float p[16];
#pragma unroll
            for (int j = 0; j < 16; ++j) { p[j] = __builtin_amdgcn_exp2f(sacc[kt][j] - mx); sum += p[j]; }
#pragma unroll
            for (int s2 = 0; s2 < 2; ++s2) { u32x4 w; w.x = pk_bf16_v(p[8 * s2], p[8 * s2 + 1]); w.y = pk_bf16_v(p[8 * s2 + 2], p[8 * s2 + 3]); w.z = pk_bf16_v(p[8 * s2 + 4], p[8 * s2 + 5]); w.w = pk_bf16_v(p[8 * s2 + 6], p[8 * s2 + 7]);
                pf[kt][s2] = __builtin_bit_cast(bf16x8, w); }
            __builtin_amdgcn_sched_barrier(0); }
        sum += shfl_xor_f(sum, 32);
        const float inv = 1.0f / sum;
        f32x16 oacc[8]; f32x16 zero16;
#pragma unroll
        for (int j = 0; j < 16; ++j) zero16[j] = 0.f;
        asm volatile("s_waitcnt vmcnt(12)" ::: "memory"); __builtin_amdgcn_s_barrier(); asm volatile("" ::: "memory");
        { OPAQUE(lane); const int r2 = lane & 31, g2 = lane >> 5;
#define ATT_LDV(t, j) (*(const LAS bf16x8*)(lds + (t) * 32768 + (32 * ((j) & 7) + r2) * 128 + (((2 * ((j) >> 3) + g2) ^ (r2 & 7)) * 16)))
#pragma unroll
          for (int t = 0; t < 4; ++t) { bf16x8 vb[4];
#pragma unroll
              for (int i = 0; i < 4; ++i) vb[i] = ATT_LDV(t, i);
#pragma unroll
              for (int j = 0; j < 32; ++j) { const int s4 = j >> 3, dt = j & 7;
                  oacc[dt] = __builtin_amdgcn_mfma_f32_32x32x16_bf16(vb[j & 3], pf[2 * t + (s4 >> 1)][s4 & 1], (t == 0 && s4 == 0) ? zero16 : oacc[dt], 0, 0, 0);
                  if (j + 4 < 32) vb[j & 3] = ATT_LDV(t, j + 4);
                  __builtin_amdgcn_sched_barrier(0); }
              if (t < 3) { if (has_next) asm volatile("s_waitcnt vmcnt(8)" ::: "memory");
                  else if (t == 0) asm volatile("s_waitcnt vmcnt(8)" ::: "memory"); else if (t == 1) asm volatile("s_waitcnt vmcnt(4)" ::: "memory"); else asm volatile("s_waitcnt vmcnt(0)" ::: "memory"); }
              asm volatile("" ::: "memory"); __builtin_amdgcn_s_barrier(); asm volatile("" ::: "memory");
              if (has_next) { int l2 = lane; OPAQUE(l2); attn_dma_k(Knext, t, ldsbase, wave, l2); __builtin_amdgcn_sched_barrier(0); } }
#undef ATT_LDV
        }
        { OPAQUE(lane); const int r2 = lane & 31, g2 = lane >> 5; LAS unsigned char* pat = lds + 131072 + wave * 2048;
#pragma unroll
            for (int dp = 0; dp < 4; ++dp)
#pragma unroll
                for (int rh = 0; rh < 2; ++rh) {
                    if (ATT_QPRE && dp == 2 && rh == 0 && has_next) ATT_LOADQ(un, 0, QPRE_N);
                    if ((r2 >> 4) == rh) {
#pragma unroll
                        for (int d2 = 0; d2 < 2; ++d2)
#pragma unroll
                            for (int g4 = 0; g4 < 4; ++g4) { const int dt = 2 * dp + d2; u32x2 w; w.x = pk_bf16(oacc[dt][4 * g4] * inv, oacc[dt][4 * g4 + 1] * inv); w.y = pk_bf16(oacc[dt][4 * g4 + 2] * inv, oacc[dt][4 * g4 + 3] * inv);
                                const int c8 = d2 * 8 + g4 * 2 + g2, lr = r2 & 15;
                                *(LAS u32x2*)(pat + lr * 128 + ((((c8 >> 1) ^ (lr & 7)) * 16) + (c8 & 1) * 8)) = w; } }
                    asm volatile("s_waitcnt lgkmcnt(0)" ::: "memory");
#pragma unroll
                    for (int j = 0; j < 2; ++j) { const int row = 8 * j + (lane >> 3), c = lane & 7;
                        const u32x4 w = *(const LAS u32x4*)(pat + row * 128 + ((c ^ (row & 7)) * 16));
                        *(u32x4*)(O + ((size_t)b * SEQ + qt * 256 + wave * 32 + rh * 16 + row) * D + h * 256 + dp * 64 + c * 8) = w; }
                    asm volatile("s_waitcnt lgkmcnt(0)" ::: "memory");
                }
        }
    }
#undef ATT_LOADQ
    asm volatile("s_waitcnt vmcnt(0)" ::: "memory");
    __syncthreads();
}

constexpr size_t WS_CHUNKCNT = WS_ROUTE + 4 * (size_t)T * 4 + 3 * (size_t)PERMROWS * 4;
__device__ __forceinline__ void phase_router(ArgsP a, LAS unsigned char* lds, int vcu, int G, int tid, int lane, int wave) {
    unsigned char* ws = a->ws;
    constexpr int BP = 2064;
    LAS unsigned char* bt = lds;
    LAS float* lg = (LAS float*)(lds + 36864 + wave * 512);
    LAS int* hist = (LAS int*)(lds + 36864 + 4096);
    const float* gn = a->in[22] + D; const float* rw = a->in[26];
    { f32x4 wv[2][2]; float gk[2];
#pragma unroll
        for (int q = 0; q < 2; ++q) { const int k = tid + NTHREADS * q; wv[q][0] = *(const f32x4*)(rw + k * 8); wv[q][1] = *(const f32x4*)(rw + k * 8 + 4); gk[q] = gn[k]; }
#pragma unroll
        for (int q = 0; q < 2; ++q) { const int k = tid + NTHREADS * q;
#pragma unroll
            for (int e = 0; e < 8; ++e) { const float w = gk[q] * wv[q][e >> 2][e & 3];
                const unsigned hi = pk_bf16(w, 0.f) & 0xffffu; const float hif = __uint_as_float(hi << 16);
                *(LAS bf16*)(bt + e * BP + k * 2) = (bf16)hi; *(LAS bf16*)(bt + (8 + e) * BP + k * 2) = f2bf(w - hif); } } }
    const f32x4* rowss = (const f32x4*)(ws + WS_ROWSS) + 5 * T;
    int* sel = (int*)(ws + WS_ROUTE); float* gate = (float*)(ws + WS_ROUTE + 2 * T * 4); int* chunkcnt = (int*)(ws + WS_CHUNKCNT);
    const int r = lane & 15, kq = lane >> 4;
    for (int chunk = vcu; chunk < T / 128; chunk += G) {
        __syncthreads();
        if (tid < 8) hist[tid] = 0;
        __syncthreads();
        const int mb = chunk * 128 + wave * 16;
        const bf16* xp = (const bf16*)(ws + WS_XB) + (size_t)(mb + r) * D + 8 * kq;
        float rs[4];
#pragma unroll
        for (int i = 0; i < 4; ++i) rs[i] = rstd4(rowss[mb + 4 * kq + i]);
        f32x4 acc = {0.f, 0.f, 0.f, 0.f};
#pragma unroll
        for (int hf = 0; hf < 2; ++hf) { bf16x8 af[16];
#pragma unroll
            for (int s = 0; s < 16; ++s) af[s] = *(const bf16x8*)(xp + 32 * (16 * hf + s));
#pragma unroll
            for (int s = 0; s < 16; ++s) { const bf16x8 bfr = *(const LAS bf16x8*)(bt + r * BP + (32 * (16 * hf + s) + 8 * kq) * 2);
                acc = __builtin_amdgcn_mfma_f32_16x16x32_bf16(af[s], bfr, acc, 0, 0, 0); } }
#pragma unroll
        for (int i = 0; i < 4; ++i) { const float v = acc[i] + dpp_f<0x128>(acc[i]); if (r < 8) lg[(4 * kq + i) * 8 + r] = v * rs[i]; }
        asm volatile("s_waitcnt lgkmcnt(0)" ::: "memory");
        if (lane < 16) { const int m = mb + lane; const f32x4 p0 = *(const LAS f32x4*)(lg + lane * 8), p1 = *(const LAS f32x4*)(lg + lane * 8 + 4);
            const float p[8] = {p0[0], p0[1], p0[2], p0[3], p1[0], p1[1], p1[2], p1[3]};
            int i0 = 0; float v0 = p[0];
#pragma unroll
            for (int e = 1; e < 8; ++e) if (p[e] > v0) { v0 = p[e]; i0 = e; }
            int i1 = -1; float v1 = -3.0e38f;
#pragma unroll
            for (int e = 0; e < 8; ++e) if (e != i0 && p[e] > v1) { v1 = p[e]; i1 = e; }
            const float g0 = 1.0f / (1.0f + __expf(v1 - v0)), g1 = 1.0f - g0;
            sel[m] = i0; sel[T + m] = i1; gate[m] = g0; gate[T + m] = g1;
            __hip_atomic_fetch_add(&hist[i0], 1, __ATOMIC_RELAXED, __HIP_MEMORY_SCOPE_WORKGROUP); __hip_atomic_fetch_add(&hist[i1], 1, __ATOMIC_RELAXED, __HIP_MEMORY_SCOPE_WORKGROUP); }
        __syncthreads();
        { int t3 = tid; OPAQUE(t3); if (t3 < 8) chunkcnt[chunk * 8 + t3] = hist[t3]; }
    }
}
__device__ __forceinline__ void phase_lists(ArgsP a, LAS unsigned char* lds, int vcu, int G, int tid) {
    unsigned char* ws = a->ws;
    const int* chunkcnt = (const int*)(ws + WS_CHUNKCNT);
    const f32x4* rowss = (const f32x4*)(ws + WS_ROWSS) + 5 * T;
    const int* sel = (const int*)(ws + WS_ROUTE); const float* gate = (const float*)(ws + WS_ROUTE + 2 * T * 4);
    int* perm = (int*)(ws + WS_ROUTE + 4 * T * 4); float* rsp = (float*)(ws + WS_ROUTE + 4 * T * 4 + (size_t)PERMROWS * 4); float* gp = (float*)(ws + WS_ROUTE + 4 * T * 4 + 2 * (size_t)PERMROWS * 4);
    LAS int* lc = (LAS int*)lds;
    LAS int* tot = (LAS int*)(lds + 64);
    LAS int* lb = (LAS int*)(lds + 128);
    const int lane = tid & 63, wv = __builtin_amdgcn_readfirstlane(tid >> 6);
    for (int chunk = vcu; chunk < T / 128; chunk += G) {
        __syncthreads();
        if (tid < 8) lc[tid] = 0;
        { float sa = 0.f, sb = 0.f;
#pragma unroll
            for (int i = 0; i < 4; ++i) { const int c = 4 * lane + i; const float v = (float)chunkcnt[c * 8 + wv]; sa += v; sb += (c < chunk) ? v : 0.f; }
            sa = wave_sum(sa); sb = wave_sum(sb);
            if (lane == 0) { tot[wv] = (int)sa; lb[wv] = (int)sb; } }
        __syncthreads();
        if (chunk == 0 && tid < 8) ((int*)(ws + OFF_MOECNT))[tid] = tot[tid];
        if (tid < 256) { const int sl = tid >> 7, tok = chunk * 128 + (tid & 127); const int e = sel[sl * T + tok];
            const int rnk = __hip_atomic_fetch_add(&lc[e], 1, __ATOMIC_RELAXED, __HIP_MEMORY_SCOPE_WORKGROUP);
            int off = 0;
#pragma unroll
            for (int j = 0; j < 8; ++j) { const int tl = (tot[j] + 255) >> 8; if (j < e) off += tl * 256; }
            const int pos = off + lb[e] + rnk;
            perm[pos] = tok + 65536 * sl; rsp[pos] = rstd4(rowss[tok]); gp[pos] = gate[sl * T + tok]; }
        if (chunk < 8) { const int e = chunk; int off = 0, ce = 0;
#pragma unroll
            for (int j = 0; j < 8; ++j) { const int cj = tot[j]; const int tl = (cj + 255) >> 8; if (j < e) off += tl * 256; if (j == e) ce = cj; }
            const int end = off + ((ce + 255) >> 8) * 256;
            for (int pos = off + ce + tid; pos < end; pos += NTHREADS) { perm[pos] = -1; rsp[pos] = 0.f; gp[pos] = 0.f; } }
    }
}

__device__ __forceinline__ void phase_final(ArgsP a, int vcu, int G, int lane, int wave) {
    const float* g = a->in[30]; const bf16* Y1 = (const bf16*)(a->ws + WS_Y1);
    const int gw = vcu * NWAVES + wave, NGW = G * NWAVES;
    f32x4 gv[4];
#pragma unroll
    for (int j = 0; j < 4; ++j) gv[j] = ((const f32x4*)g)[lane + 64 * j];
    for (int m0 = gw; m0 < T; m0 += 4 * NGW) {
        u32x2 xx[4][4], yy[4][4];
#pragma unroll
        for (int q4 = 0; q4 < 4; ++q4) { const int m = m0 + q4 * NGW; const u32x2* yr = (const u32x2*)(Y1 + (size_t)m * D) + lane; const u32x2* xbr = (const u32x2*)((const bf16*)(a->ws + WS_XB) + (size_t)m * D) + lane;
#pragma unroll
            for (int j = 0; j < 4; ++j) { xx[q4][j] = xbr[64 * j]; yy[q4][j] = yr[64 * j]; } }
#pragma unroll
        for (int q4 = 0; q4 < 4; ++q4) { const int m = m0 + q4 * NGW; f32x4* xr = (f32x4*)(a->out + (size_t)m * D) + lane; f32x4 v[4]; float ss = 0.f;
#pragma unroll
            for (int j = 0; j < 4; ++j) { v[j] = (f32x4){bf_lo(xx[q4][j].x) + bf_lo(yy[q4][j].x), bf_hi(xx[q4][j].x) + bf_hi(yy[q4][j].x), bf_lo(xx[q4][j].y) + bf_lo(yy[q4][j].y), bf_hi(xx[q4][j].y) + bf_hi(yy[q4][j].y)};
                ss += (v[j][0] * v[j][0] + v[j][1] * v[j][1]) + (v[j][2] * v[j][2] + v[j][3] * v[j][3]); }
            const float rstd = __builtin_amdgcn_rsqf(wave_sum(ss) * (1.0f / 1024.0f) + EPS);
#pragma unroll
            for (int j = 0; j < 4; ++j) xr[64 * j] = v[j] * rstd * gv[j]; }
    }
}

__global__ void __launch_bounds__(NTHREADS, 2) fwd_kernel(Args args_byval) {
    extern __shared__ __attribute__((aligned(16))) unsigned char lds_raw[];
    LAS unsigned char* lds = (LAS unsigned char*)lds_raw;
    const int wave = __builtin_amdgcn_readfirstlane((int)threadIdx.x >> 6);
    const int G = gridDim.x; const int bx = blockIdx.x; const int vcu = (G % 8 == 0) ? (bx % 8) * (G / 8) + bx / 8 : bx;
#define ARGS() ArgsP args = (ArgsP)__builtin_amdgcn_kernarg_segment_ptr(); asm volatile("" : "+s"(args)); unsigned char* ws = args->ws; f32x4* rowss = (f32x4*)(ws + WS_ROWSS); bf16* XB = (bf16*)(ws + WS_XB); (void)rowss; (void)XB
#define TID() (wave * 64 + lane_id())
    volatile LAS unsigned* MISC = (volatile LAS unsigned*)(lds + MISC_OFF);
    if (threadIdx.x < 64) MISC[threadIdx.x] = 0u;
    __syncthreads();
    int lo, hi; XcdBarrier bar;
    { ARGS(); lo = args->ph_lo; hi = args->ph_hi; bar.bar = (unsigned*)ws + CW_BAR; bar.x = 0; bar.st = nullptr;
      if (hi - lo > 1) bar = xcd_barrier_post((unsigned*)ws + CW_BAR, MISC + 8); }
    unsigned long long pr_acc = 0ull, pr_t0 = 0ull;
#define IN(k) (((PROBE_MASK >> (k)) & 1u) ? (pr_t0 = __builtin_amdgcn_s_memrealtime(), lo <= (k) && (k) < hi) : (lo <= (k) && (k) < hi))
#define SEAM(k) do { if (lo <= (k) && (k) + 1 < hi) xcd_barrier(bar); if ((PROBE_MASK >> (k)) & 1u) pr_acc += __builtin_amdgcn_s_memrealtime() - pr_t0; } while (0)
    constexpr float QSCALE = 0.0625f * 1.4426950408889634f;

    if (EN_PRO && IN(0)) { ARGS(); for (int rep = 0; rep < REP_PRO; ++rep) { int t2 = TID(); OPAQUE(t2); phase_prologue(args, lds, vcu, G, t2, t2 & 63, wave); __syncthreads(); } }
    SEAM(0);
#pragma unroll 1
    for (int l = 0; l < 2; ++l) {
        const int pb = 1 + 8 * l;
        if (EN_GEMM && EN_G1 && IN(pb)) { ARGS();
            if (EN_KV && l == 0 && bx >= 128) {
                if (bx < 192) { pg8::Gemm g{(const bf16*)(ws + WS_MEMB), (const bf16*)(ws + WS_WK), nullptr, MROWS, 2048, D}; pg8::StaticOrder S; S.init(MROWS, 2048, 64, bx - 128);
                    pg8::EpiRowScale<false> E{(bf16*)(ws + WS_KB), 2048, (const void*)(ws + OFF_MEMSS), 1.0f};
                    pg8::gemm_phase<pg8::EpiRowScale<false>, pg8::StaticOrder, true, false>(lds, g, S, E, wave); }
                else { pg8::Gemm g{(const bf16*)(ws + WS_WV), (const bf16*)(ws + WS_MEMB), nullptr, 2048, MROWS, D}; pg8::StaticOrder S; S.init(2048, MROWS, 64, bx - 192);
                    pg8::EpiColScale E{(bf16*)(ws + WS_VT), 2048, (const u64*)(ws + OFF_MEMSS)};
                    pg8::gemm_phase<pg8::EpiColScale, pg8::StaticOrder, true, false>(lds, g, S, E, wave); }
            }
            pg8::Gemm g{XB, (const bf16*)(ws + WS_WIN) + (size_t)l * DIN * D, nullptr, T, DIN, D, (const float*)(rowss + (size_t)(3 * l) * T)}; pg8::StaticOrder S; S.init(T, DIN, G, bx);
            pg8::EpiRowScale<false, true> E{(bf16*)(ws + WS_Z), DIN, nullptr, 1.0f};
            pg8::gemm_phase<pg8::EpiRowScale<false, true>, pg8::StaticOrder, true, false, false, 2>(lds, g, S, E, wave);
        }
        SEAM(pb);
        if (EN_MIX && IN(pb + 1)) { ARGS(); for (int rep = 0; rep < REP_MIX; ++rep) { int t2 = TID(); asm volatile("" : "+v"(t2)); for (int u = vcu; u < 256; u += G) mixer_unit(args, lds, l, u, t2, t2 & 63, wave); } }
        SEAM(pb + 1);
        if (EN_GEMM && EN_G2 && IN(pb + 2)) { ARGS();
            pg8::Gemm g{(const bf16*)(ws + WS_MIXED), (const bf16*)(ws + WS_WOUT) + (size_t)l * D * D, nullptr, T, D, D}; pg8::StaticOrder S; S.init(T, D, G, bx);
            pg8::EpiResid<false, true> E{XB, nullptr, (float*)(rowss + (size_t)(3 * l + 1) * T), 1.0f, nullptr};
            pg8::gemm_phase<pg8::EpiResid<false, true>, pg8::StaticOrder, true, false>(lds, g, S, E, wave);
        }
        SEAM(pb + 2);
        if (EN_GEMM && EN_G3 && IN(pb + 3)) { ARGS();
            pg8::Gemm g{XB, (const bf16*)(ws + WS_WQ) + (size_t)l * D * D, nullptr, T, D, D, (const float*)(rowss + (size_t)(3 * l + 1) * T)}; pg8::StaticOrder S; S.init(T, D, G, bx);
            pg8::EpiRowScale<false, true> E{(bf16*)(ws + WS_Q), D, nullptr, QSCALE};
            for (int rep = 0; rep < REP_Q; ++rep) pg8::gemm_phase<pg8::EpiRowScale<false, true>, pg8::StaticOrder, true, false, false, 2>(lds, g, S, E, wave);
        }
        SEAM(pb + 3);
        if (EN_ATT && IN(pb + 4)) { ARGS(); for (int rep = 0; rep < REP_ATT; ++rep) { int t2 = TID(); asm volatile("" : "+v"(t2)); attn_phase(args, lds, l, vcu, G, t2, wave); } }
        SEAM(pb + 4);
        if (EN_GEMM && EN_G2 && IN(pb + 5)) { ARGS();
            pg8::Gemm g{(const bf16*)(ws + WS_O), (const bf16*)(ws + WS_WO) + (size_t)l * D * D, nullptr, T, D, D}; pg8::StaticOrder S; S.init(T, D, G, bx);
            pg8::EpiResid<false, true> E{XB, l == 1 ? ws + WS_XB8 : nullptr, (float*)(rowss + (size_t)(3 * l + 2) * T), 1.0f, nullptr};
            pg8::gemm_phase<pg8::EpiResid<false, true>, pg8::StaticOrder, true, false>(lds, g, S, E, wave);
        }
        SEAM(pb + 5);
        if (l == 0) {
            if (EN_GEMM && EN_G4 && IN(7)) { ARGS();
                pg8::Gemm g{XB, (const bf16*)(ws + WS_WGU), nullptr, T, 2 * DFF, D, (const float*)(rowss + (size_t)2 * T)}; pg8::StaticOrder S; S.init(T, 2 * DFF, G, bx);
                pg8::EpiSwiglu<false, true> E{(bf16*)(ws + WS_H), DFF, nullptr};
                for (int rep = 0; rep < REP_UP; ++rep) pg8::gemm_phase<pg8::EpiSwiglu<false, true>, pg8::StaticOrder, true, false, false, 2>(lds, g, S, E, wave);
            }
            SEAM(7);
            if (EN_GEMM && EN_G2 && IN(8)) { ARGS();
                pg8::Gemm g{(const bf16*)(ws + WS_H), (const bf16*)(ws + WS_WD), nullptr, T, D, DFF}; pg8::StaticOrder S; S.init(T, D, G, bx);
                pg8::EpiResid<false, true> E{XB, nullptr, (float*)(rowss + (size_t)3 * T), 1.0f, nullptr};
                pg8::gemm_phase<pg8::EpiResid<false, true>, pg8::StaticOrder, true, false>(lds, g, S, E, wave);
            }
            SEAM(8);
        } else {
            if (EN_ROUTE && IN(15)) { ARGS(); int t2 = TID(); OPAQUE(t2); phase_router(args, lds, vcu, G, t2, t2 & 63, wave); }
            SEAM(15);
            if (EN_ROUTE && IN(16)) { ARGS(); int t2 = TID(); OPAQUE(t2); phase_lists(args, lds, vcu, G, t2); }
            SEAM(16);
            if (EN_MOE && EN_MUP && IN(17)) { ARGS();
                const int* perm = (const int*)(ws + WS_ROUTE + 4 * T * 4); const float* rsp = (const float*)(ws + WS_ROUTE + 4 * T * 4 + (size_t)PERMROWS * 4);
                pg8::MoeOrder S; S.G = G; S.c = bx; S.tp[0] = 0; S.nN = 2 * DFF / 256;
                const int* cnt = (const int*)(ws + OFF_MOECNT);
#pragma unroll
                for (int j = 0; j < 8; ++j) S.tp[j + 1] = S.tp[j] + ((__builtin_amdgcn_readfirstlane(cnt[j]) + 255) >> 8);
                pg8::Gemm g{(const bf16*)(ws + WS_XB8), (const bf16*)(ws + WS_MWGU), perm, T, 2 * DFF, D / 2, rsp};
                pg8::EpiSwiglu8 E{ws + WS_H, DFF, rsp};
                pg8::gemm_phase<pg8::EpiSwiglu8, pg8::MoeOrder, true, true, true, 1>(lds, g, S, E, wave);
            }
            SEAM(17);
            if (EN_MOE && EN_MDN && IN(18)) { ARGS();
                const int* perm = (const int*)(ws + WS_ROUTE + 4 * T * 4); const float* gp = (const float*)(ws + WS_ROUTE + 4 * T * 4 + 2 * (size_t)PERMROWS * 4);
                pg8::MoeOrder S; S.G = G; S.c = bx; S.tp[0] = 0; S.nN = D / 256;
                const int* cnt = (const int*)(ws + OFF_MOECNT);
#pragma unroll
                for (int j = 0; j < 8; ++j) S.tp[j + 1] = S.tp[j] + ((__builtin_amdgcn_readfirstlane(cnt[j]) + 255) >> 8);
                pg8::Gemm g{(const bf16*)(ws + WS_H), (const bf16*)(ws + WS_MWD), perm, T, D, DFF / 2, gp};
                pg8::EpiResid<true, false> E{XB, nullptr, nullptr, 1.0f / S8_DN, (bf16*)(ws + WS_Y1)};
                pg8::gemm_phase<pg8::EpiResid<true, false>, pg8::MoeOrder, true, false, true, 1>(lds, g, S, E, wave);
            }
            SEAM(18);
            if (IN(19)) { ARGS(); int t2 = TID(); OPAQUE(t2); phase_final(args, vcu, G, t2 & 63, wave); }
            SEAM(19);
            if (PROBE_K && IN(19)) { ARGS();
                pg8::Gemm g{XB, (const bf16*)(ws + WS_WGU), nullptr, T, 2048, PROBE_K}; pg8::StaticOrder S; S.init(T, 2048, G, bx);
                pg8::EpiRowScale<false> E{(bf16*)(ws + WS_ACT), 2048, rowss, 1.0f};
                pg8::gemm_phase<pg8::EpiRowScale<false>, pg8::StaticOrder, true, false>(lds, g, S, E, wave); }
        }
    }
    if (PROBE_MLO >= 0 && bx == PROBE_MWG) { const unsigned long long t0 = __builtin_amdgcn_s_memrealtime(), dl = MISC[40]; while (__builtin_amdgcn_s_memrealtime() - t0 < dl) __builtin_amdgcn_s_sleep(8); }
    if (PROBE_MASK && bx == 0) { const unsigned long long t0 = __builtin_amdgcn_s_memrealtime(); while (__builtin_amdgcn_s_memrealtime() - t0 < pr_acc) __builtin_amdgcn_s_sleep(8); }
#undef IN
#undef SEAM
}

extern "C" void kernel_launch(void* const* d_in, const int* in_sizes, int n_in, void* d_out, int out_size, void* d_ws, size_t ws_size, hipStream_t stream) {
    static int grid = 0;
    if (grid == 0) {
        if (n_in != 31 || in_sizes[0] != T * D || out_size != T * D || ws_size < WS_END) { fprintf(stderr, "kernel_launch: unexpected shapes (n_in %d, in0 %d, out %d, ws %zu)\n", n_in, n_in > 0 ? in_sizes[0] : -1, out_size, ws_size); grid = -1; return; }
        int dev = 0, cus = 0;
        if (hipGetDevice(&dev) != hipSuccess || hipDeviceGetAttribute(&cus, hipDeviceAttributeMultiprocessorCount, dev) != hipSuccess) { grid = -1; return; }
        if (hipFuncSetAttribute((const void*)fwd_kernel, hipFuncAttributeMaxDynamicSharedMemorySize, LDS_BYTES) != hipSuccess) { fprintf(stderr, "kernel_launch: hipFuncSetAttribute failed\n"); grid = -1; return; }
        int per_cu = 0;
        if (hipOccupancyMaxActiveBlocksPerMultiprocessor(&per_cu, (const void*)fwd_kernel, NTHREADS, LDS_BYTES) != hipSuccess || per_cu < 1) fprintf(stderr, "kernel_launch: occupancy query reports %d\n", per_cu);
        (void)hipGetLastError();
        if (cus < 256) { fprintf(stderr, "kernel_launch: built for a 256-CU device (found %d CUs)\n", cus); grid = -1; return; }
        grid = 256;
    }
    if (grid < 0) return;
    (void)hipMemsetAsync(d_ws, 0, CTL_ZERO_BYTES, stream);
    Args a{};
    for (int i = 0; i < 31; ++i) a.in[i] = (const float*)d_in[i];
    a.out = (float*)d_out; a.ws = (unsigned char*)d_ws;
#if MK_PER_PHASE
    for (int ph = 0; ph < NPH; ++ph) { a.ph_lo = ph; a.ph_hi = ph + 1; hipLaunchKernelGGL(fwd_kernel, dim3(grid), dim3(NTHREADS), LDS_BYTES, stream, a); }
#else
    a.ph_lo = 0; a.ph_hi = NPH; hipLaunchKernelGGL(fwd_kernel, dim3(grid), dim3(NTHREADS), LDS_BYTES, stream, a);
#endif
}
```

```cpp
#include <hip/hip_runtime.h>
#include <cstdio>
#include <cstdint>

#ifndef MK_PER_PHASE
#define MK_PER_PHASE 0
#endif

#ifndef EN_PRO
#define EN_PRO 1
#endif
#ifndef EN_GEMM
#define EN_GEMM 1
#endif
#ifndef EN_G1
#define EN_G1 1
#endif
#ifndef EN_G2
#define EN_G2 1
#endif
#ifndef EN_G3
#define EN_G3 1
#endif
#ifndef EN_G4
#define EN_G4 1
#endif
#ifndef EN_KV
#define EN_KV 1
#endif
#ifndef REP_PRO
#define REP_PRO 1
#endif
#ifndef REP_MIX
#define REP_MIX 1
#endif
#ifndef REP_ATT
#define REP_ATT 1
#endif
#ifndef REP_Q
#define REP_Q 1
#endif
#ifndef REP_UP
#define REP_UP 1
#endif
#ifndef EN_MUP
#define EN_MUP 1
#endif
#ifndef EN_MDN
#define EN_MDN 1
#endif
#ifndef PROBE_MASK
#define ATT_QPRE 1
#define PROBE_MLO -1
#define PROBE_MHI -1
#define PROBE_MWG 100
#define MSEC(k) do { if (PROBE_MLO >= 0 && blockIdx.x == PROBE_MWG && threadIdx.x == 0) { volatile LAS unsigned* _m = (volatile LAS unsigned*)(lds + MISC_OFF) + 40; const unsigned _t = (unsigned)__builtin_amdgcn_s_memrealtime(); if ((k) == PROBE_MLO) *_m -= _t; if ((k) == PROBE_MHI) *_m += _t; } } while (0)
#define PROBE_MASK 0u
#endif
#ifndef PROBE_K
#define PROBE_K 0
#endif
#ifndef STAG_TICKS
#define STAG_TICKS 0
#endif
#ifndef EN_MIX
#define EN_MIX 1
#endif
#ifndef EN_ATT
#define EN_ATT 1
#endif
#ifndef EN_MOE
#define EN_MOE 1
#endif
#ifndef EN_ROUTE
#define EN_ROUTE 1
#endif
#define LAS __attribute__((address_space(3)))
#define GAS __attribute__((address_space(1)))
typedef unsigned short bf16;
typedef short bf16x8 __attribute__((ext_vector_type(8)));
typedef float f32x2 __attribute__((ext_vector_type(2)));
typedef float f32x4 __attribute__((ext_vector_type(4)));
typedef float f32x16 __attribute__((ext_vector_type(16)));
typedef unsigned u32x2 __attribute__((ext_vector_type(2)));
typedef unsigned u32x4 __attribute__((ext_vector_type(4)));
typedef __bf16 bf16x2_t __attribute__((ext_vector_type(2)));
typedef int i32x4 __attribute__((ext_vector_type(4)));
typedef int i32x8 __attribute__((ext_vector_type(8)));
typedef unsigned long long u64;
typedef unsigned long long u64x2 __attribute__((ext_vector_type(2)));

constexpr int NB = 8, SEQ = 4096, D = 1024, T = NB * SEQ, DIN = 1792, DFF = 2816, NE = 8, MEMLEN = 256, MROWS = NB * MEMLEN;
constexpr float EPS = 1e-6f;
constexpr float S8_UP = 32.0f, S8_DN = 64.0f;
constexpr int NWAVES = 8, NTHREADS = 512;
constexpr int NPH = 20;

constexpr size_t MiB = 1u << 20;
constexpr size_t CTL_ZERO_BYTES = 64 * 1024;
constexpr int CW_BAR = 4096;
constexpr size_t WS_ROWSS = 124 * MiB;
constexpr size_t OFF_MOECNT = 32 * 1024;
constexpr size_t OFF_MEMSS = 40 * 1024;
constexpr size_t WS_WIN = 2 * MiB;
constexpr size_t WS_WOUT = 9 * MiB;
constexpr size_t WS_WQ = 13 * MiB;
constexpr size_t WS_WO = 17 * MiB;
constexpr size_t WS_WK = 21 * MiB;
constexpr size_t WS_WV = 25 * MiB;
constexpr size_t WS_WGU = 29 * MiB;
constexpr size_t WS_WD = 40 * MiB;
constexpr size_t WS_MWGU = 46 * MiB;
constexpr size_t WS_MWD = 134 * MiB;
constexpr size_t WS_SGUW = 178 * MiB;
constexpr size_t WS_POOLW = 178 * MiB + 512 * 1024;
constexpr size_t WS_XB = 180 * MiB;
constexpr size_t WS_MEMB = 244 * MiB;
constexpr size_t WS_KB = 248 * MiB;
constexpr size_t WS_VT = 256 * MiB;
constexpr size_t WS_ROUTE = 264 * MiB;
constexpr int PERMROWS = 264 * 256;
constexpr size_t WS_Y1 = 448 * MiB;
constexpr size_t WS_XB8 = 90 * MiB;
constexpr size_t WS_ACT = 266 * MiB;
constexpr size_t WS_Z = WS_ACT;
constexpr size_t WS_MIXED = WS_ACT + 112 * MiB;
constexpr size_t WS_Q = WS_ACT;
constexpr size_t WS_O = WS_ACT + 64 * MiB;
constexpr size_t WS_H = WS_ACT;
constexpr size_t WS_END = 512 * MiB;
static_assert(WS_H + (size_t)PERMROWS * DFF <= WS_Y1 && WS_Y1 + (size_t)T * D * 2 <= WS_END && WS_MWGU + (size_t)NE * 2 * DFF * D <= WS_XB8 && WS_XB8 + (size_t)T * D <= WS_ROWSS && WS_ROWSS + 7 * (size_t)T * 16 <= WS_MWD && WS_ROUTE + 4 * (size_t)T * 4 + 3 * (size_t)PERMROWS * 4 + 8192 <= WS_ACT, "ws map");

constexpr int LDS_BYTES = 160 * 1024;
constexpr int MISC_OFF = LDS_BYTES - 256;

__device__ __forceinline__ float bf_lo(unsigned v) { return __uint_as_float(v << 16); }
__device__ __forceinline__ float bf_hi(unsigned v) { return __uint_as_float(v & 0xffff0000u); }
__device__ __forceinline__ unsigned pk_bf16(float lo, float hi) { f32x2 v = {lo, hi}; bf16x2_t b = __builtin_convertvector(v, bf16x2_t); return __builtin_bit_cast(unsigned, b); }
__device__ __forceinline__ unsigned pk_bf16_v(float lo, float hi) { unsigned r; asm volatile("v_cvt_pk_bf16_f32 %0, %1, %2" : "=v"(r) : "v"(lo), "v"(hi)); return r; }
__device__ __forceinline__ bf16 f2bf(float f) { return (bf16)(pk_bf16(f, 0.f) & 0xffffu); }
__device__ __forceinline__ float sigm(float x) { return __builtin_amdgcn_rcpf(1.0f + __expf(-x)); }
__device__ __forceinline__ float silu_f(float x) { return x * sigm(x); }
__device__ __forceinline__ float gelu_tanh(float x) { const float t = x * __builtin_fmaf(x * x, -0.10294324f, -2.3022082f); return x * __builtin_amdgcn_rcpf(1.0f + __builtin_amdgcn_exp2f(t)); }
constexpr float SS_FIX = 16777216.0f;
__device__ __forceinline__ u64 ss_to_fix(float ss) { return (u64)(ss * SS_FIX); }
__device__ __forceinline__ float rstd_ss(u64 ssf) { return __builtin_amdgcn_rsqf((float)ssf * (1.0f / (1024.0f * SS_FIX)) + EPS); }
__device__ __forceinline__ float rstd4(f32x4 p) { return __builtin_amdgcn_rsqf(((p[0] + p[1]) + (p[2] + p[3])) * (1.0f / 1024.0f) + EPS); }
__device__ __forceinline__ unsigned pk_fp8x4(float a, float b, float c, float d) { int p = __builtin_amdgcn_cvt_pk_fp8_f32(a, b, 0, false); p = __builtin_amdgcn_cvt_pk_fp8_f32(c, d, p, true); return (unsigned)p; }
__device__ __forceinline__ int lane_id() { int l; asm volatile("v_mbcnt_lo_u32_b32 %0, -1, 0\n\tv_mbcnt_hi_u32_b32 %0, -1, %0" : "=v"(l)); return l; }
__device__ __forceinline__ float shfl_xor_f(float v, int mask) { const int idx = (lane_id() ^ mask) << 2; return __builtin_bit_cast(float, __builtin_amdgcn_ds_bpermute(idx, __builtin_bit_cast(int, v))); }
#define OPAQUE(x) asm volatile("" : "+v"(x))
template <int CTRL> __device__ __forceinline__ float dpp_f(float v) { return __builtin_bit_cast(float, __builtin_amdgcn_update_dpp(0, __builtin_bit_cast(int, v), CTRL, 0xf, 0xf, true)); }
__device__ __forceinline__ float row16_sum(float v) { v += dpp_f<0xB1>(v); v += dpp_f<0x4E>(v); v += dpp_f<0x141>(v); v += dpp_f<0x140>(v); return v; }
__device__ __forceinline__ float wave_sum(float v) { v = row16_sum(v); v += shfl_xor_f(v, 16); v += shfl_xor_f(v, 32); return v; }

namespace pg8 {
__device__ __forceinline__ void glds_s(const void* sbase, unsigned voff, unsigned lds_dst) {
    asm volatile("s_mov_b32 m0, %2\n\ts_nop 0\n\tglobal_load_lds_dwordx4 %0, %1" : : "v"(voff), "s"(sbase), "s"(lds_dst) : "memory", "m0");
}
constexpr int BM = 256, BK = 64, HALF = 128, HTB = HALF * BK * 2, STAGE_BYTES = 8 * HTB, NXCD = 8, WGM = 8;
__host__ __device__ __forceinline__ int lds_byte(int r, int c) { const int st = (r >> 4) * 2 + (c >> 5), rr = r & 15, cc = c & 31, ob = rr * 64 + cc * 2; return st * 1024 + (ob ^ (((ob >> 9) & 1) << 5)); }
__host__ __device__ __forceinline__ void stage_rc(int b, int& R, int& C) { const int st = b / 1024, sb = b % 1024, swz = sb ^ (((sb >> 9) & 1) << 5); R = (st >> 1) * 16 + swz / 64; C = (st & 1) * 32 + (swz % 64) / 2; }
__host__ __device__ __forceinline__ int perm32(int rho) { const int n = rho >> 4, i = rho & 15; return 8 * (i >> 2) + 4 * n + (i & 3); }

struct Unit { int pm, pn, brow; };
struct Gemm { const bf16* A; const bf16* Bt; const int* perm; int M, N, K; const float* aux = nullptr; };

struct StaticOrder {
    int nM, nN, nwg, G, c;
    __device__ void init(int M, int N, int G_, int c_) { nM = M / BM; nN = N / BM; nwg = nM * nN; G = G_; c = c_; }
    __device__ bool next(int i, Unit& u) const {
        const long L = (long)i * G + c; if (L >= nwg) return false;
        int wgid = (int)L; { const int q = nwg / NXCD, r = nwg % NXCD, xcd = wgid % NXCD, off = wgid / NXCD; wgid = (xcd < r ? xcd * (q + 1) : r * (q + 1) + (xcd - r) * q) + off; }
        const int nig = WGM * nN, gid = wgid / nig, fm = gid * WGM, gsz = (nM - fm) < WGM ? (nM - fm) : WGM;
        u.pm = fm + ((wgid % nig) % gsz); u.pn = (wgid % nig) / gsz; u.brow = u.pn; return true;
    }
};
struct MoeOrder {
    int nN, G, c; int tp[9];
    __device__ bool next(int i, Unit& u) const {
        const int L = i * G + c; if (L >= tp[8] * nN) return false;
        int e = 0;
#pragma unroll
        for (int j = 1; j < 8; ++j) e += (L >= tp[j] * nN) ? 1 : 0;
        int base = 0, nx = 0;
#pragma unroll
        for (int j = 0; j < 8; ++j) if (e == j) { base = tp[j]; nx = tp[j + 1]; }
        const int te = nx - base, Lp = L - base * nN; u.pn = Lp / te; u.pm = base + Lp % te; u.brow = e * nN + u.pn; return true;
    }
};

typedef f32x4 Acc[2][2][4][2];

constexpr int EPI_R0 = 3 * HTB, EPI_R1 = STAGE_BYTES;
constexpr int SLOT_OFF = STAGE_BYTES + 16384, SLOT_BYTES = 4096;
__device__ __forceinline__ void glds4_s(const void* sbase, unsigned voff, unsigned lds_dst) {
    asm volatile("s_mov_b32 m0, %2\n\ts_nop 0\n\tglobal_load_lds_dword %0, %1" : : "v"(voff), "s"(sbase), "s"(lds_dst) : "memory", "m0");
}
#define EPI_BAR() do { asm volatile("s_waitcnt lgkmcnt(0)" ::: "memory"); __builtin_amdgcn_s_barrier(); asm volatile("" ::: "memory"); } while (0)

template <bool DIRECT, bool SLOT = false> struct EpiRowScale {
    static constexpr bool PERM = true;
    bf16* O; int ldc; const void* rs; float cst;
    __device__ __forceinline__ void operator()(const Acc& acc, const Unit& u, int wr, int wc, LAS unsigned char* lds, int ui) const {
        const int ln = lane_id(), fr = ln & 15, fq = ln >> 4;
        const int row0 = u.pm * BM + wr * 64 + fr;
        float sc[2][4];
        if (DIRECT) {
#pragma unroll
            for (int ai = 0; ai < 2; ++ai)
#pragma unroll
                for (int m = 0; m < 4; ++m) sc[ai][m] = ((const float*)rs)[row0 + ai * HALF + m * 16] * cst;
        } else if (SLOT) { f32x4 sv[2][4];
#pragma unroll
            for (int ai = 0; ai < 2; ++ai)
#pragma unroll
                for (int m = 0; m < 4; ++m) sv[ai][m] = ((const LAS f32x4*)(lds + SLOT_OFF + (ui & 1) * SLOT_BYTES))[wr * 64 + fr + ai * HALF + m * 16];
#pragma unroll
            for (int ai = 0; ai < 2; ++ai)
#pragma unroll
                for (int m = 0; m < 4; ++m) sc[ai][m] = rstd4(sv[ai][m]) * cst;
        } else { u64 sv[2][4];
#pragma unroll
            for (int ai = 0; ai < 2; ++ai)
#pragma unroll
                for (int m = 0; m < 4; ++m) sv[ai][m] = ((const u64*)rs)[row0 + ai * HALF + m * 16];
#pragma unroll
            for (int ai = 0; ai < 2; ++ai)
#pragma unroll
                for (int m = 0; m < 4; ++m) sc[ai][m] = rstd_ss(sv[ai][m]) * cst; }
        LAS unsigned char* reg = lds + (wr ? EPI_R1 : EPI_R0);
#pragma unroll
        for (int ai = 0; ai < 2; ++ai)
#pragma unroll
            for (int mh = 0; mh < 2; ++mh) {
#pragma unroll
                for (int mm = 0; mm < 2; ++mm) { const int m = 2 * mh + mm, lr = mm * 16 + fr; const float s1 = sc[ai][m];
#pragma unroll
                    for (int bj = 0; bj < 2; ++bj) { const f32x4 v0 = acc[ai][bj][m][0] * s1, v1 = acc[ai][bj][m][1] * s1;
                        u32x4 w; w.x = pk_bf16(v0[0], v0[1]); w.y = pk_bf16(v0[2], v0[3]); w.z = pk_bf16(v1[0], v1[1]); w.w = pk_bf16(v1[2], v1[3]);
                        *(LAS u32x4*)(reg + lr * 512 + (((bj * 16 + wc * 4 + fq) ^ (lr & 7)) * 16)) = w; } }
                EPI_BAR();
                bf16* ob = O + (size_t)(u.pm * BM + ai * HALF + wr * 64 + mh * 32) * ldc + u.pn * BM;
#pragma unroll
                for (int j = 0; j < 4; ++j) { const int lr = wc * 8 + 2 * j + (ln >> 5), c = ln & 31;
                    const u32x4 w = *(const LAS u32x4*)(reg + lr * 512 + ((c ^ (lr & 7)) * 16));
                    *(u32x4*)(ob + (size_t)lr * ldc + c * 8) = w; }
                EPI_BAR();
            }
    }
};
struct EpiColScale {
    static constexpr bool PERM = true;
    bf16* O; int ldc; const u64* css;
    __device__ __forceinline__ void operator()(const Acc& acc, const Unit& u, int wr, int wc, LAS unsigned char* lds, int ui) const {
        const int ln = lane_id(), fr = ln & 15, fq = ln >> 4;
        const int row0 = u.pm * BM + wr * 64 + fr, col0 = u.pn * BM + wc * 32 + 8 * fq;
#pragma unroll
        for (int bj = 0; bj < 2; ++bj) {
            const u64* cp = css + col0 + bj * HALF;
            const f32x4 c0 = (f32x4){rstd_ss(cp[0]), rstd_ss(cp[1]), rstd_ss(cp[2]), rstd_ss(cp[3])}, c1 = (f32x4){rstd_ss(cp[4]), rstd_ss(cp[5]), rstd_ss(cp[6]), rstd_ss(cp[7])};
#pragma unroll
            for (int ai = 0; ai < 2; ++ai)
#pragma unroll
                for (int m = 0; m < 4; ++m) { bf16* rowp = O + (size_t)(row0 + ai * HALF + m * 16) * ldc + ((col0 + bj * HALF) & ~15) + 4 * (fq & 1);
                    const f32x4 v0 = acc[ai][bj][m][0] * c0, v1 = acc[ai][bj][m][1] * c1;
                    u32x2 wa, wb; wa.x = pk_bf16(v0[0], v0[1]); wa.y = pk_bf16(v0[2], v0[3]); wb.x = pk_bf16(v1[0], v1[1]); wb.y = pk_bf16(v1[2], v1[3]);
                    *(u32x2*)rowp = wa; *(u32x2*)(rowp + 8) = wb; }
            asm volatile("" ::: "memory"); }
    }
};
template <bool DIRECT, bool SLOT = false> struct EpiSwiglu {
    static constexpr bool PERM = true;
    bf16* O; int ldc; const void* rs;
    __device__ __forceinline__ void operator()(const Acc& acc, const Unit& u, int wr, int wc, LAS unsigned char* lds, int ui) const {
        const int ln = lane_id(), fr = ln & 15, fq = ln >> 4;
        const int row0 = u.pm * BM + wr * 64 + fr;
        float sc[2][4];
        if (DIRECT) {
#pragma unroll
            for (int ai = 0; ai < 2; ++ai)
#pragma unroll
                for (int m = 0; m < 4; ++m) sc[ai][m] = ((const float*)rs)[row0 + ai * HALF + m * 16];
        } else { f32x4 sv[2][4];
#pragma unroll
            for (int ai = 0; ai < 2; ++ai)
#pragma unroll
                for (int m = 0; m < 4; ++m) sv[ai][m] = SLOT ? ((const LAS f32x4*)(lds + SLOT_OFF + (ui & 1) * SLOT_BYTES))[wr * 64 + fr + ai * HALF + m * 16] : ((const f32x4*)rs)[row0 + ai * HALF + m * 16];
#pragma unroll
            for (int ai = 0; ai < 2; ++ai)
#pragma unroll
                for (int m = 0; m < 4; ++m) sc[ai][m] = rstd4(sv[ai][m]); }
        LAS unsigned char* reg = lds + (wr ? EPI_R1 : EPI_R0);
#pragma unroll
        for (int ai = 0; ai < 2; ++ai) {
#pragma unroll
            for (int m = 0; m < 4; ++m) { const int lr = m * 16 + fr; const float s1 = sc[ai][m], s2 = s1 * s1, sneg = s1 * -1.4426950408889634f;
                u32x4 w;
#pragma unroll
                for (int n = 0; n < 2; ++n) { const f32x4 a = acc[ai][0][m][n], b = acc[ai][1][m][n];
                    const f32x4 p = (a * b) * s2, t = a * sneg;
                    const f32x4 o = (f32x4){p[0] * __builtin_amdgcn_rcpf(1.0f + __builtin_amdgcn_exp2f(t[0])), p[1] * __builtin_amdgcn_rcpf(1.0f + __builtin_amdgcn_exp2f(t[1])),
                                            p[2] * __builtin_amdgcn_rcpf(1.0f + __builtin_amdgcn_exp2f(t[2])), p[3] * __builtin_amdgcn_rcpf(1.0f + __builtin_amdgcn_exp2f(t[3]))};
                    w[2 * n] = pk_bf16(o[0], o[1]); w[2 * n + 1] = pk_bf16(o[2], o[3]); }
                *(LAS u32x4*)(reg + lr * 256 + (((wc * 4 + fq) ^ (lr & 7)) * 16)) = w; }
            EPI_BAR();
            bf16* ob = O + (size_t)(u.pm * BM + ai * HALF + wr * 64) * ldc + u.pn * HALF;
#pragma unroll
            for (int j = 0; j < 4; ++j) { const int lr = wc * 16 + 4 * j + (ln >> 4), c = ln & 15;
                const u32x4 w = *(const LAS u32x4*)(reg + lr * 256 + ((c ^ (lr & 7)) * 16));
                *(u32x4*)(ob + (size_t)lr * ldc + c * 8) = w; }
            EPI_BAR();
        }
    }
};
struct EpiSwiglu8 {
    static constexpr bool PERM = true;
    unsigned char* O; int ldc; const float* rs;
    __device__ __forceinline__ void operator()(const Acc& acc, const Unit& u, int wr, int wc, LAS unsigned char* lds, int ui) const {
        const int ln = lane_id(), fr = ln & 15, fq = ln >> 4;
        const int row0 = u.pm * BM + wr * 64 + fr;
        float sc[2][4];
#pragma unroll
        for (int ai = 0; ai < 2; ++ai)
#pragma unroll
            for (int m = 0; m < 4; ++m) sc[ai][m] = ((const LAS float*)(lds + SLOT_OFF + (ui & 1) * SLOT_BYTES + 1024))[wr * 64 + fr + ai * HALF + m * 16] * (1.0f / S8_UP);
        (void)row0;
        LAS unsigned char* reg = lds + (wr ? EPI_R1 : EPI_R0);
#pragma unroll
        for (int ai = 0; ai < 2; ++ai) {
#pragma unroll
            for (int m = 0; m < 4; ++m) { const int lr = ai * 64 + m * 16 + fr; const float s1 = sc[ai][m], s2 = s1 * s1, sneg = s1 * -1.4426950408889634f;
                u32x2 w;
#pragma unroll
                for (int n = 0; n < 2; ++n) { const f32x4 a = acc[ai][0][m][n], b = acc[ai][1][m][n];
                    const f32x4 p = (a * b) * s2, t = a * sneg;
                    w[n] = pk_fp8x4(p[0] * __builtin_amdgcn_rcpf(1.0f + __builtin_amdgcn_exp2f(t[0])), p[1] * __builtin_amdgcn_rcpf(1.0f + __builtin_amdgcn_exp2f(t[1])),
                                    p[2] * __builtin_amdgcn_rcpf(1.0f + __builtin_amdgcn_exp2f(t[2])), p[3] * __builtin_amdgcn_rcpf(1.0f + __builtin_amdgcn_exp2f(t[3]))); }
                const int c8 = wc * 4 + fq;
                *(LAS u32x2*)(reg + lr * 128 + ((((c8 >> 1) ^ (lr & 7)) * 16) + (c8 & 1) * 8)) = w; } }
        EPI_BAR();
#pragma unroll
        for (int j = 0; j < 4; ++j) { const int lr = wc * 32 + 8 * j + (ln >> 3), c = ln & 7;
            const u32x4 w = *(const LAS u32x4*)(reg + lr * 128 + ((c ^ (lr & 7)) * 16));
            unsigned char* ob = O + (size_t)(u.pm * BM + (lr >> 6) * HALF + wr * 64 + (lr & 63)) * ldc + u.pn * HALF;
            *(u32x4*)(ob + c * 16) = w; }
        EPI_BAR();
    }
};
template <bool SCATTER, bool ACC_SS> struct EpiResid {
    static constexpr bool PERM = true;
    bf16* X; unsigned char* X8; float* ss_out; float gscale; bf16* Y1;
    __device__ __forceinline__ void operator()(const Acc& acc, const Unit& u, int wr, int wc, LAS unsigned char* lds, int ui) const {
        static_assert(!(ACC_SS && SCATTER), "dense rows only");
        const int ln = lane_id(), fr = ln & 15, fq = ln >> 4;
        LAS unsigned char* reg = lds + (wr ? EPI_R1 : EPI_R0);
        const LAS int* sl = (const LAS int*)(lds + SLOT_OFF + (ui & 1) * SLOT_BYTES);
        const int colb = u.pn * BM;
#pragma unroll
        for (int ai = 0; ai < 2; ++ai) {
            u32x4 xv[4][2]; float gate[4];
#pragma unroll
            for (int m = 0; m < 4; ++m) { const int rl = ai * HALF + wr * 64 + m * 16 + fr; int row; bool take = true;
                if (SCATTER) { row = sl[rl]; gate[m] = ((const LAS float*)sl)[256 + rl] * gscale; take = (unsigned)row < 65536u; }
                else { row = u.pm * BM + rl; gate[m] = 1.0f; }
                const bf16* xp = X + (size_t)(take ? row : 0) * D + colb + wc * 32 + fq * 8;
#pragma unroll
                for (int bj = 0; bj < 2; ++bj) { if (take) xv[m][bj] = *(const u32x4*)(xp + bj * HALF); else xv[m][bj] = (u32x4){0u, 0u, 0u, 0u}; } }
#pragma unroll
            for (int mh = 0; mh < 2; ++mh) {
#pragma unroll
                for (int mm = 0; mm < 2; ++mm) { const int m = 2 * mh + mm, lr = mm * 16 + fr; const float gt = gate[m];
#pragma unroll
                    for (int bj = 0; bj < 2; ++bj) { const f32x4 a0 = acc[ai][bj][m][0], a1 = acc[ai][bj][m][1]; const u32x4 x = xv[m][bj];
                        u32x4 w; w.x = pk_bf16(bf_lo(x.x) + a0[0] * gt, bf_hi(x.x) + a0[1] * gt); w.y = pk_bf16(bf_lo(x.y) + a0[2] * gt, bf_hi(x.y) + a0[3] * gt);
                        w.z = pk_bf16(bf_lo(x.z) + a1[0] * gt, bf_hi(x.z) + a1[1] * gt); w.w = pk_bf16(bf_lo(x.w) + a1[2] * gt, bf_hi(x.w) + a1[3] * gt);
                        *(LAS u32x4*)(reg + lr * 512 + (((bj * 16 + wc * 4 + fq) ^ (lr & 7)) * 16)) = w; } }
                EPI_BAR();
#pragma unroll
                for (int j = 0; j < 4; ++j) { const int lr = wc * 8 + 2 * j + (ln >> 5), c = ln & 31, rl = ai * HALF + wr * 64 + mh * 32 + lr;
                    const u32x4 w = *(const LAS u32x4*)(reg + lr * 512 + ((c ^ (lr & 7)) * 16));
                    if (SCATTER) { const int re = sl[rl];
                        if (re >= 0) { bf16* dst = (re >= 65536 ? Y1 : X) + (size_t)(re & 65535) * D + colb + c * 8; *(u32x4*)dst = w; } }
                    else { const size_t row = (size_t)(u.pm * BM + rl);
                        *(u32x4*)(X + row * D + colb + c * 8) = w;
                        if (X8) { u32x2 q; q.x = pk_fp8x4(bf_lo(w.x), bf_hi(w.x), bf_lo(w.y), bf_hi(w.y)); q.y = pk_fp8x4(bf_lo(w.z), bf_hi(w.z), bf_lo(w.w), bf_hi(w.w)); *(u32x2*)(X8 + row * D + colb + c * 8) = q; }
                        if (ACC_SS) { const float r0 = bf_lo(w.x), r1 = bf_hi(w.x), r2 = bf_lo(w.y), r3 = bf_hi(w.y), r4 = bf_lo(w.z), r5 = bf_hi(w.z), r6 = bf_lo(w.w), r7 = bf_hi(w.w);
                            float ss = ((r0 * r0 + r1 * r1) + (r2 * r2 + r3 * r3)) + ((r4 * r4 + r5 * r5) + (r6 * r6 + r7 * r7));
                            ss = row16_sum(ss); ss += shfl_xor_f(ss, 16);
                            if (c == 0) ss_out[row * 4 + u.pn] = ss; } } }
                EPI_BAR();
            }
        }
    }
};

__device__ __forceinline__ void load_offs(const Gemm& g, const Unit& u, const int (&Rr)[2], const int (&Cc)[2], unsigned (&o)[2][2]) {
#pragma unroll
    for (int h = 0; h < 2; ++h)
#pragma unroll
        for (int i = 0; i < 2; ++i) { int row = g.perm[u.pm * BM + h * HALF + Rr[i]]; row = row < 0 ? 0 : (row & 65535); o[h][i] = (unsigned)(row * g.K + Cc[i]) * 2u; }
}

template <class Epi, class Sched, bool ALIGN_EPI, bool GATHER, bool FP8 = false, int SLOTS = 0>
__device__ __forceinline__ void gemm_phase(LAS unsigned char* lds, const Gemm g, const Sched& S, const Epi& E, int wave_id) {
    int tid_ = wave_id * 64 + lane_id(); asm volatile("" : "+v"(tid_));
    const int tid = tid_, wid = __builtin_amdgcn_readfirstlane(tid >> 6), lane = tid & 63, wr = wid >> 2, wc = wid & 3, fr = lane & 15, fq = lane >> 4;
    const int K = g.K, nt = K / BK;
    int Rr[2], Cc[2]; unsigned voffA[2], voffB[2];
#pragma unroll
    for (int i = 0; i < 2; ++i) { int R, C; stage_rc(tid * 16 + i * 8192, R, C); Rr[i] = R; Cc[i] = C; const int Rb = Epi::PERM ? ((R & ~31) + perm32(R & 31)) : R;
        voffA[i] = (unsigned)(R * K + C) * 2u; voffB[i] = (unsigned)(Rb * K + C) * 2u; }
    const size_t kstep = (size_t)(BK * 2);
    const size_t hstep = (size_t)HALF * K * 2;
    const size_t tstep = 2 * hstep;
    const unsigned ldsw = (unsigned)wid * 1024u, ldsbase = (unsigned)(size_t)lds;
    const int aoff = lds_byte(wr * 64 + fr, fq * 8), boff = lds_byte(wc * 32 + fr, fq * 8);
#define PG8_SA(b, h) (((b) * 2 + (h)) * HTB)
#define PG8_SB(b, h) ((4 + (b) * 2 + (h)) * HTB)
#define PG8_STAGE(bufoff, gbase, voff) do { _Pragma("unroll") for (int _i = 0; _i < 2; ++_i) glds_s((const void*)(gbase), (voff)[_i], ldsbase + (unsigned)(bufoff) + ldsw + _i * 8192u); } while (0)
#define PG8_STAGE_A(bufoff, gbase, h) do { if constexpr (GATHER) PG8_STAGE(bufoff, gbase, offA[h]); else PG8_STAGE(bufoff, (gbase) + (h) * hstep, voffA); } while (0)
#define PG8_LDA(dst, b, h) do { _Pragma("unroll") for (int m = 0; m < 4; ++m) _Pragma("unroll") for (int k = 0; k < 2; ++k) dst[m][k] = *(const LAS bf16x8*)(lds + PG8_SA(b, h) + aoff + m * 2048 + k * 1024); } while (0)
#define PG8_LDB(dst, b, h) do { _Pragma("unroll") for (int n = 0; n < 2; ++n) _Pragma("unroll") for (int k = 0; k < 2; ++k) dst[n][k] = *(const LAS bf16x8*)(lds + PG8_SB(b, h) + boff + n * 2048 + k * 1024); } while (0)
#define PG8_CAT8(x) __builtin_shufflevector(__builtin_bit_cast(i32x4, (x)[0]), __builtin_bit_cast(i32x4, (x)[1]), 0, 1, 2, 3, 4, 5, 6, 7)
#define PG8_MMA(ai, bj, At, Bt) do { __builtin_amdgcn_s_setprio(1); \
        if constexpr (FP8) { _Pragma("unroll") for (int m = 0; m < 4; ++m) _Pragma("unroll") for (int n = 0; n < 2; ++n) \
            acc[ai][bj][m][n] = __builtin_amdgcn_mfma_scale_f32_16x16x128_f8f6f4(PG8_CAT8(Bt[n]), PG8_CAT8(At[m]), acc[ai][bj][m][n], 0, 0, 0, 0x7F7F7F7F, 0, 0x7F7F7F7F); } \
        else { _Pragma("unroll") for (int m = 0; m < 4; ++m) _Pragma("unroll") for (int n = 0; n < 2; ++n) _Pragma("unroll") for (int k = 0; k < 2; ++k) \
            acc[ai][bj][m][n] = __builtin_amdgcn_mfma_f32_16x16x32_bf16(Bt[n][k], At[m][k], acc[ai][bj][m][n], 0, 0, 0); } \
        __builtin_amdgcn_s_setprio(0); } while (0)
#define PG8_WAIT_V(n) asm volatile("s_waitcnt vmcnt(" #n ")" ::: "memory")
#define PG8_WAIT_L(n) asm volatile("s_waitcnt lgkmcnt(" #n ")" ::: "memory")
#define PG8_BAR __builtin_amdgcn_s_barrier()
#define PG8_SCHED __builtin_amdgcn_sched_barrier(0)
    Unit cur, nxt; int ui = 0;
    if (!S.next(0, cur)) return;
    if (STAG_TICKS) { const unsigned long long dly = (unsigned long long)((blockIdx.x >> 3) & 3) * STAG_TICKS, t0 = __builtin_amdgcn_s_memrealtime(); while (__builtin_amdgcn_s_memrealtime() - t0 < dly) __builtin_amdgcn_s_sleep(8); }
    Acc acc;
#pragma unroll
    for (int a = 0; a < 2; ++a)
#pragma unroll
        for (int b = 0; b < 2; ++b)
#pragma unroll
            for (int m = 0; m < 4; ++m)
#pragma unroll
                for (int n = 0; n < 2; ++n) acc[a][b][m][n] = (f32x4){0.f, 0.f, 0.f, 0.f};
    bf16x8 At[4][2], B0[2][2], B1[2][2];
    unsigned offA[2][2], offN[2][2];
#define PG8_SLOT_DMA(unit, par) do { if constexpr (SLOTS == 2) {   \
            if (wid < 4) glds_s((const void*)((const char*)g.aux + (size_t)(unit).pm * (BM * 16) + wid * 1024), (unsigned)lane_id() * 16u, ldsbase + SLOT_OFF + (par) * SLOT_BYTES + wid * 1024); } \
        else { const void* _b = wid < 4 ? (const void*)(g.perm + (unit).pm * BM + (wid & 3) * 64) : (const void*)(g.aux + (unit).pm * BM + (wid & 3) * 64); \
            glds4_s(_b, (unsigned)lane_id() * 4u, ldsbase + SLOT_OFF + (par) * SLOT_BYTES + wid * 256); } } while (0)
#define PG8_SLOT_OFFS(par, o) do { const LAS int* _sl = (const LAS int*)(lds + SLOT_OFF + (par) * SLOT_BYTES); _Pragma("unroll") for (int _h = 0; _h < 2; ++_h) _Pragma("unroll") for (int _i = 0; _i < 2; ++_i) { \
        int _r = _sl[_h * HALF + Rr[_i]]; _r = _r < 0 ? 0 : (_r & 65535); (o)[_h][_i] = (unsigned)(_r * K + Cc[_i]) * 2u; } } while (0)
    if constexpr (SLOTS) { PG8_SLOT_DMA(cur, 0); asm volatile("s_waitcnt vmcnt(0)" ::: "memory"); __builtin_amdgcn_s_barrier(); asm volatile("" ::: "memory");
        if constexpr (GATHER) PG8_SLOT_OFFS(0, offA); }
    else if constexpr (GATHER) load_offs(g, cur, Rr, Cc, offA);
    const char* cA = GATHER ? (const char*)g.A : (const char*)g.A + (size_t)cur.pm * tstep; const char* cB = (const char*)g.Bt + (size_t)cur.brow * tstep;
    PG8_STAGE(PG8_SB(0, 0), cB, voffB); PG8_STAGE(PG8_SB(0, 1), cB + hstep, voffB); PG8_STAGE_A(PG8_SA(0, 0), cA, 0); PG8_STAGE_A(PG8_SA(0, 1), cA, 1);
    if (wr == 1) PG8_BAR;
    PG8_WAIT_V(2); PG8_BAR;
    PG8_STAGE(PG8_SB(1, 0), cB + kstep, voffB); PG8_STAGE_A(PG8_SA(1, 0), cA + kstep, 0); PG8_STAGE(PG8_SB(1, 1), cB + hstep + kstep, voffB);
    PG8_WAIT_V(6); PG8_BAR;
    for (;;) {
        const bool has_next = S.next(ui + 1, nxt);
        if constexpr (SLOTS) { if (has_next) PG8_SLOT_DMA(nxt, (ui + 1) & 1); }
        if constexpr (GATHER && SLOTS == 0) { if (has_next) load_offs(g, nxt, Rr, Cc, offN); else {
#pragma unroll
            for (int h = 0; h < 2; ++h)
#pragma unroll
                for (int i = 0; i < 2; ++i) offN[h][i] = offA[h][i]; } }
        const char* nA = has_next ? (GATHER ? (const char*)g.A : (const char*)g.A + (size_t)nxt.pm * tstep) : cA; const char* nB = has_next ? (const char*)g.Bt + (size_t)nxt.brow * tstep : cB;
        for (int t = 0; t < nt; t += 2) {
            const bool last = (t == nt - 2);
            const char* a1 = cA + (size_t)(t + 1) * kstep;
            const char* a2 = last ? nA : cA + (size_t)(t + 2) * kstep; const char* b2 = last ? nB : cB + (size_t)(t + 2) * kstep;
            const char* a3 = a2 + kstep; const char* b3 = b2 + kstep;
            PG8_LDB(B0, 0, 0); PG8_LDB(B1, 0, 1); PG8_SCHED; PG8_LDA(At, 0, 0); PG8_STAGE_A(PG8_SA(1, 1), a1, 1);
            if constexpr (GATHER && SLOTS != 0) { if (last) { if (has_next) PG8_SLOT_OFFS((ui + 1) & 1, offN); else {
#pragma unroll
                for (int h = 0; h < 2; ++h)
#pragma unroll
                    for (int i = 0; i < 2; ++i) offN[h][i] = offA[h][i]; } } }
            if constexpr (GATHER) { if (last) {
#pragma unroll
                for (int h = 0; h < 2; ++h)
#pragma unroll
                    for (int i = 0; i < 2; ++i) offA[h][i] = offN[h][i]; } }
            PG8_WAIT_V(8); PG8_WAIT_L(0); PG8_BAR; PG8_MMA(0, 0, At, B0); PG8_MMA(0, 1, At, B1); PG8_BAR; PG8_SCHED;
            PG8_LDA(At, 0, 1); PG8_STAGE(PG8_SB(0, 0), b2, voffB); PG8_STAGE(PG8_SB(0, 1), b2 + hstep, voffB); PG8_STAGE_A(PG8_SA(0, 0), a2, 0);
            PG8_WAIT_V(8); PG8_WAIT_L(0); PG8_BAR; PG8_MMA(1, 0, At, B0); PG8_MMA(1, 1, At, B1); PG8_BAR; PG8_SCHED;
            PG8_LDB(B0, 1, 0); PG8_LDB(B1, 1, 1); PG8_SCHED; PG8_LDA(At, 1, 0); PG8_STAGE_A(PG8_SA(0, 1), a2, 1);
            PG8_WAIT_V(8); PG8_WAIT_L(0); PG8_BAR; PG8_MMA(0, 0, At, B0); PG8_MMA(0, 1, At, B1); PG8_BAR; PG8_SCHED;
            PG8_LDA(At, 1, 1); PG8_STAGE(PG8_SB(1, 0), b3, voffB); PG8_STAGE(PG8_SB(1, 1), b3 + hstep, voffB); PG8_STAGE_A(PG8_SA(1, 0), a3, 0);
            PG8_WAIT_V(8); PG8_WAIT_L(0); PG8_BAR; PG8_MMA(1, 0, At, B0); PG8_MMA(1, 1, At, B1); PG8_BAR; PG8_SCHED;
        }
        if constexpr (ALIGN_EPI) { if (wr == 0) PG8_BAR; }
        E(acc, cur, wr, wc, lds, ui);
        if (!has_next) break;
#pragma unroll
        for (int a = 0; a < 2; ++a)
#pragma unroll
            for (int b = 0; b < 2; ++b)
#pragma unroll
                for (int m = 0; m < 4; ++m)
#pragma unroll
                    for (int n = 0; n < 2; ++n) acc[a][b][m][n] = (f32x4){0.f, 0.f, 0.f, 0.f};
        cur = nxt; cA = nA; cB = nB; ++ui;
        if constexpr (ALIGN_EPI) { if (wr == 1) PG8_BAR; }
    }
    PG8_WAIT_V(0);
    if constexpr (!ALIGN_EPI) { if (wr == 0) PG8_BAR; }
    PG8_BAR;
#undef PG8_SA
#undef PG8_SB
#undef PG8_STAGE
#undef PG8_STAGE_A
#undef PG8_SLOT_DMA
#undef PG8_SLOT_OFFS
#undef PG8_LDA
#undef PG8_LDB
#undef PG8_MMA
#undef PG8_CAT8
#undef PG8_WAIT_V
#undef PG8_WAIT_L
#undef PG8_BAR
#undef PG8_SCHED
}
}

#define XB_TMO      128
#define XB_XCNT(j)  (256  + 64 * (j))
#define XB_XSUB(j)  (1280 + 64 * (j))
#define XB_XGEN(j)  (2304 + 64 * (j))
#define XB_TOP      3328
#define XB_TOPGEN   3392
#define XCD_BAR_WORDS 3456
#define XB_SPIN_CAP (1u << 18)
__device__ __forceinline__ unsigned xb_ld(unsigned* p)              { return __hip_atomic_load(p, __ATOMIC_RELAXED, __HIP_MEMORY_SCOPE_AGENT); }
__device__ __forceinline__ unsigned xb_add(unsigned* p, unsigned v) { return __hip_atomic_fetch_add(p, v, __ATOMIC_RELAXED, __HIP_MEMORY_SCOPE_AGENT); }
__device__ __forceinline__ unsigned xb_xcc_id() { return (unsigned)__builtin_amdgcn_s_getreg((3 << 11) | 20) & 0xFu; }
#define XB_SPIN(cond, bar) do { unsigned _sp = 0; while (cond) { __builtin_amdgcn_s_sleep(1); \
    if ((++_sp & 255u) == 0u) { if (xb_ld(&(bar)[XB_TMO])) break; if (_sp > XB_SPIN_CAP) { atomicAdd(&(bar)[XB_TMO], 1u); break; } } } } while (0)
struct XcdBarrier { unsigned* bar; unsigned x; volatile LAS unsigned* st; };
__device__ __forceinline__ XcdBarrier xcd_barrier_post(unsigned* bar, volatile LAS unsigned* st) {
    XcdBarrier b; b.bar = bar; b.x = xb_xcc_id(); b.st = st;
    if (threadIdx.x == 0) (void)xb_add(&bar[XB_XCNT(b.x)], 1u);
    return b;
}
__device__ __forceinline__ void xcd_barrier_complete(unsigned* bar, unsigned x, unsigned& nloc, unsigned& nx) {
    const unsigned G = gridDim.x * gridDim.y * gridDim.z;
    unsigned sum, cnt, mine, sp = 0u;
    for (;;) {
        sum = 0u; cnt = 0u; mine = 0u;
#pragma unroll
        for (unsigned j = 0; j < 16; ++j) { const unsigned c = xb_ld(&bar[XB_XCNT(j)]); sum += c; cnt += (c > 0u) ? 1u : 0u; mine = (j == x) ? c : mine; }
        if (sum == G) break;
        __builtin_amdgcn_s_sleep(1);
        if ((++sp & 255u) == 0u) { if (xb_ld(&bar[XB_TMO])) break; if (sp > XB_SPIN_CAP) { atomicAdd(&bar[XB_TMO], 1u); break; } }
    }
    nloc = mine > 0u ? mine : 1u; nx = cnt > 0u ? cnt : 1u;
}
__device__ __forceinline__ void xcd_barrier(const XcdBarrier& b) {
    asm volatile("s_waitcnt vmcnt(0)" ::: "memory");
    __syncthreads();
    if (threadIdx.x == 0) {
        unsigned* bar = b.bar;
        __builtin_amdgcn_s_waitcnt(0);
        unsigned nloc = b.st[0], nx = b.st[1];
        if (nloc == 0u) { xcd_barrier_complete(bar, b.x, nloc, nx); b.st[0] = nloc; b.st[1] = nx; }
        const unsigned old = xb_add(&bar[XB_XSUB(b.x)], 1u);
        const unsigned gen = old / nloc;
        if (old + 1u == (gen + 1u) * nloc) {
            __builtin_amdgcn_fence(__ATOMIC_RELEASE, "agent");
            asm volatile("s_waitcnt vmcnt(0)" ::: "memory");
            const unsigned og = xb_add(&bar[XB_TOP], 1u);
            const unsigned tg = og / nx;
            if (og + 1u == (tg + 1u) * nx) xb_add(&bar[XB_TOPGEN], 1u);
            else XB_SPIN(xb_ld(&bar[XB_TOPGEN]) == tg, bar);
            __builtin_amdgcn_fence(__ATOMIC_ACQUIRE, "agent");
            xb_add(&bar[XB_XGEN(b.x)], 1u);
            asm volatile("s_waitcnt vmcnt(0)" ::: "memory");
        } else {
            XB_SPIN(xb_ld(&bar[XB_XGEN(b.x)]) == gen, bar);
            __builtin_amdgcn_fence(__ATOMIC_ACQUIRE, "agent");
            asm volatile("s_waitcnt vmcnt(0)" ::: "memory");
        }
    }
    __syncthreads();
}

struct Args { const float* in[31]; float* out; unsigned char* ws; int ph_lo, ph_hi; };
typedef const __attribute__((address_space(4))) Args* ArgsP;

struct CvtDesc { const float* W; const float* gain; unsigned char* WT; int N, Kd, k0, n0, drow0; float qs; };
__device__ __forceinline__ CvtDesc cvt_decode(ArgsP a, int it) {
    constexpr int I_IN = 16 * 56, I_SQ = 16 * 32, I_UP = 16 * 88, I_DN = 44 * 32, I_LAYER = I_IN + 5 * I_SQ, I_FFN = 2 * I_UP + I_DN;
    unsigned char* ws = a->ws; CvtDesc d; d.gain = nullptr; d.qs = 0.f;
    if (it < 2 * I_LAYER) {
        const int l = it / I_LAYER; int r = it - l * I_LAYER;
        if (r < I_IN) { d.W = a->in[3] + (size_t)l * D * DIN; d.N = DIN; d.gain = a->in[2] + l * D; d.WT = ws + WS_WIN + (size_t)l * DIN * D * 2; d.Kd = D; d.k0 = 64 * (r / 56); d.n0 = 32 * (r % 56); d.drow0 = d.n0; }
        else { r -= I_IN; const int m = r / I_SQ; r -= m * I_SQ; d.N = D; d.Kd = D; d.k0 = 64 * (r / 32); d.n0 = 32 * (r % 32); d.drow0 = d.n0; const size_t lo = (size_t)l * D * D;
            if (m == 0)      { d.W = a->in[15] + lo; d.WT = ws + WS_WOUT + lo * 2; }
            else if (m == 1) { d.W = a->in[18] + lo; d.gain = a->in[16] + l * D; d.WT = ws + WS_WQ + lo * 2; }
            else if (m == 2) { d.W = a->in[19] + lo; d.gain = a->in[17] + l * D; d.WT = ws + WS_WK + lo * 2; }
            else if (m == 3) { d.W = a->in[20] + lo; d.gain = a->in[17] + l * D; d.WT = ws + WS_WV + lo * 2; }
            else             { d.W = a->in[21] + lo; d.WT = ws + WS_WO + lo * 2; } }
    } else {
        it -= 2 * I_LAYER; const int ex = it / I_FFN; int r = it - ex * I_FFN;
        const float *wg, *wu, *wd, *gn;
        if (ex == 0) { wg = a->in[23]; wu = a->in[24]; wd = a->in[25]; gn = a->in[22]; }
        else { const size_t e = ex - 1; wg = a->in[27] + e * D * DFF; wu = a->in[28] + e * D * DFF; wd = a->in[29] + e * DFF * D; gn = a->in[22] + D; }
        const bool up = r < 2 * I_UP;
        if (up) { const int isu = r >= I_UP; r -= isu * I_UP; d.W = isu ? wu : wg; d.N = DFF; d.gain = gn; d.Kd = D; d.k0 = 64 * (r / 88); d.n0 = 32 * (r % 88); d.drow0 = (d.n0 >> 7) * 256 + (d.n0 & 127) + (isu ? 128 : 0); }
        else { r -= 2 * I_UP; d.W = wd; d.N = D; d.Kd = DFF; d.k0 = 64 * (r / 32); d.n0 = 32 * (r % 32); d.drow0 = d.n0; }
        if (ex == 0) d.WT = up ? ws + WS_WGU : ws + WS_WD;
        else { const size_t e = ex - 1; d.WT = up ? ws + WS_MWGU + e * 2 * DFF * D : ws + WS_MWD + e * D * DFF; d.qs = up ? S8_UP : S8_DN; }
    }
    return d;
}
__device__ __forceinline__ void cvt_load(const CvtDesc& d, int lane, f32x4 (&v)[8], float (&g)[8]) {
    const float* p = d.W + (size_t)(d.k0 + (lane >> 3)) * d.N + d.n0 + 4 * (lane & 7);
#pragma unroll
    for (int j = 0; j < 8; ++j) { v[j] = *(const f32x4*)(p + (size_t)(8 * j) * d.N); g[j] = d.gain ? d.gain[d.k0 + (lane >> 3) + 8 * j] : 1.0f; }
}
__device__ __forceinline__ void cvt_store(const CvtDesc& d, int lane, const f32x4 (&v)[8], const float (&g)[8], LAS float* scr) {
    const float qm = d.qs != 0.f ? d.qs : 1.0f;
#pragma unroll
    for (int j = 0; j < 8; ++j) { LAS float* sp = scr + ((lane >> 3) + 8 * j) * 33 + 4 * (lane & 7); const float m = g[j] * qm;
        sp[0] = v[j][0] * m; sp[1] = v[j][1] * m; sp[2] = v[j][2] * m; sp[3] = v[j][3] * m; }
    asm volatile("s_waitcnt lgkmcnt(0)" ::: "memory");
    if (d.qs == 0.f) { const int c = lane & 7;
#pragma unroll
        for (int j = 0; j < 4; ++j) { const int n = (lane >> 3) + 8 * j; const LAS float* s = scr + (8 * c) * 33 + n;
            u32x4 o; o.x = pk_bf16(s[0 * 33], s[1 * 33]); o.y = pk_bf16(s[2 * 33], s[3 * 33]); o.z = pk_bf16(s[4 * 33], s[5 * 33]); o.w = pk_bf16(s[6 * 33], s[7 * 33]);
            *(u32x4*)(d.WT + ((size_t)(d.drow0 + n) * d.Kd + d.k0 + 8 * c) * 2) = o; }
    } else { const int c = lane & 3;
#pragma unroll
        for (int j = 0; j < 2; ++j) { const int n = (lane >> 2) + 16 * j; const LAS float* s = scr + (16 * c) * 33 + n;
            u32x4 o; o.x = pk_fp8x4(s[0 * 33], s[1 * 33], s[2 * 33], s[3 * 33]); o.y = pk_fp8x4(s[4 * 33], s[5 * 33], s[6 * 33], s[7 * 33]);
            o.z = pk_fp8x4(s[8 * 33], s[9 * 33], s[10 * 33], s[11 * 33]); o.w = pk_fp8x4(s[12 * 33], s[13 * 33], s[14 * 33], s[15 * 33]);
            *(u32x4*)(d.WT + (size_t)(d.drow0 + n) * d.Kd + d.k0 + 16 * c) = o; }
    }
    asm volatile("s_waitcnt lgkmcnt(0)" ::: "memory");
}

__device__ __forceinline__ void phase_prologue(ArgsP a, LAS unsigned char* lds, int vcu, int G, int tid, int lane, int wave) {
    unsigned char* ws = a->ws;
    LAS float* scr = (LAS float*)(lds + wave * 16384);
    const int gw = vcu * NWAVES + wave, NGW = G * NWAVES;
    constexpr int NITEMS = 2 * (16 * 56 + 5 * 16 * 32) + 9 * (2 * 16 * 88 + 44 * 32);
    {
        f32x4* rowss0 = (f32x4*)(ws + WS_ROWSS);
        for (int m0 = gw; m0 < T + MROWS; m0 += NGW) {
            f32x4 v[1][4];
#pragma unroll
            for (int q = 0; q < 1; ++q) { const int m = m0 + q; const bool isx = m < T; const int r = isx ? m : m - T;
                const f32x4* xr = (const f32x4*)((isx ? a->in[0] : a->in[1]) + (size_t)r * D) + lane;
#pragma unroll
                for (int j = 0; j < 4; ++j) v[q][j] = xr[64 * j]; }
#pragma unroll
            for (int q = 0; q < 1; ++q) { const int m = m0 + q; const bool isx = m < T; const int r = isx ? m : m - T; float s = 0.f;
#pragma unroll
                for (int j = 0; j < 4; ++j) s += (v[q][j][0] * v[q][j][0] + v[q][j][1] * v[q][j][1]) + (v[q][j][2] * v[q][j][2] + v[q][j][3] * v[q][j][3]);
                s = wave_sum(s);
                u32x2* o8 = (u32x2*)((isx ? (bf16*)(ws + WS_XB) : (bf16*)(ws + WS_MEMB)) + (size_t)r * D) + lane;
#pragma unroll
                for (int j = 0; j < 4; ++j) { u32x2 w; w.x = pk_bf16(v[q][j][0], v[q][j][1]); w.y = pk_bf16(v[q][j][2], v[q][j][3]); o8[64 * j] = w; }
                if (lane == 0) { if (isx) rowss0[r] = (f32x4){s, 0.f, 0.f, 0.f}; else ((u64*)(ws + OFF_MEMSS))[r] = ss_to_fix(s); } }
        }
    }
    if (gw < NITEMS) {
        CvtDesc d0 = cvt_decode(a, gw); f32x4 v[8]; float g[8]; cvt_load(d0, lane, v, g);
        for (int it = gw; it < NITEMS; it += NGW) {
            const int itn = it + NGW; const bool hn = itn < NITEMS;
            CvtDesc dn = d0; f32x4 w[8]; float gn[8];
            if (hn) { dn = cvt_decode(a, itn); cvt_load(dn, lane, w, gn); }
            cvt_store(d0, lane, v, g, scr);
            if (hn) { d0 = dn;
#pragma unroll
                for (int j = 0; j < 8; ++j) { v[j] = w[j]; g[j] = gn[j]; } }
        }
    }
    const int gt = vcu * NTHREADS + tid, NGT = G * NTHREADS;
    for (int i = gt; i < 2 * 4 * 128 * 128; i += NGT) { const int ii = (i >> 7) & 127, jj = i & 127; const float v = a->in[10][i]; ((bf16*)(ws + WS_SGUW))[i] = f2bf(((ii >> 6) >= (jj >> 6)) ? v : 0.f); }
    for (int i = gt; i < 2 * 4 * 64 * 64; i += NGT) { const int lg = i >> 12, o = (i >> 6) & 63, ii = i & 63; ((bf16*)(ws + WS_POOLW))[i] = f2bf(a->in[12][(lg << 12) + ii * 64 + o]); }
}

__device__ __forceinline__ void mixer_unit(ArgsP a, LAS unsigned char* lds, int l, int u, int tid_in, int lane_in, int wave) {
    int tid = tid_in, lane = lane_in;
    const bf16* z = (const bf16*)(a->ws + WS_Z); bf16* mixed = (bf16*)(a->ws + WS_MIXED);
    const int b = u >> 5, c = u & 31, t0 = c * 128; const size_t R0 = (size_t)b * SEQ + t0;
    u32x4 cvp[9], rv[12]; float sgl, sgb;
    MSEC(0);
    {
        const float* cw = a->in[4] + l * 31 * 384; const float* cb = a->in[5] + l * 384; const float* lg = a->in[6] + l * 384; const float* lb = a->in[7] + l * 384;
        LAS unsigned* wl = (LAS unsigned*)(lds + 135168);
        OPAQUE(tid);
        f32x2 cbv[3], lgv[3], lbv[3];
#pragma unroll
        for (int jt = 0; jt < 3; ++jt) { const unsigned p2 = (unsigned)((tid + NTHREADS * jt) % 192) * 8u; cbv[jt] = *(const f32x2*)((const char*)cb + p2); lgv[jt] = *(const f32x2*)((const char*)lg + p2); lbv[jt] = *(const f32x2*)((const char*)lb + p2); }
#pragma unroll 1
        for (int hb = 0; hb < 2; ++hb) { f32x2 wst[6];
#pragma unroll
          for (int q = 0; q < 6; ++q) { const unsigned idx = (unsigned)tid + (unsigned)(hb * 6 + q) * NTHREADS; wst[q] = (f32x2){0.f, 0.f}; if (idx < 31u * 192u) wst[q] = *(const f32x2*)((const char*)cw + idx * 8u); }
#pragma unroll
          for (int q = 0; q < 6; ++q) { const unsigned idx = (unsigned)tid + (unsigned)(hb * 6 + q) * NTHREADS; if (idx < 31u * 192u) wl[idx] = pk_bf16(wst[q].x, wst[q].y); } }
#pragma unroll 1
        for (int it0 = tid; it0 < 158 * 48; it0 += 5 * NTHREADS) {
            u32x4 av[5], gv[5];
#pragma unroll
            for (int q5 = 0; q5 < 5; ++q5) { const int it = it0 + q5 * NTHREADS, j = it / 48, v = it - j * 48; av[q5] = (u32x4){0u, 0u, 0u, 0u}; gv[q5] = av[q5];
                if (it < 158 * 48 && t0 - 30 + j >= 0) { const bf16* rp = z + (R0 + j - 30) * DIN + 8 * v; av[q5] = *(const u32x4*)rp; gv[q5] = *(const u32x4*)(rp + 384); } }
#pragma unroll
            for (int q5 = 0; q5 < 5; ++q5) { const int it = it0 + q5 * NTHREADS, j = it / 48, v = it - j * 48; u32x4 o;
#pragma unroll
                for (int q = 0; q < 4; ++q) o[q] = pk_bf16(bf_lo(av[q5][q]) * sigm(bf_lo(gv[q5][q])), bf_hi(av[q5][q]) * sigm(bf_hi(gv[q5][q])));
                if (it < 158 * 48) *(LAS u32x4*)(lds + j * 768 + v * 16) = o; }
        }
        __syncthreads();
        MSEC(1);
        LAS float* part = (LAS float*)(lds + 122880);
        LAS float* fin = (LAS float*)(lds + 159744);
        OPAQUE(tid); lane = tid & 63;
#pragma unroll 1
        for (int jt = 0; jt < 3; ++jt) { const int item = tid + NTHREADS * jt, rg = item / 192, p = item - rg * 192, q3 = p >> 6;
            f32x2 w[31];
#pragma unroll
            for (int k = 0; k < 31; ++k) { const unsigned wq = wl[k * 192 + p]; w[k] = (f32x2){bf_lo(wq), bf_hi(wq)}; }
            const f32x2 bias = jt == 0 ? cbv[0] : jt == 1 ? cbv[1] : cbv[2];
            float y0[16], y1[16];
#pragma unroll
            for (int i = 0; i < 16; ++i) { y0[i] = bias.x; y1[i] = bias.y; }
            const LAS unsigned* hp = (const LAS unsigned*)lds + (rg * 16) * 192 + p;
#pragma unroll
            for (int jj = 0; jj < 46; ++jj) { const unsigned hv = hp[jj * 192]; const float h0 = bf_lo(hv), h1 = bf_hi(hv);
#pragma unroll
                for (int i = 0; i < 16; ++i) { const int k = jj - i; if (k >= 0 && k <= 30) { y0[i] += w[k].x * h0; y1[i] += w[k].y * h1; } } }
#pragma unroll
            for (int i = 0; i < 16; ++i) { float s1 = y0[i] + y1[i], s2 = y0[i] * y0[i] + y1[i] * y1[i];
                s1 = row16_sum(s1); s2 = row16_sum(s2);
                if ((lane & 15) == 0) { const int pi = ((rg * 16 + i) * 12 + q3 * 4 + (lane >> 4)) * 2; part[pi] = s1; part[pi + 1] = s2; }
                *(unsigned*)(mixed + (R0 + rg * 16 + i) * D + 2 * p) = pk_bf16(y0[i], y1[i]); }
        }
        __syncthreads();
        MSEC(2);
        OPAQUE(tid);
#pragma unroll
        for (int q9 = 0; q9 < 9; ++q9) { const int it = tid + q9 * NTHREADS, j = it >> 5, v = it & 31; cvp[q9] = (u32x4){0u, 0u, 0u, 0u};
            if (it < 143 * 32 && t0 - 15 + j >= 0) cvp[q9] = *(const u32x4*)(z + (R0 + j - 15) * DIN + 1536 + 8 * v); }
        if (tid < 256) { const LAS float* pr = part + (tid >> 1) * 24 + (tid & 1); float sm = 0.f;
#pragma unroll
            for (int k = 0; k < 12; ++k) sm += pr[2 * k];
            fin[tid] = sm; }
        __syncthreads();
        OPAQUE(tid);
#pragma unroll 1
        for (int jt = 0; jt < 3; ++jt) { const int item = tid + NTHREADS * jt, rg = item / 192, p = item - rg * 192;
            const f32x2 g2 = jt == 0 ? lgv[0] : jt == 1 ? lgv[1] : lgv[2], b2 = jt == 0 ? lbv[0] : jt == 1 ? lbv[1] : lbv[2];
#pragma unroll
            for (int i = 0; i < 16; ++i) { const int row = rg * 16 + i;
                const float S1 = fin[row * 2], S2 = fin[row * 2 + 1];
                const float mean = S1 * (1.0f / 384.0f), var = S2 * (1.0f / 384.0f) - mean * mean, rstd = __builtin_amdgcn_rsqf(var + EPS);
                unsigned* mp = (unsigned*)(mixed + (R0 + row) * D + 2 * p); const unsigned yv = *mp;
                const float o0 = (bf_lo(yv) - mean) * rstd * g2.x + b2.x, o1 = (bf_hi(yv) - mean) * rstd * g2.y + b2.y;
                *mp = pk_bf16(silu_f(o0), silu_f(o1)); } }
    }
    {
        MSEC(3);
        OPAQUE(tid); lane = tid & 63;
        const bf16* pwT = (const bf16*)(a->ws + WS_POOLW) + l * 4 * 64 * 64; const float* pb = a->in[13] + l * 256; const float* psc = a->in[14] + l * 256;
        {
#pragma unroll
            for (int q9 = 0; q9 < 9; ++q9) { const int it = tid + q9 * NTHREADS, j = it >> 5, v = it & 31; if (it < 143 * 32) *(LAS u32x4*)(lds + j * 512 + v * 16) = cvp[q9]; } }
        __syncthreads();
        OPAQUE(tid);
        bf16x8 pwf[2][4]; f32x4 pbv[4], pscv[4];
        { const int l2 = tid & 63, r = l2 & 15, kq = l2 >> 4, g = wave & 3;
#pragma unroll
            for (int ks = 0; ks < 2; ++ks)
#pragma unroll
                for (int n = 0; n < 4; ++n) pwf[ks][n] = *(const bf16x8*)(pwT + ((g * 64 + 16 * n + r) * 64 + 32 * ks + 8 * kq));
#pragma unroll
            for (int n = 0; n < 4; ++n) { const int ch = g * 64 + 16 * n + 4 * kq; pbv[n] = *(const f32x4*)(pb + ch); pscv[n] = *(const f32x4*)(psc + ch); } }
        sgl = 0.f; sgb = 0.f; if (tid < 384) { sgl = a->in[8][l * 384 + tid]; sgb = a->in[9][l * 384 + tid]; }
#pragma unroll
        for (int q12 = 0; q12 < 12; ++q12) rv[q12] = *(const u32x4*)(z + (R0 + (tid & 127)) * DIN + 1152 + (tid >> 7) * 96 + 8 * q12);
        { const int pp = tid & 127, rq = tid >> 7; const int w = 2 << (pp >> 5); const LAS unsigned* cp = (const LAS unsigned*)lds + pp; const int i0 = rq * 32;
            float s0 = 0.f, s1 = 0.f;
#pragma unroll
            for (int kk = 0; kk < 16; ++kk) if (kk < w) { const unsigned v = cp[(i0 + 15 - kk) * 128]; s0 += bf_lo(v); s1 += bf_hi(v); }
#pragma unroll 8
            for (int ii = 0; ii < 32; ++ii) { const int i = i0 + ii; const unsigned cv = cp[(i + 15) * 128];
                const int tpos = t0 + i + 1; const float inv = 1.0f / (float)(tpos < w ? tpos : w);
                *(LAS unsigned*)(lds + 73728 + i * 528 + pp * 4) = pk_bf16(s0 * inv - bf_lo(cv), s1 * inv - bf_hi(cv));
                if (ii < 31) { const unsigned vn = cp[(i + 16) * 128], vo = cp[(i + 16 - w) * 128]; s0 += bf_lo(vn) - bf_lo(vo); s1 += bf_hi(vn) - bf_hi(vo); } } }
        __syncthreads();
        OPAQUE(tid); lane = tid & 63;
        { const int r = lane & 15, kq = lane >> 4, g = wave & 3, rh = wave >> 2; f32x4 acc[4][4];
#pragma unroll
            for (int rt = 0; rt < 4; ++rt)
#pragma unroll
                for (int n = 0; n < 4; ++n) acc[rt][n] = (f32x4){0.f, 0.f, 0.f, 0.f};
#pragma unroll
            for (int ks = 0; ks < 2; ++ks)
#pragma unroll
                for (int rt = 0; rt < 4; ++rt) { const bf16x8 af = *(const LAS bf16x8*)(lds + 73728 + (64 * rh + 16 * rt + r) * 528 + (g * 64 + 32 * ks + 8 * kq) * 2);
#pragma unroll
                    for (int n = 0; n < 4; ++n) acc[rt][n] = __builtin_amdgcn_mfma_f32_16x16x32_bf16(pwf[ks][n], af, acc[rt][n], 0, 0, 0); }
#pragma unroll
            for (int n = 0; n < 4; ++n) { const int ch = g * 64 + 16 * n + 4 * kq; const f32x4 b4 = pbv[n], s4 = pscv[n];
#pragma unroll
                for (int rt = 0; rt < 4; ++rt) { const int row = 64 * rh + 16 * rt + r; const f32x4 o = (acc[rt][n] + b4) * s4;
                    u32x2 w2; w2.x = pk_bf16(o[0], o[1]); w2.y = pk_bf16(o[2], o[3]); *(u32x2*)(mixed + (R0 + row) * D + 768 + ch) = w2; } } }
        __syncthreads();
    }
    {
        MSEC(4);
        OPAQUE(tid); lane = tid & 63;
        const float* lg = a->in[8] + l * 384; const float* lb = a->in[9] + l * 384; const float* sb = a->in[11] + l * 4 * 128;
        const bf16* Wm = (const bf16*)(a->ws + WS_SGUW) + (size_t)l * 4 * 128 * 128;
        LAS float* prm = (LAS float*)(lds + 126976);
        if (tid < 384) { prm[tid] = sgl; prm[384 + tid] = sgb; }
        { const int j = tid & 127, qd = __builtin_amdgcn_readfirstlane(tid >> 7); float vv[96]; float s1 = 0.f, s2 = 0.f;
#pragma unroll
            for (int k = 0; k < 12; ++k) { const u32x4 x = rv[k];
#pragma unroll
                for (int q = 0; q < 4; ++q) { const float e0 = gelu_tanh(bf_lo(x[q])), e1 = gelu_tanh(bf_hi(x[q])); vv[8 * k + 2 * q] = e0; vv[8 * k + 2 * q + 1] = e1; s1 += e0 + e1; s2 += e0 * e0 + e1 * e1; } }
            LAS float* st = (LAS float*)(lds + 122880);
            st[(j * 4 + qd) * 2] = s1; st[(j * 4 + qd) * 2 + 1] = s2;
            __syncthreads();
            const float S1 = st[j * 8] + st[j * 8 + 2] + st[j * 8 + 4] + st[j * 8 + 6], S2 = st[j * 8 + 1] + st[j * 8 + 3] + st[j * 8 + 5] + st[j * 8 + 7];
            const float mean = S1 * (1.0f / 384.0f), var = S2 * (1.0f / 384.0f) - mean * mean, rstd = __builtin_amdgcn_rsqf(var + EPS);
#pragma unroll
            for (int cidx = 0; cidx < 96; ++cidx) { const float o = (vv[cidx] - mean) * rstd * prm[qd * 96 + cidx] + prm[384 + qd * 96 + cidx];
                *(LAS bf16*)(lds + (qd * 96 + cidx) * 272 + j * 2) = f2bf(o); } }
        __syncthreads();
        MSEC(5);
        OPAQUE(tid); lane = tid & 63;
        { const int hd = wave >> 1, ih = wave & 1, r = lane & 15, kq = lane >> 4; f32x4 acc[6][4];
#pragma unroll
            for (int dt = 0; dt < 6; ++dt)
#pragma unroll
                for (int it = 0; it < 4; ++it) acc[dt][it] = (f32x4){0.f, 0.f, 0.f, 0.f};
            bf16x8 wf[4][4]; u32x2 uu[4][6];
            const bf16* Wh = Wm + (size_t)hd * 128 * 128;
#pragma unroll
            for (int ks = 0; ks < 4; ++ks)
#pragma unroll
                for (int it = 0; it < 4; ++it) wf[ks][it] = *(const bf16x8*)(Wh + (64 * ih + 16 * it + r) * 128 + 32 * ks + 8 * kq);
#pragma unroll
            for (int it = 0; it < 4; ++it)
#pragma unroll
                for (int dt = 0; dt < 6; ++dt) uu[it][dt] = *(const u32x2*)(z + (R0 + 64 * ih + 16 * it + r) * DIN + 768 + hd * 96 + 16 * dt + 4 * kq);
#pragma unroll
            for (int ks = 0; ks < 4; ++ks) { if (ks >= 2 && ih == 0) continue;
#pragma unroll
                for (int dt = 0; dt < 6; ++dt) { const bf16x8 vf = *(const LAS bf16x8*)(lds + (hd * 96 + 16 * dt + r) * 272 + (32 * ks + 8 * kq) * 2);
#pragma unroll
                    for (int it = 0; it < 4; ++it) acc[dt][it] = __builtin_amdgcn_mfma_f32_16x16x32_bf16(vf, wf[ks][it], acc[dt][it], 0, 0, 0); } }
#pragma unroll
            for (int it = 0; it < 4; ++it) { const int i = 64 * ih + 16 * it + r; const float sbv = sb[hd * 128 + i];
#pragma unroll
                for (int dt = 0; dt < 6; ++dt) { const int ch = hd * 96 + 16 * dt + 4 * kq; const u32x2 u2 = uu[it][dt];
                    const float o0 = gelu_tanh(bf_lo(u2.x)) * (acc[dt][it][0] + sbv), o1 = gelu_tanh(bf_hi(u2.x)) * (acc[dt][it][1] + sbv);
                    const float o2 = gelu_tanh(bf_lo(u2.y)) * (acc[dt][it][2] + sbv), o3 = gelu_tanh(bf_hi(u2.y)) * (acc[dt][it][3] + sbv);
                    u32x2 w2; w2.x = pk_bf16(o0, o1); w2.y = pk_bf16(o2, o3); *(u32x2*)(mixed + (R0 + i) * D + 384 + ch) = w2; } } }
        __syncthreads();
        MSEC(6);
    }
}

__device__ __forceinline__ void attn_dma_k(const bf16* Kbase, int t, unsigned ldsbase, int wave, int lane) {
#pragma unroll
    for (int i = 0; i < 4; ++i) { const int pi = wave * 4 + i, rowt = 2 * pi + (lane >> 5), cl = (lane & 31) ^ (rowt & 31);
        pg8::glds_s((const void*)Kbase, (unsigned)((64 * t + rowt) * 2048 + cl * 8) * 2u, ldsbase + (unsigned)t * 32768u + (unsigned)pi * 1024u); }
}
__device__ __forceinline__ void attn_dma_v(const bf16* Vbase, int t, unsigned ldsbase, int wave, int lane) {
#pragma unroll
    for (int i = 0; i < 4; ++i) { const int pi = wave * 4 + i, row = 8 * pi + (lane >> 3), cl = (lane & 7) ^ (row & 7);
        pg8::glds_s((const void*)Vbase, (unsigned)(row * 2048 + 64 * t + cl * 8) * 2u, ldsbase + (unsigned)t * 32768u + (unsigned)pi * 1024u); }
}
__device__ __forceinline__ void attn_phase(ArgsP a, LAS unsigned char* lds, int l, int vcu, int G, int tid, int wave) {
    const bf16* Q = (const bf16*)(a->ws + WS_Q); bf16* O = (bf16*)(a->ws + WS_O);
    const bf16* KB = (const bf16*)(a->ws + WS_KB); const bf16* VT = (const bf16*)(a->ws + WS_VT);
    const unsigned ldsbase = (unsigned)(size_t)lds;
    int lane = tid & 63;
    bool first = true;
    bf16x8 qf[16];
#define ATT_LOADQ(uu, s0, s1) do { const int _bh = (uu) >> 4; const bf16* _qp = Q + ((size_t)(_bh >> 2) * SEQ + ((uu) & 15) * 256 + wave * 32 + (lane & 31)) * D + (_bh & 3) * 256 + 8 * (lane >> 5); \
        _Pragma("unroll") for (int s = s0; s < s1; ++s) qf[s] = *(const bf16x8*)(_qp + 16 * s); } while (0)
    constexpr int QPRE_N = 6;
    if (ATT_QPRE && vcu < 512) ATT_LOADQ(vcu, 0, QPRE_N);
    for (int u = vcu; u < 512; u += G) {
        const int qt = u & 15, bh = u >> 4, b = bh >> 2, h = bh & 3;
        const int un = u + G; const bool has_next = un < 512;
        const bf16* Kbase = KB + (size_t)(b * 256) * 2048 + l * 1024 + h * 256;
        const bf16* Vbase = VT + (size_t)(l * 1024 + h * 256) * 2048 + b * 256;
        const bf16* Knext = KB + (size_t)(((un >> 4) >> 2) * 256) * 2048 + l * 1024 + ((un >> 4) & 3) * 256;
        OPAQUE(lane);
        if (first) {
#pragma unroll
            for (int t = 0; t < 4; ++t) attn_dma_k(Kbase, t, ldsbase, wave, lane); }
        first = false;
        const int r = lane & 31, h2 = lane >> 5;
        if (!ATT_QPRE) ATT_LOADQ(u, 0, 16);
        asm volatile("s_waitcnt vmcnt(0)" ::: "memory");
        __syncthreads();
        if (ATT_QPRE) ATT_LOADQ(u, QPRE_N, 16);
        f32x16 sacc[8];
#pragma unroll
        for (int kt = 0; kt < 8; ++kt)
#pragma unroll
            for (int j = 0; j < 16; ++j) sacc[kt][j] = 0.f;
#define ATT_LDK(i) (*(const LAS bf16x8*)(lds + ((i) >> 5) * 32768 + (32 * ((i) & 1) + r) * 512 + (((2 * (((i) >> 1) & 15) + h2) ^ r) * 16)))
        { bf16x8 kb[4];
#pragma unroll
          for (int i = 0; i < 4; ++i) kb[i] = ATT_LDK(i);
#pragma unroll
          for (int idx = 0; idx < 128; ++idx) { const int t = idx >> 5, sq = (idx >> 1) & 15, k2 = idx & 1;
              sacc[2 * t + k2] = __builtin_amdgcn_mfma_f32_32x32x16_bf16(kb[idx & 3], qf[sq], sacc[2 * t + k2], 0, 0, 0);
              if (idx + 4 < 128) kb[idx & 3] = ATT_LDK(idx + 4);
              __builtin_amdgcn_sched_barrier(0);
              if ((idx & 31) == 31) {
                  asm volatile("" ::: "memory"); __builtin_amdgcn_s_barrier(); asm volatile("" ::: "memory");
                  OPAQUE(lane); attn_dma_v(Vbase, t, ldsbase, wave, lane); __builtin_amdgcn_sched_barrier(0); } } }
#undef ATT_LDK
        float mx = -3.0e38f;
#pragma unroll
        for (int kt = 0; kt < 8; ++kt)
#pragma unroll
            for (int j = 0; j < 16; ++j) mx = fmaxf(mx, sacc[kt][j]);
        mx = fmaxf(mx, shfl_xor_f(mx, 32));
        float sum = 0.f; bf16x8 pf[8][2];
#pragma unroll
        for (int kt = 0; kt < 8; ++kt) {
            float p[16];
#pragma unroll
            for (int j = 0; j < 16; ++j) { p[j] = __builtin_amdgcn_exp2f(sacc[kt][j] - mx); sum += p[j]; }
#pragma unroll
            for (int s2 = 0; s2 < 2; ++s2) { u32x4 w; w.x = pk_bf16_v(p[8 * s2], p[8 * s2 + 1]); w.y = pk_bf16_v(p[8 * s2 + 2], p[8 * s2 + 3]); w.z = pk_bf16_v(p[8 * s2 + 4], p[8 * s2 + 5]); w.w = pk_bf16_v(p[8 * s2 + 6], p[8 * s2 + 7]);
                pf[kt][s2] = __builtin_bit_cast(bf16x8, w); }
            __builtin_amdgcn_sched_barrier(0); }
        sum += shfl_xor_f(sum, 32);
        const float inv = 1.0f / sum;
        f32x16 oacc[8]; f32x16 zero16;
#pragma unroll
        for (int j = 0; j < 16; ++j) zero16[j] = 0.f;
        asm volatile("s_waitcnt vmcnt(12)" ::: "memory"); __builtin_amdgcn_s_barrier(); asm volatile("" ::: "memory");
        { OPAQUE(lane); const int r2 = lane & 31, g2 = lane >> 5;
#define ATT_LDV(t, j) (*(const LAS bf16x8*)(lds + (t) * 32768 + (32 * ((j) & 7) + r2) * 128 + (((2 * ((j) >> 3) + g2) ^ (r2 & 7)) * 16)))
#pragma unroll
          for (int t = 0; t < 4; ++t) { bf16x8 vb[4];
#pragma unroll
              for (int i = 0; i < 4; ++i) vb[i] = ATT_LDV(t, i);
#pragma unroll
              for (int j = 0; j < 32; ++j) { const int s4 = j >> 3, dt = j & 7;
                  oacc[dt] = __builtin_amdgcn_mfma_f32_32x32x16_bf16(vb[j & 3], pf[2 * t + (s4 >> 1)][s4 & 1], (t == 0 && s4 == 0) ? zero16 : oacc[dt], 0, 0, 0);
                  if (j + 4 < 32) vb[j & 3] = ATT_LDV(t, j + 4);
                  __builtin_amdgcn_sched_barrier(0); }
              if (t < 3) { if (has_next) asm volatile("s_waitcnt vmcnt(8)" ::: "memory");
                  else if (t == 0) asm volatile("s_waitcnt vmcnt(8)" ::: "memory"); else if (t == 1) asm volatile("s_waitcnt vmcnt(4)" ::: "memory"); else asm volatile("s_waitcnt vmcnt(0)" ::: "memory"); }
              asm volatile("" ::: "memory"); __builtin_amdgcn_s_barrier(); asm volatile("" ::: "memory");
              if (has_next) { int l2 = lane; OPAQUE(l2); attn_dma_k(Knext, t, ldsbase, wave, l2); __builtin_amdgcn_sched_barrier(0); } }
#undef ATT_LDV
        }
        { OPAQUE(lane); const int r2 = lane & 31, g2 = lane >> 5; LAS unsigned char* pat = lds + 131072 + wave * 2048;
#pragma unroll
            for (int dp = 0; dp < 4; ++dp)
#pragma unroll
                for (int rh = 0; rh < 2; ++rh) {
                    if (ATT_QPRE && dp == 2 && rh == 0 && has_next) ATT_LOADQ(un, 0, QPRE_N);
                    if ((r2 >> 4) == rh) {
#pragma unroll
                        for (int d2 = 0; d2 < 2; ++d2)
#pragma unroll
                            for (int g4 = 0; g4 < 4; ++g4) { const int dt = 2 * dp + d2; u32x2 w; w.x = pk_bf16(oacc[dt][4 * g4] * inv, oacc[dt][4 * g4 + 1] * inv); w.y = pk_bf16(oacc[dt][4 * g4 + 2] * inv, oacc[dt][4 * g4 + 3] * inv);
                                const int c8 = d2 * 8 + g4 * 2 + g2, lr = r2 & 15;
                                *(LAS u32x2*)(pat + lr * 128 + ((((c8 >> 1) ^ (lr & 7)) * 16) + (c8 & 1) * 8)) = w; } }
                    asm volatile("s_waitcnt lgkmcnt(0)" ::: "memory");
#pragma unroll
                    for (int j = 0; j < 2; ++j) { const int row = 8 * j + (lane >> 3), c = lane & 7;
                        const u32x4 w = *(const LAS u32x4*)(pat + row * 128 + ((c ^ (row & 7)) * 16));
                        *(u32x4*)(O + ((size_t)b * SEQ + qt * 256 + wave * 32 + rh * 16 + row) * D + h * 256 + dp * 64 + c * 8) = w; }
                    asm volatile("s_waitcnt lgkmcnt(0)" ::: "memory");
                }
        }
    }
#undef ATT_LOADQ
    asm volatile("s_waitcnt vmcnt(0)" ::: "memory");
    __syncthreads();
}

constexpr size_t WS_CHUNKCNT = WS_ROUTE + 4 * (size_t)T * 4 + 3 * (size_t)PERMROWS * 4;
__device__ __forceinline__ void phase_router(ArgsP a, LAS unsigned char* lds, int vcu, int G, int tid, int lane, int wave) {
    unsigned char* ws = a->ws;
    constexpr int BP = 2064;
    LAS unsigned char* bt = lds;
    LAS float* lg = (LAS float*)(lds + 36864 + wave * 512);
    LAS int* hist = (LAS int*)(lds + 36864 + 4096);
    const float* gn = a->in[22] + D; const float* rw = a->in[26];
    { f32x4 wv[2][2]; float gk[2];
#pragma unroll
        for (int q = 0; q < 2; ++q) { const int k = tid + NTHREADS * q; wv[q][0] = *(const f32x4*)(rw + k * 8); wv[q][1] = *(const f32x4*)(rw + k * 8 + 4); gk[q] = gn[k]; }
#pragma unroll
        for (int q = 0; q < 2; ++q) { const int k = tid + NTHREADS * q;
#pragma unroll
            for (int e = 0; e < 8; ++e) { const float w = gk[q] * wv[q][e >> 2][e & 3];
                const unsigned hi = pk_bf16(w, 0.f) & 0xffffu; const float hif = __uint_as_float(hi << 16);
                *(LAS bf16*)(bt + e * BP + k * 2) = (bf16)hi; *(LAS bf16*)(bt + (8 + e) * BP + k * 2) = f2bf(w - hif); } } }
    const f32x4* rowss = (const f32x4*)(ws + WS_ROWSS) + 5 * T;
    int* sel = (int*)(ws + WS_ROUTE); float* gate = (float*)(ws + WS_ROUTE + 2 * T * 4); int* chunkcnt = (int*)(ws + WS_CHUNKCNT);
    const int r = lane & 15, kq = lane >> 4;
    for (int chunk = vcu; chunk < T / 128; chunk += G) {
        __syncthreads();
        if (tid < 8) hist[tid] = 0;
        __syncthreads();
        const int mb = chunk * 128 + wave * 16;
        const bf16* xp = (const bf16*)(ws + WS_XB) + (size_t)(mb + r) * D + 8 * kq;
        float rs[4];
#pragma unroll
        for (int i = 0; i < 4; ++i) rs[i] = rstd4(rowss[mb + 4 * kq + i]);
        f32x4 acc = {0.f, 0.f, 0.f, 0.f};
#pragma unroll
        for (int hf = 0; hf < 2; ++hf) { bf16x8 af[16];
#pragma unroll
            for (int s = 0; s < 16; ++s) af[s] = *(const bf16x8*)(xp + 32 * (16 * hf + s));
#pragma unroll
            for (int s = 0; s < 16; ++s) { const bf16x8 bfr = *(const LAS bf16x8*)(bt + r * BP + (32 * (16 * hf + s) + 8 * kq) * 2);
                acc = __builtin_amdgcn_mfma_f32_16x16x32_bf16(af[s], bfr, acc, 0, 0, 0); } }
#pragma unroll
        for (int i = 0; i < 4; ++i) { const float v = acc[i] + dpp_f<0x128>(acc[i]); if (r < 8) lg[(4 * kq + i) * 8 + r] = v * rs[i]; }
        asm volatile("s_waitcnt lgkmcnt(0)" ::: "memory");
        if (lane < 16) { const int m = mb + lane; const f32x4 p0 = *(const LAS f32x4*)(lg + lane * 8), p1 = *(const LAS f32x4*)(lg + lane * 8 + 4);
            const float p[8] = {p0[0], p0[1], p0[2], p0[3], p1[0], p1[1], p1[2], p1[3]};
            int i0 = 0; float v0 = p[0];
#pragma unroll
            for (int e = 1; e < 8; ++e) if (p[e] > v0) { v0 = p[e]; i0 = e; }
            int i1 = -1; float v1 = -3.0e38f;
#pragma unroll
            for (int e = 0; e < 8; ++e) if (e != i0 && p[e] > v1) { v1 = p[e]; i1 = e; }
            const float g0 = 1.0f / (1.0f + __expf(v1 - v0)), g1 = 1.0f - g0;
            sel[m] = i0; sel[T + m] = i1; gate[m] = g0; gate[T + m] = g1;
            __hip_atomic_fetch_add(&hist[i0], 1, __ATOMIC_RELAXED, __HIP_MEMORY_SCOPE_WORKGROUP); __hip_atomic_fetch_add(&hist[i1], 1, __ATOMIC_RELAXED, __HIP_MEMORY_SCOPE_WORKGROUP); }
        __syncthreads();
        { int t3 = tid; OPAQUE(t3); if (t3 < 8) chunkcnt[chunk * 8 + t3] = hist[t3]; }
    }
}
__device__ __forceinline__ void phase_lists(ArgsP a, LAS unsigned char* lds, int vcu, int G, int tid) {
    unsigned char* ws = a->ws;
    const int* chunkcnt = (const int*)(ws + WS_CHUNKCNT);
    const f32x4* rowss = (const f32x4*)(ws + WS_ROWSS) + 5 * T;
    const int* sel = (const int*)(ws + WS_ROUTE); const float* gate = (const float*)(ws + WS_ROUTE + 2 * T * 4);
    int* perm = (int*)(ws + WS_ROUTE + 4 * T * 4); float* rsp = (float*)(ws + WS_ROUTE + 4 * T * 4 + (size_t)PERMROWS * 4); float* gp = (float*)(ws + WS_ROUTE + 4 * T * 4 + 2 * (size_t)PERMROWS * 4);
    LAS int* lc = (LAS int*)lds;
    LAS int* tot = (LAS int*)(lds + 64);
    LAS int* lb = (LAS int*)(lds + 128);
    const int lane = tid & 63, wv = __builtin_amdgcn_readfirstlane(tid >> 6);
    for (int chunk = vcu; chunk < T / 128; chunk += G) {
        __syncthreads();
        if (tid < 8) lc[tid] = 0;
        { float sa = 0.f, sb = 0.f;
#pragma unroll
            for (int i = 0; i < 4; ++i) { const int c = 4 * lane + i; const float v = (float)chunkcnt[c * 8 + wv]; sa += v; sb += (c < chunk) ? v : 0.f; }
            sa = wave_sum(sa); sb = wave_sum(sb);
            if (lane == 0) { tot[wv] = (int)sa; lb[wv] = (int)sb; } }
        __syncthreads();
        if (chunk == 0 && tid < 8) ((int*)(ws + OFF_MOECNT))[tid] = tot[tid];
        if (tid < 256) { const int sl = tid >> 7, tok = chunk * 128 + (tid & 127); const int e = sel[sl * T + tok];
            const int rnk = __hip_atomic_fetch_add(&lc[e], 1, __ATOMIC_RELAXED, __HIP_MEMORY_SCOPE_WORKGROUP);
            int off = 0;
#pragma unroll
            for (int j = 0; j < 8; ++j) { const int tl = (tot[j] + 255) >> 8; if (j < e) off += tl * 256; }
            const int pos = off + lb[e] + rnk;
            perm[pos] = tok + 65536 * sl; rsp[pos] = rstd4(rowss[tok]); gp[pos] = gate[sl * T + tok]; }
        if (chunk < 8) { const int e = chunk; int off = 0, ce = 0;
#pragma unroll
            for (int j = 0; j < 8; ++j) { const int cj = tot[j]; const int tl = (cj + 255) >> 8; if (j < e) off += tl * 256; if (j == e) ce = cj; }
            const int end = off + ((ce + 255) >> 8) * 256;
            for (int pos = off + ce + tid; pos < end; pos += NTHREADS) { perm[pos] = -1; rsp[pos] = 0.f; gp[pos] = 0.f; } }
    }
}

__device__ __forceinline__ void phase_final(ArgsP a, int vcu, int G, int lane, int wave) {
    const float* g = a->in[30]; const bf16* Y1 = (const bf16*)(a->ws + WS_Y1);
    const int gw = vcu * NWAVES + wave, NGW = G * NWAVES;
    f32x4 gv[4];
#pragma unroll
    for (int j = 0; j < 4; ++j) gv[j] = ((const f32x4*)g)[lane + 64 * j];
    for (int m0 = gw; m0 < T; m0 += 4 * NGW) {
        u32x2 xx[4][4], yy[4][4];
#pragma unroll
        for (int q4 = 0; q4 < 4; ++q4) { const int m = m0 + q4 * NGW; const u32x2* yr = (const u32x2*)(Y1 + (size_t)m * D) + lane; const u32x2* xbr = (const u32x2*)((const bf16*)(a->ws + WS_XB) + (size_t)m * D) + lane;
#pragma unroll
            for (int j = 0; j < 4; ++j) { xx[q4][j] = xbr[64 * j]; yy[q4][j] = yr[64 * j]; } }
#pragma unroll
        for (int q4 = 0; q4 < 4; ++q4) { const int m = m0 + q4 * NGW; f32x4* xr = (f32x4*)(a->out + (size_t)m * D) + lane; f32x4 v[4]; float ss = 0.f;
#pragma unroll
            for (int j = 0; j < 4; ++j) { v[j] = (f32x4){bf_lo(xx[q4][j].x) + bf_lo(yy[q4][j].x), bf_hi(xx[q4][j].x) + bf_hi(yy[q4][j].x), bf_lo(xx[q4][j].y) + bf_lo(yy[q4][j].y), bf_hi(xx[q4][j].y) + bf_hi(yy[q4][j].y)};
                ss += (v[j][0] * v[j][0] + v[j][1] * v[j][1]) + (v[j][2] * v[j][2] + v[j][3] * v[j][3]); }
            const float rstd = __builtin_amdgcn_rsqf(wave_sum(ss) * (1.0f / 1024.0f) + EPS);
#pragma unroll
            for (int j = 0; j < 4; ++j) xr[64 * j] = v[j] * rstd * gv[j]; }
    }
}

__global__ void __launch_bounds__(NTHREADS, 2) fwd_kernel(Args args_byval) {
    extern __shared__ __attribute__((aligned(16))) unsigned char lds_raw[];
    LAS unsigned char* lds = (LAS unsigned char*)lds_raw;
    const int wave = __builtin_amdgcn_readfirstlane((int)threadIdx.x >> 6);
    const int G = gridDim.x; const int bx = blockIdx.x; const int vcu = (G % 8 == 0) ? (bx % 8) * (G / 8) + bx / 8 : bx;
#define ARGS() ArgsP args = (ArgsP)__builtin_amdgcn_kernarg_segment_ptr(); asm volatile("" : "+s"(args)); unsigned char* ws = args->ws; f32x4* rowss = (f32x4*)(ws + WS_ROWSS); bf16* XB = (bf16*)(ws + WS_XB); (void)rowss; (void)XB
#define TID() (wave * 64 + lane_id())
    volatile LAS unsigned* MISC = (volatile LAS unsigned*)(lds + MISC_OFF);
    if (threadIdx.x < 64) MISC[threadIdx.x] = 0u;
    __syncthreads();
    int lo, hi; XcdBarrier bar;
    { ARGS(); lo = args->ph_lo; hi = args->ph_hi; bar.bar = (unsigned*)ws + CW_BAR; bar.x = 0; bar.st = nullptr;
      if (hi - lo > 1) bar = xcd_barrier_post((unsigned*)ws + CW_BAR, MISC + 8); }
    unsigned long long pr_acc = 0ull, pr_t0 = 0ull;
#define IN(k) (((PROBE_MASK >> (k)) & 1u) ? (pr_t0 = __builtin_amdgcn_s_memrealtime(), lo <= (k) && (k) < hi) : (lo <= (k) && (k) < hi))
#define SEAM(k) do { if (lo <= (k) && (k) + 1 < hi) xcd_barrier(bar); if ((PROBE_MASK >> (k)) & 1u) pr_acc += __builtin_amdgcn_s_memrealtime() - pr_t0; } while (0)
    constexpr float QSCALE = 0.0625f * 1.4426950408889634f;

    if (EN_PRO && IN(0)) { ARGS(); for (int rep = 0; rep < REP_PRO; ++rep) { int t2 = TID(); OPAQUE(t2); phase_prologue(args, lds, vcu, G, t2, t2 & 63, wave); __syncthreads(); } }
    SEAM(0);
#pragma unroll 1
    for (int l = 0; l < 2; ++l) {
        const int pb = 1 + 8 * l;
        if (EN_GEMM && EN_G1 && IN(pb)) { ARGS();
            if (EN_KV && l == 0 && bx >= 128) {
                if (bx < 192) { pg8::Gemm g{(const bf16*)(ws + WS_MEMB), (const bf16*)(ws + WS_WK), nullptr, MROWS, 2048, D}; pg8::StaticOrder S; S.init(MROWS, 2048, 64, bx - 128);
                    pg8::EpiRowScale<false> E{(bf16*)(ws + WS_KB), 2048, (const void*)(ws + OFF_MEMSS), 1.0f};
                    pg8::gemm_phase<pg8::EpiRowScale<false>, pg8::StaticOrder, true, false>(lds, g, S, E, wave); }
                else { pg8::Gemm g{(const bf16*)(ws + WS_WV), (const bf16*)(ws + WS_MEMB), nullptr, 2048, MROWS, D}; pg8::StaticOrder S; S.init(2048, MROWS, 64, bx - 192);
                    pg8::EpiColScale E{(bf16*)(ws + WS_VT), 2048, (const u64*)(ws + OFF_MEMSS)};
                    pg8::gemm_phase<pg8::EpiColScale, pg8::StaticOrder, true, false>(lds, g, S, E, wave); }
            }
            pg8::Gemm g{XB, (const bf16*)(ws + WS_WIN) + (size_t)l * DIN * D, nullptr, T, DIN, D, (const float*)(rowss + (size_t)(3 * l) * T)}; pg8::StaticOrder S; S.init(T, DIN, G, bx);
            pg8::EpiRowScale<false, true> E{(bf16*)(ws + WS_Z), DIN, nullptr, 1.0f};
            pg8::gemm_phase<pg8::EpiRowScale<false, true>, pg8::StaticOrder, true, false, false, 2>(lds, g, S, E, wave);
        }
        SEAM(pb);
        if (EN_MIX && IN(pb + 1)) { ARGS(); for (int rep = 0; rep < REP_MIX; ++rep) { int t2 = TID(); asm volatile("" : "+v"(t2)); for (int u = vcu; u < 256; u += G) mixer_unit(args, lds, l, u, t2, t2 & 63, wave); } }
        SEAM(pb + 1);
        if (EN_GEMM && EN_G2 && IN(pb + 2)) { ARGS();
            pg8::Gemm g{(const bf16*)(ws + WS_MIXED), (const bf16*)(ws + WS_WOUT) + (size_t)l * D * D, nullptr, T, D, D}; pg8::StaticOrder S; S.init(T, D, G, bx);
            pg8::EpiResid<false, true> E{XB, nullptr, (float*)(rowss + (size_t)(3 * l + 1) * T), 1.0f, nullptr};
            pg8::gemm_phase<pg8::EpiResid<false, true>, pg8::StaticOrder, true, false>(lds, g, S, E, wave);
        }
        SEAM(pb + 2);
        if (EN_GEMM && EN_G3 && IN(pb + 3)) { ARGS();
            pg8::Gemm g{XB, (const bf16*)(ws + WS_WQ) + (size_t)l * D * D, nullptr, T, D, D, (const float*)(rowss + (size_t)(3 * l + 1) * T)}; pg8::StaticOrder S; S.init(T, D, G, bx);
            pg8::EpiRowScale<false, true> E{(bf16*)(ws + WS_Q), D, nullptr, QSCALE};
            for (int rep = 0; rep < REP_Q; ++rep) pg8::gemm_phase<pg8::EpiRowScale<false, true>, pg8::StaticOrder, true, false, false, 2>(lds, g, S, E, wave);
        }
        SEAM(pb + 3);
        if (EN_ATT && IN(pb + 4)) { ARGS(); for (int rep = 0; rep < REP_ATT; ++rep) { int t2 = TID(); asm volatile("" : "+v"(t2)); attn_phase(args, lds, l, vcu, G, t2, wave); } }
        SEAM(pb + 4);
        if (EN_GEMM && EN_G2 && IN(pb + 5)) { ARGS();
            pg8::Gemm g{(const bf16*)(ws + WS_O), (const bf16*)(ws + WS_WO) + (size_t)l * D * D, nullptr, T, D, D}; pg8::StaticOrder S; S.init(T, D, G, bx);
            pg8::EpiResid<false, true> E{XB, l == 1 ? ws + WS_XB8 : nullptr, (float*)(rowss + (size_t)(3 * l + 2) * T), 1.0f, nullptr};
            pg8::gemm_phase<pg8::EpiResid<false, true>, pg8::StaticOrder, true, false>(lds, g, S, E, wave);
        }
        SEAM(pb + 5);
        if (l == 0) {
            if (EN_GEMM && EN_G4 && IN(7)) { ARGS();
                pg8::Gemm g{XB, (const bf16*)(ws + WS_WGU), nullptr, T, 2 * DFF, D, (const float*)(rowss + (size_t)2 * T)}; pg8::StaticOrder S; S.init(T, 2 * DFF, G, bx);
                pg8::EpiSwiglu<false, true> E{(bf16*)(ws + WS_H), DFF, nullptr};
                for (int rep = 0; rep < REP_UP; ++rep) pg8::gemm_phase<pg8::EpiSwiglu<false, true>, pg8::StaticOrder, true, false, false, 2>(lds, g, S, E, wave);
            }
            SEAM(7);
            if (EN_GEMM && EN_G2 && IN(8)) { ARGS();
                pg8::Gemm g{(const bf16*)(ws + WS_H), (const bf16*)(ws + WS_WD), nullptr, T, D, DFF}; pg8::StaticOrder S; S.init(T, D, G, bx);
                pg8::EpiResid<false, true> E{XB, nullptr, (float*)(rowss + (size_t)3 * T), 1.0f, nullptr};
                pg8::gemm_phase<pg8::EpiResid<false, true>, pg8::StaticOrder, true, false>(lds, g, S, E, wave);
            }
            SEAM(8);
        } else {
            if (EN_ROUTE && IN(15)) { ARGS(); int t2 = TID(); OPAQUE(t2); phase_router(args, lds, vcu, G, t2, t2 & 63, wave); }
            SEAM(15);
            if (EN_ROUTE && IN(16)) { ARGS(); int t2 = TID(); OPAQUE(t2); phase_lists(args, lds, vcu, G, t2); }
            SEAM(16);
            if (EN_MOE && EN_MUP && IN(17)) { ARGS();
                const int* perm = (const int*)(ws + WS_ROUTE + 4 * T * 4); const float* rsp = (const float*)(ws + WS_ROUTE + 4 * T * 4 + (size_t)PERMROWS * 4);
                pg8::MoeOrder S; S.G = G; S.c = bx; S.tp[0] = 0; S.nN = 2 * DFF / 256;
                const int* cnt = (const int*)(ws + OFF_MOECNT);
#pragma unroll
                for (int j = 0; j < 8; ++j) S.tp[j + 1] = S.tp[j] + ((__builtin_amdgcn_readfirstlane(cnt[j]) + 255) >> 8);
                pg8::Gemm g{(const bf16*)(ws + WS_XB8), (const bf16*)(ws + WS_MWGU), perm, T, 2 * DFF, D / 2, rsp};
                pg8::EpiSwiglu8 E{ws + WS_H, DFF, rsp};
                pg8::gemm_phase<pg8::EpiSwiglu8, pg8::MoeOrder, true, true, true, 1>(lds, g, S, E, wave);
            }
            SEAM(17);
            if (EN_MOE && EN_MDN && IN(18)) { ARGS();
                const int* perm = (const int*)(ws + WS_ROUTE + 4 * T * 4); const float* gp = (const float*)(ws + WS_ROUTE + 4 * T * 4 + 2 * (size_t)PERMROWS * 4);
                pg8::MoeOrder S; S.G = G; S.c = bx; S.tp[0] = 0; S.nN = D / 256;
                const int* cnt = (const int*)(ws + OFF_MOECNT);
#pragma unroll
                for (int j = 0; j < 8; ++j) S.tp[j + 1] = S.tp[j] + ((__builtin_amdgcn_readfirstlane(cnt[j]) + 255) >> 8);
                pg8::Gemm g{(const bf16*)(ws + WS_H), (const bf16*)(ws + WS_MWD), perm, T, D, DFF / 2, gp};
                pg8::EpiResid<true, false> E{XB, nullptr, nullptr, 1.0f / S8_DN, (bf16*)(ws + WS_Y1)};
                pg8::gemm_phase<pg8::EpiResid<true, false>, pg8::MoeOrder, true, false, true, 1>(lds, g, S, E, wave);
            }
            SEAM(18);
            if (IN(19)) { ARGS(); int t2 = TID(); OPAQUE(t2); phase_final(args, vcu, G, t2 & 63, wave); }
            SEAM(19);
            if (PROBE_K && IN(19)) { ARGS();
                pg8::Gemm g{XB, (const bf16*)(ws + WS_WGU), nullptr, T, 2048, PROBE_K}; pg8::StaticOrder S; S.init(T, 2048, G, bx);
                pg8::EpiRowScale<false> E{(bf16*)(ws + WS_ACT), 2048, rowss, 1.0f};
                pg8::gemm_phase<pg8::EpiRowScale<false>, pg8::StaticOrder, true, false>(lds, g, S, E, wave); }
        }
    }
    if (PROBE_MLO >= 0 && bx == PROBE_MWG) { const unsigned long long t0 = __builtin_amdgcn_s_memrealtime(), dl = MISC[40]; while (__builtin_amdgcn_s_memrealtime() - t0 < dl) __builtin_amdgcn_s_sleep(8); }
    if (PROBE_MASK && bx == 0) { const unsigned long long t0 = __builtin_amdgcn_s_memrealtime(); while (__builtin_amdgcn_s_memrealtime() - t0 < pr_acc) __builtin_amdgcn_s_sleep(8); }
#undef IN
#undef SEAM
}

extern "C" void kernel_launch(void* const* d_in, const int* in_sizes, int n_in, void* d_out, int out_size, void* d_ws, size_t ws_size, hipStream_t stream) {
    static int grid = 0;
    if (grid == 0) {
        if (n_in != 31 || in_sizes[0] != T * D || out_size != T * D || ws_size < WS_END) { fprintf(stderr, "kernel_launch: unexpected shapes (n_in %d, in0 %d, out %d, ws %zu)\n", n_in, n_in > 0 ? in_sizes[0] : -1, out_size, ws_size); grid = -1; return; }
        int dev = 0, cus = 0;
        if (hipGetDevice(&dev) != hipSuccess || hipDeviceGetAttribute(&cus, hipDeviceAttributeMultiprocessorCount, dev) != hipSuccess) { grid = -1; return; }
        if (hipFuncSetAttribute((const void*)fwd_kernel, hipFuncAttributeMaxDynamicSharedMemorySize, LDS_BYTES) != hipSuccess) { fprintf(stderr, "kernel_launch: hipFuncSetAttribute failed\n"); grid = -1; return; }
        int per_cu = 0;
        if (hipOccupancyMaxActiveBlocksPerMultiprocessor(&per_cu, (const void*)fwd_kernel, NTHREADS, LDS_BYTES) != hipSuccess || per_cu < 1) fprintf(stderr, "kernel_launch: occupancy query reports %d\n", per_cu);
        (void)hipGetLastError();
        if (cus < 256) { fprintf(stderr, "kernel_launch: built for a 256-CU device (found %d CUs)\n", cus); grid = -1; return; }
        grid = 256;
    }
    if (grid < 0) return;
    (void)hipMemsetAsync(d_ws, 0, CTL_ZERO_BYTES, stream);
    Args a{};
    for (int i = 0; i < 31; ++i) a.in[i] = (const float*)d_in[i];
    a.out = (float*)d_out; a.ws = (unsigned char*)d_ws;
#if MK_PER_PHASE
    for (int ph = 0; ph < NPH; ++ph) { a.ph_lo = ph; a.ph_hi = ph + 1; hipLaunchKernelGGL(fwd_kernel, dim3(grid), dim3(NTHREADS), LDS_BYTES, stream, a); }
#else
    a.ph_lo = 0; a.ph_hi = NPH; hipLaunchKernelGGL(fwd_kernel, dim3(grid), dim3(NTHREADS), LDS_BYTES, stream, a);
#endif
}
```

```cpp
#include <hip/hip_runtime.h>
#include <cstdio>
#include <cstdint>

#ifndef MK_PER_PHASE
#define MK_PER_PHASE 0
#endif

#ifndef EN_PRO
#define EN_PRO 1
#endif
#ifndef EN_GEMM
#define EN_GEMM 1
#endif
#ifndef EN_G1
#define EN_G1 1
#endif
#ifndef EN_G2
#define EN_G2 1
#endif
#ifndef EN_G3
#define EN_G3 1
#endif
#ifndef EN_G4
#define EN_G4 1
#endif
#ifndef EN_KV
#define EN_KV 1
#endif
#ifndef REP_PRO
#define REP_PRO 1
#endif
#ifndef REP_MIX
#define REP_MIX 1
#endif
#ifndef REP_ATT
#define REP_ATT 1
#endif
#ifndef REP_Q
#define REP_Q 1
#endif
#ifndef REP_UP
#define REP_UP 1
#endif
#ifndef EN_MUP
#define EN_MUP 1
#endif
#ifndef EN_MDN
#define EN_MDN 1
#endif
#ifndef PROBE_MASK
#define ATT_QPRE 1
#define PROBE_MLO -1
#define PROBE_MHI -1
#define PROBE_MWG 100
#define MSEC(k) do { if (PROBE_MLO >= 0 && blockIdx.x == PROBE_MWG && threadIdx.x == 0) { volatile LAS unsigned* _m = (volatile LAS unsigned*)(lds + MISC_OFF) + 40; const unsigned _t = (unsigned)__builtin_amdgcn_s_memrealtime(); if ((k) == PROBE_MLO) *_m -= _t; if ((k) == PROBE_MHI) *_m += _t; } } while (0)
#define PROBE_MASK 0u
#endif
#ifndef PROBE_K
#define PROBE_K 0
#endif
#ifndef STAG_TICKS
#define STAG_TICKS 0
#endif
#ifndef EN_MIX
#define EN_MIX 1
#endif
#ifndef EN_ATT
#define EN_ATT 1
#endif
#ifndef EN_MOE
#define EN_MOE 1
#endif
#ifndef EN_ROUTE
#define EN_ROUTE 1
#endif
#define LAS __attribute__((address_space(3)))
#define GAS __attribute__((address_space(1)))
typedef unsigned short bf16;
typedef short bf16x8 __attribute__((ext_vector_type(8)));
typedef float f32x2 __attribute__((ext_vector_type(2)));
typedef float f32x4 __attribute__((ext_vector_type(4)));
typedef float f32x16 __attribute__((ext_vector_type(16)));
typedef unsigned u32x2 __attribute__((ext_vector_type(2)));
typedef unsigned u32x4 __attribute__((ext_vector_type(4)));
typedef __bf16 bf16x2_t __attribute__((ext_vector_type(2)));
typedef int i32x4 __attribute__((ext_vector_type(4)));
typedef int i32x8 __attribute__((ext_vector_type(8)));
typedef unsigned long long u64;
typedef unsigned long long u64x2 __attribute__((ext_vector_type(2)));

constexpr int NB = 8, SEQ = 4096, D = 1024, T = NB * SEQ, DIN = 1792, DFF = 2816, NE = 8, MEMLEN = 256, MROWS = NB * MEMLEN;
constexpr float EPS = 1e-6f;
constexpr float S8_UP = 32.0f, S8_DN = 64.0f;
constexpr int NWAVES = 8, NTHREADS = 512;
constexpr int NPH = 20;

constexpr size_t MiB = 1u << 20;
constexpr size_t CTL_ZERO_BYTES = 64 * 1024;
constexpr int CW_BAR = 4096;
constexpr size_t WS_ROWSS = 124 * MiB;
constexpr size_t OFF_MOECNT = 32 * 1024;
constexpr size_t OFF_MEMSS = 40 * 1024;
constexpr size_t WS_WIN = 2 * MiB;
constexpr size_t WS_WOUT = 9 * MiB;
constexpr size_t WS_WQ = 13 * MiB;
constexpr size_t WS_WO = 17 * MiB;
constexpr size_t WS_WK = 21 * MiB;
constexpr size_t WS_WV = 25 * MiB;
constexpr size_t WS_WGU = 29 * MiB;
constexpr size_t WS_WD = 40 * MiB;
constexpr size_t WS_MWGU = 46 * MiB;
constexpr size_t WS_MWD = 134 * MiB;
constexpr size_t WS_SGUW = 178 * MiB;
constexpr size_t WS_POOLW = 178 * MiB + 512 * 1024;
constexpr size_t WS_XB = 180 * MiB;
constexpr size_t WS_MEMB = 244 * MiB;
constexpr size_t WS_KB = 248 * MiB;
constexpr size_t WS_VT = 256 * MiB;
constexpr size_t WS_ROUTE = 264 * MiB;
constexpr int PERMROWS = 264 * 256;
constexpr size_t WS_Y1 = 448 * MiB;
constexpr size_t WS_XB8 = 90 * MiB;
constexpr size_t WS_ACT = 266 * MiB;
constexpr size_t WS_Z = WS_ACT;
constexpr size_t WS_MIXED = WS_ACT + 112 * MiB;
constexpr size_t WS_Q = WS_ACT;
constexpr size_t WS_O = WS_ACT + 64 * MiB;
constexpr size_t WS_H = WS_ACT;
constexpr size_t WS_END = 512 * MiB;
static_assert(WS_H + (size_t)PERMROWS * DFF <= WS_Y1 && WS_Y1 + (size_t)T * D * 2 <= WS_END && WS_MWGU + (size_t)NE * 2 * DFF * D <= WS_XB8 && WS_XB8 + (size_t)T * D <= WS_ROWSS && WS_ROWSS + 7 * (size_t)T * 16 <= WS_MWD && WS_ROUTE + 4 * (size_t)T * 4 + 3 * (size_t)PERMROWS * 4 + 8192 <= WS_ACT, "ws map");

constexpr int LDS_BYTES = 160 * 1024;
constexpr int MISC_OFF = LDS_BYTES - 256;

__device__ __forceinline__ float bf_lo(unsigned v) { return __uint_as_float(v << 16); }
__device__ __forceinline__ float bf_hi(unsigned v) { return __uint_as_float(v & 0xffff0000u); }
__device__ __forceinline__ unsigned pk_bf16(float lo, float hi) { f32x2 v = {lo, hi}; bf16x2_t b = __builtin_convertvector(v, bf16x2_t); return __builtin_bit_cast(unsigned, b); }
__device__ __forceinline__ unsigned pk_bf16_v(float lo, float hi) { unsigned r; asm volatile("v_cvt_pk_bf16_f32 %0, %1, %2" : "=v"(r) : "v"(lo), "v"(hi)); return r; }
__device__ __forceinline__ bf16 f2bf(float f) { return (bf16)(pk_bf16(f, 0.f) & 0xffffu); }
__device__ __forceinline__ float sigm(float x) { return __builtin_amdgcn_rcpf(1.0f + __expf(-x)); }
__device__ __forceinline__ float silu_f(float x) { return x * sigm(x); }
__device__ __forceinline__ float gelu_tanh(float x) { const float t = x * __builtin_fmaf(x * x, -0.10294324f, -2.3022082f); return x * __builtin_amdgcn_rcpf(1.0f + __builtin_amdgcn_exp2f(t)); }
constexpr float SS_FIX = 16777216.0f;
__device__ __forceinline__ u64 ss_to_fix(float ss) { return (u64)(ss * SS_FIX); }
__device__ __forceinline__ float rstd_ss(u64 ssf) { return __builtin_amdgcn_rsqf((float)ssf * (1.0f / (1024.0f * SS_FIX)) + EPS); }
__device__ __forceinline__ float rstd4(f32x4 p) { return __builtin_amdgcn_rsqf(((p[0] + p[1]) + (p[2] + p[3])) * (1.0f / 1024.0f) + EPS); }
__device__ __forceinline__ unsigned pk_fp8x4(float a, float b, float c, float d) { int p = __builtin_amdgcn_cvt_pk_fp8_f32(a, b, 0, false); p = __builtin_amdgcn_cvt_pk_fp8_f32(c, d, p, true); return (unsigned)p; }
__device__ __forceinline__ int lane_id() { int l; asm volatile("v_mbcnt_lo_u32_b32 %0, -1, 0\n\tv_mbcnt_hi_u32_b32 %0, -1, %0" : "=v"(l)); return l; }
__device__ __forceinline__ float shfl_xor_f(float v, int mask) { const int idx = (lane_id() ^ mask) << 2; return __builtin_bit_cast(float, __builtin_amdgcn_ds_bpermute(idx, __builtin_bit_cast(int, v))); }
#define OPAQUE(x) asm volatile("" : "+v"(x))
__device__ __forceinline__ void st16_wt(void* p, u32x4 v) { asm volatile("global_store_dwordx4 %0, %1, off sc1\n\ts_nop 2" : : "v"(p), "v"(v) : "memory"); }
__device__ __forceinline__ void st8_wt(void* p, u32x2 v) { asm volatile("global_store_dwordx2 %0, %1, off sc1\n\ts_nop 2" : : "v"(p), "v"(v) : "memory"); }
template <int CTRL> __device__ __forceinline__ float dpp_f(float v) { return __builtin_bit_cast(float, __builtin_amdgcn_update_dpp(0, __builtin_bit_cast(int, v), CTRL, 0xf, 0xf, true)); }
__device__ __forceinline__ float row16_sum(float v) { v += dpp_f<0xB1>(v); v += dpp_f<0x4E>(v); v += dpp_f<0x141>(v); v += dpp_f<0x140>(v); return v; }
__device__ __forceinline__ float wave_sum(float v) { v = row16_sum(v); v += shfl_xor_f(v, 16); v += shfl_xor_f(v, 32); return v; }

namespace pg8 {
__device__ __forceinline__ void glds_s(const void* sbase, unsigned voff, unsigned lds_dst) {
    asm volatile("s_mov_b32 m0, %2\n\ts_nop 0\n\tglobal_load_lds_dwordx4 %0, %1" : : "v"(voff), "s"(sbase), "s"(lds_dst) : "memory", "m0");
}
constexpr int BM = 256, BK = 64, HALF = 128, HTB = HALF * BK * 2, STAGE_BYTES = 8 * HTB, NXCD = 8, WGM = 8;
__host__ __device__ __forceinline__ int lds_byte(int r, int c) { const int st = (r >> 4) * 2 + (c >> 5), rr = r & 15, cc = c & 31, ob = rr * 64 + cc * 2; return st * 1024 + (ob ^ (((ob >> 9) & 1) << 5)); }
__host__ __device__ __forceinline__ void stage_rc(int b, int& R, int& C) { const int st = b / 1024, sb = b % 1024, swz = sb ^ (((sb >> 9) & 1) << 5); R = (st >> 1) * 16 + swz / 64; C = (st & 1) * 32 + (swz % 64) / 2; }
__host__ __device__ __forceinline__ int perm32(int rho) { const int n = rho >> 4, i = rho & 15; return 8 * (i >> 2) + 4 * n + (i & 3); }

struct Unit { int pm, pn, brow; };
struct Gemm { const bf16* A; const bf16* Bt; const int* perm; int M, N, K; const float* aux = nullptr; };

struct StaticOrder {
    int nM, nN, nwg, G, c;
    __device__ void init(int M, int N, int G_, int c_) { nM = M / BM; nN = N / BM; nwg = nM * nN; G = G_; c = c_; }
    __device__ bool next(int i, Unit& u) const {
        const long L = (long)i * G + c; if (L >= nwg) return false;
        int wgid = (int)L; { const int q = nwg / NXCD, r = nwg % NXCD, xcd = wgid % NXCD, off = wgid / NXCD; wgid = (xcd < r ? xcd * (q + 1) : r * (q + 1) + (xcd - r) * q) + off; }
        const int nig = WGM * nN, gid = wgid / nig, fm = gid * WGM, gsz = (nM - fm) < WGM ? (nM - fm) : WGM;
        u.pm = fm + ((wgid % nig) % gsz); u.pn = (wgid % nig) / gsz; u.brow = u.pn; return true;
    }
};
struct MoeOrder {
    int nN, G, c; int tp[9];
    __device__ bool next(int i, Unit& u) const {
        const int L = i * G + c; if (L >= tp[8] * nN) return false;
        int e = 0;
#pragma unroll
        for (int j = 1; j < 8; ++j) e += (L >= tp[j] * nN) ? 1 : 0;
        int base = 0, nx = 0;
#pragma unroll
        for (int j = 0; j < 8; ++j) if (e == j) { base = tp[j]; nx = tp[j + 1]; }
        const int te = nx - base, Lp = L - base * nN; u.pn = Lp / te; u.pm = base + Lp % te; u.brow = e * nN + u.pn; return true;
    }
};

typedef f32x4 Acc[2][2][4][2];

constexpr int EPI_R0 = 3 * HTB, EPI_R1 = STAGE_BYTES;
constexpr int SLOT_OFF = STAGE_BYTES + 16384, SLOT_BYTES = 4096;
__device__ __forceinline__ void glds4_s(const void* sbase, unsigned voff, unsigned lds_dst) {
    asm volatile("s_mov_b32 m0, %2\n\ts_nop 0\n\tglobal_load_lds_dword %0, %1" : : "v"(voff), "s"(sbase), "s"(lds_dst) : "memory", "m0");
}
#define EPI_BAR() do { asm volatile("s_waitcnt lgkmcnt(0)" ::: "memory"); __builtin_amdgcn_s_barrier(); asm volatile("" ::: "memory"); } while (0)

template <bool DIRECT, bool SLOT = false> struct EpiRowScale {
    static constexpr bool PERM = true;
    bf16* O; int ldc; const void* rs; float cst;
    __device__ __forceinline__ void operator()(const Acc& acc, const Unit& u, int wr, int wc, LAS unsigned char* lds, int ui) const {
        const int ln = lane_id(), fr = ln & 15, fq = ln >> 4;
        const int row0 = u.pm * BM + wr * 64 + fr;
        float sc[2][4];
        if (DIRECT) {
#pragma unroll
            for (int ai = 0; ai < 2; ++ai)
#pragma unroll
                for (int m = 0; m < 4; ++m) sc[ai][m] = ((const float*)rs)[row0 + ai * HALF + m * 16] * cst;
        } else if (SLOT) { f32x4 sv[2][4];
#pragma unroll
            for (int ai = 0; ai < 2; ++ai)
#pragma unroll
                for (int m = 0; m < 4; ++m) sv[ai][m] = ((const LAS f32x4*)(lds + SLOT_OFF + (ui & 1) * SLOT_BYTES))[wr * 64 + fr + ai * HALF + m * 16];
#pragma unroll
            for (int ai = 0; ai < 2; ++ai)
#pragma unroll
                for (int m = 0; m < 4; ++m) sc[ai][m] = rstd4(sv[ai][m]) * cst;
        } else { u64 sv[2][4];
#pragma unroll
            for (int ai = 0; ai < 2; ++ai)
#pragma unroll
                for (int m = 0; m < 4; ++m) sv[ai][m] = ((const u64*)rs)[row0 + ai * HALF + m * 16];
#pragma unroll
            for (int ai = 0; ai < 2; ++ai)
#pragma unroll
                for (int m = 0; m < 4; ++m) sc[ai][m] = rstd_ss(sv[ai][m]) * cst; }
        LAS unsigned char* reg = lds + (wr ? EPI_R1 : EPI_R0);
#pragma unroll
        for (int ai = 0; ai < 2; ++ai)
#pragma unroll
            for (int mh = 0; mh < 2; ++mh) {
#pragma unroll
                for (int mm = 0; mm < 2; ++mm) { const int m = 2 * mh + mm, lr = mm * 16 + fr; const float s1 = sc[ai][m];
#pragma unroll
                    for (int bj = 0; bj < 2; ++bj) { const f32x4 v0 = acc[ai][bj][m][0] * s1, v1 = acc[ai][bj][m][1] * s1;
                        u32x4 w; w.x = pk_bf16(v0[0], v0[1]); w.y = pk_bf16(v0[2], v0[3]); w.z = pk_bf16(v1[0], v1[1]); w.w = pk_bf16(v1[2], v1[3]);
                        *(LAS u32x4*)(reg + lr * 512 + (((bj * 16 + wc * 4 + fq) ^ (lr & 7)) * 16)) = w; } }
                EPI_BAR();
                bf16* ob = O + (size_t)(u.pm * BM + ai * HALF + wr * 64 + mh * 32) * ldc + u.pn * BM;
#pragma unroll
                for (int j = 0; j < 4; ++j) { const int lr = wc * 8 + 2 * j + (ln >> 5), c = ln & 31;
                    const u32x4 w = *(const LAS u32x4*)(reg + lr * 512 + ((c ^ (lr & 7)) * 16));
                    st16_wt(ob + (size_t)lr * ldc + c * 8, w); }
                EPI_BAR();
            }
    }
};
struct EpiColScale {
    static constexpr bool PERM = true;
    bf16* O; int ldc; const u64* css;
    __device__ __forceinline__ void operator()(const Acc& acc, const Unit& u, int wr, int wc, LAS unsigned char* lds, int ui) const {
        const int ln = lane_id(), fr = ln & 15, fq = ln >> 4;
        const int row0 = u.pm * BM + wr * 64 + fr, col0 = u.pn * BM + wc * 32 + 8 * fq;
#pragma unroll
        for (int bj = 0; bj < 2; ++bj) {
            const u64* cp = css + col0 + bj * HALF;
            const f32x4 c0 = (f32x4){rstd_ss(cp[0]), rstd_ss(cp[1]), rstd_ss(cp[2]), rstd_ss(cp[3])}, c1 = (f32x4){rstd_ss(cp[4]), rstd_ss(cp[5]), rstd_ss(cp[6]), rstd_ss(cp[7])};
#pragma unroll
            for (int ai = 0; ai < 2; ++ai)
#pragma unroll
                for (int m = 0; m < 4; ++m) { bf16* rowp = O + (size_t)(row0 + ai * HALF + m * 16) * ldc + ((col0 + bj * HALF) & ~15) + 4 * (fq & 1);
                    const f32x4 v0 = acc[ai][bj][m][0] * c0, v1 = acc[ai][bj][m][1] * c1;
                    u32x2 wa, wb; wa.x = pk_bf16(v0[0], v0[1]); wa.y = pk_bf16(v0[2], v0[3]); wb.x = pk_bf16(v1[0], v1[1]); wb.y = pk_bf16(v1[2], v1[3]);
                    *(u32x2*)rowp = wa; *(u32x2*)(rowp + 8) = wb; }
            asm volatile("" ::: "memory"); }
    }
};
template <bool DIRECT, bool SLOT = false> struct EpiSwiglu {
    static constexpr bool PERM = true;
    bf16* O; int ldc; const void* rs;
    __device__ __forceinline__ void operator()(const Acc& acc, const Unit& u, int wr, int wc, LAS unsigned char* lds, int ui) const {
        const int ln = lane_id(), fr = ln & 15, fq = ln >> 4;
        const int row0 = u.pm * BM + wr * 64 + fr;
        float sc[2][4];
        if (DIRECT) {
#pragma unroll
            for (int ai = 0; ai < 2; ++ai)
#pragma unroll
                for (int m = 0; m < 4; ++m) sc[ai][m] = ((const float*)rs)[row0 + ai * HALF + m * 16];
        } else { f32x4 sv[2][4];
#pragma unroll
            for (int ai = 0; ai < 2; ++ai)
#pragma unroll
                for (int m = 0; m < 4; ++m) sv[ai][m] = SLOT ? ((const LAS f32x4*)(lds + SLOT_OFF + (ui & 1) * SLOT_BYTES))[wr * 64 + fr + ai * HALF + m * 16] : ((const f32x4*)rs)[row0 + ai * HALF + m * 16];
#pragma unroll
            for (int ai = 0; ai < 2; ++ai)
#pragma unroll
                for (int m = 0; m < 4; ++m) sc[ai][m] = rstd4(sv[ai][m]); }
        LAS unsigned char* reg = lds + (wr ? EPI_R1 : EPI_R0);
#pragma unroll
        for (int ai = 0; ai < 2; ++ai) {
#pragma unroll
            for (int m = 0; m < 4; ++m) { const int lr = m * 16 + fr; const float s1 = sc[ai][m], s2 = s1 * s1, sneg = s1 * -1.4426950408889634f;
                u32x4 w;
#pragma unroll
                for (int n = 0; n < 2; ++n) { const f32x4 a = acc[ai][0][m][n], b = acc[ai][1][m][n];
                    const f32x4 p = (a * b) * s2, t = a * sneg;
                    const f32x4 o = (f32x4){p[0] * __builtin_amdgcn_rcpf(1.0f + __builtin_amdgcn_exp2f(t[0])), p[1] * __builtin_amdgcn_rcpf(1.0f + __builtin_amdgcn_exp2f(t[1])),
                                            p[2] * __builtin_amdgcn_rcpf(1.0f + __builtin_amdgcn_exp2f(t[2])), p[3] * __builtin_amdgcn_rcpf(1.0f + __builtin_amdgcn_exp2f(t[3]))};
                    w[2 * n] = pk_bf16(o[0], o[1]); w[2 * n + 1] = pk_bf16(o[2], o[3]); }
                *(LAS u32x4*)(reg + lr * 256 + (((wc * 4 + fq) ^ (lr & 7)) * 16)) = w; }
            EPI_BAR();
            bf16* ob = O + (size_t)(u.pm * BM + ai * HALF + wr * 64) * ldc + u.pn * HALF;
#pragma unroll
            for (int j = 0; j < 4; ++j) { const int lr = wc * 16 + 4 * j + (ln >> 4), c = ln & 15;
                const u32x4 w = *(const LAS u32x4*)(reg + lr * 256 + ((c ^ (lr & 7)) * 16));
                __builtin_nontemporal_store(w, (u32x4*)(ob + (size_t)lr * ldc + c * 8)); }
            EPI_BAR();
        }
    }
};
struct EpiSwiglu8 {
    static constexpr bool PERM = true;
    unsigned char* O; int ldc; const float* rs;
    __device__ __forceinline__ void operator()(const Acc& acc, const Unit& u, int wr, int wc, LAS unsigned char* lds, int ui) const {
        const int ln = lane_id(), fr = ln & 15, fq = ln >> 4;
        const int row0 = u.pm * BM + wr * 64 + fr;
        float sc[2][4];
#pragma unroll
        for (int ai = 0; ai < 2; ++ai)
#pragma unroll
            for (int m = 0; m < 4; ++m) sc[ai][m] = ((const LAS float*)(lds + SLOT_OFF + (ui & 1) * SLOT_BYTES + 1024))[wr * 64 + fr + ai * HALF + m * 16] * (1.0f / S8_UP);
        (void)row0;
        LAS unsigned char* reg = lds + (wr ? EPI_R1 : EPI_R0);
#pragma unroll
        for (int ai = 0; ai < 2; ++ai) {
#pragma unroll
            for (int m = 0; m < 4; ++m) { const int lr = ai * 64 + m * 16 + fr; const float s1 = sc[ai][m], s2 = s1 * s1, sneg = s1 * -1.4426950408889634f;
                u32x2 w;
#pragma unroll
                for (int n = 0; n < 2; ++n) { const f32x4 a = acc[ai][0][m][n], b = acc[ai][1][m][n];
                    const f32x4 p = (a * b) * s2, t = a * sneg;
                    w[n] = pk_fp8x4(p[0] * __builtin_amdgcn_rcpf(1.0f + __builtin_amdgcn_exp2f(t[0])), p[1] * __builtin_amdgcn_rcpf(1.0f + __builtin_amdgcn_exp2f(t[1])),
                                    p[2] * __builtin_amdgcn_rcpf(1.0f + __builtin_amdgcn_exp2f(t[2])), p[3] * __builtin_amdgcn_rcpf(1.0f + __builtin_amdgcn_exp2f(t[3]))); }
                const int c8 = wc * 4 + fq;
                *(LAS u32x2*)(reg + lr * 128 + ((((c8 >> 1) ^ (lr & 7)) * 16) + (c8 & 1) * 8)) = w; } }
        EPI_BAR();
#pragma unroll
        for (int j = 0; j < 4; ++j) { const int lr = wc * 32 + 8 * j + (ln >> 3), c = ln & 7;
            const u32x4 w = *(const LAS u32x4*)(reg + lr * 128 + ((c ^ (lr & 7)) * 16));
            unsigned char* ob = O + (size_t)(u.pm * BM + (lr >> 6) * HALF + wr * 64 + (lr & 63)) * ldc + u.pn * HALF;
            __builtin_nontemporal_store(w, (u32x4*)(ob + c * 16)); }
        EPI_BAR();
    }
};
template <bool SCATTER, bool ACC_SS> struct EpiResid {
    static constexpr bool PERM = true;
    bf16* X; unsigned char* X8; float* ss_out; float gscale; bf16* Y1;
    __device__ __forceinline__ void operator()(const Acc& acc, const Unit& u, int wr, int wc, LAS unsigned char* lds, int ui) const {
        static_assert(!(ACC_SS && SCATTER), "dense rows only");
        const int ln = lane_id(), fr = ln & 15, fq = ln >> 4;
        LAS unsigned char* reg = lds + (wr ? EPI_R1 : EPI_R0);
        const LAS int* sl = (const LAS int*)(lds + SLOT_OFF + (ui & 1) * SLOT_BYTES);
        const int colb = u.pn * BM;
#pragma unroll
        for (int ai = 0; ai < 2; ++ai) {
            u32x4 xv[4][2]; float gate[4];
#pragma unroll
            for (int m = 0; m < 4; ++m) { const int rl = ai * HALF + wr * 64 + m * 16 + fr; int row; bool take = true;
                if (SCATTER) { row = sl[rl]; gate[m] = ((const LAS float*)sl)[256 + rl] * gscale; take = (unsigned)row < 65536u; }
                else { row = u.pm * BM + rl; gate[m] = 1.0f; }
                const bf16* xp = X + (size_t)(take ? row : 0) * D + colb + wc * 32 + fq * 8;
#pragma unroll
                for (int bj = 0; bj < 2; ++bj) { if (take) xv[m][bj] = *(const u32x4*)(xp + bj * HALF); else xv[m][bj] = (u32x4){0u, 0u, 0u, 0u}; } }
#pragma unroll
            for (int mh = 0; mh < 2; ++mh) {
#pragma unroll
                for (int mm = 0; mm < 2; ++mm) { const int m = 2 * mh + mm, lr = mm * 16 + fr; const float gt = gate[m];
#pragma unroll
                    for (int bj = 0; bj < 2; ++bj) { const f32x4 a0 = acc[ai][bj][m][0], a1 = acc[ai][bj][m][1]; const u32x4 x = xv[m][bj];
                        u32x4 w; w.x = pk_bf16(bf_lo(x.x) + a0[0] * gt, bf_hi(x.x) + a0[1] * gt); w.y = pk_bf16(bf_lo(x.y) + a0[2] * gt, bf_hi(x.y) + a0[3] * gt);
                        w.z = pk_bf16(bf_lo(x.z) + a1[0] * gt, bf_hi(x.z) + a1[1] * gt); w.w = pk_bf16(bf_lo(x.w) + a1[2] * gt, bf_hi(x.w) + a1[3] * gt);
                        *(LAS u32x4*)(reg + lr * 512 + (((bj * 16 + wc * 4 + fq) ^ (lr & 7)) * 16)) = w; } }
                EPI_BAR();
#pragma unroll
                for (int j = 0; j < 4; ++j) { const int lr = wc * 8 + 2 * j + (ln >> 5), c = ln & 31, rl = ai * HALF + wr * 64 + mh * 32 + lr;
                    const u32x4 w = *(const LAS u32x4*)(reg + lr * 512 + ((c ^ (lr & 7)) * 16));
                    if (SCATTER) { const int re = sl[rl];
                        if (re >= 0) { bf16* dst = (re >= 65536 ? Y1 : X) + (size_t)(re & 65535) * D + colb + c * 8; st16_wt(dst, w); } }
                    else { const size_t row = (size_t)(u.pm * BM + rl);
                        st16_wt(X + row * D + colb + c * 8, w);
                        if (X8) { u32x2 q; q.x = pk_fp8x4(bf_lo(w.x), bf_hi(w.x), bf_lo(w.y), bf_hi(w.y)); q.y = pk_fp8x4(bf_lo(w.z), bf_hi(w.z), bf_lo(w.w), bf_hi(w.w)); st8_wt(X8 + row * D + colb + c * 8, q); }
                        if (ACC_SS) { const float r0 = bf_lo(w.x), r1 = bf_hi(w.x), r2 = bf_lo(w.y), r3 = bf_hi(w.y), r4 = bf_lo(w.z), r5 = bf_hi(w.z), r6 = bf_lo(w.w), r7 = bf_hi(w.w);
                            float ss = ((r0 * r0 + r1 * r1) + (r2 * r2 + r3 * r3)) + ((r4 * r4 + r5 * r5) + (r6 * r6 + r7 * r7));
                            ss = row16_sum(ss); ss += shfl_xor_f(ss, 16);
                            if (c == 0) ss_out[row * 4 + u.pn] = ss; } } }
                EPI_BAR();
            }
        }
    }
};

__device__ __forceinline__ void load_offs(const Gemm& g, const Unit& u, const int (&Rr)[2], const int (&Cc)[2], unsigned (&o)[2][2]) {
#pragma unroll
    for (int h = 0; h < 2; ++h)
#pragma unroll
        for (int i = 0; i < 2; ++i) { int row = g.perm[u.pm * BM + h * HALF + Rr[i]]; row = row < 0 ? 0 : (row & 65535); o[h][i] = (unsigned)(row * g.K + Cc[i]) * 2u; }
}

template <class Epi, class Sched, bool ALIGN_EPI, bool GATHER, bool FP8 = false, int SLOTS = 0>
__device__ __forceinline__ void gemm_phase(LAS unsigned char* lds, const Gemm g, const Sched& S, const Epi& E, int wave_id) {
    int tid_ = wave_id * 64 + lane_id(); asm volatile("" : "+v"(tid_));
    const int tid = tid_, wid = __builtin_amdgcn_readfirstlane(tid >> 6), lane = tid & 63, wr = wid >> 2, wc = wid & 3, fr = lane & 15, fq = lane >> 4;
    const int K = g.K, nt = K / BK;
    int Rr[2], Cc[2]; unsigned voffA[2], voffB[2];
#pragma unroll
    for (int i = 0; i < 2; ++i) { int R, C; stage_rc(tid * 16 + i * 8192, R, C); Rr[i] = R; Cc[i] = C; const int Rb = Epi::PERM ? ((R & ~31) + perm32(R & 31)) : R;
        voffA[i] = (unsigned)(R * K + C) * 2u; voffB[i] = (unsigned)(Rb * K + C) * 2u; }
    const size_t kstep = (size_t)(BK * 2);
    const size_t hstep = (size_t)HALF * K * 2;
    const size_t tstep = 2 * hstep;
    const unsigned ldsw = (unsigned)wid * 1024u, ldsbase = (unsigned)(size_t)lds;
    const int aoff = lds_byte(wr * 64 + fr, fq * 8), boff = lds_byte(wc * 32 + fr, fq * 8);
#define PG8_SA(b, h) (((b) * 2 + (h)) * HTB)
#define PG8_SB(b, h) ((4 + (b) * 2 + (h)) * HTB)
#define PG8_STAGE(bufoff, gbase, voff) do { _Pragma("unroll") for (int _i = 0; _i < 2; ++_i) glds_s((const void*)(gbase), (voff)[_i], ldsbase + (unsigned)(bufoff) + ldsw + _i * 8192u); } while (0)
#define PG8_STAGE_A(bufoff, gbase, h) do { if constexpr (GATHER) PG8_STAGE(bufoff, gbase, offA[h]); else PG8_STAGE(bufoff, (gbase) + (h) * hstep, voffA); } while (0)
#define PG8_LDA(dst, b, h) do { _Pragma("unroll") for (int m = 0; m < 4; ++m) _Pragma("unroll") for (int k = 0; k < 2; ++k) dst[m][k] = *(const LAS bf16x8*)(lds + PG8_SA(b, h) + aoff + m * 2048 + k * 1024); } while (0)
#define PG8_LDB(dst, b, h) do { _Pragma("unroll") for (int n = 0; n < 2; ++n) _Pragma("unroll") for (int k = 0; k < 2; ++k) dst[n][k] = *(const LAS bf16x8*)(lds + PG8_SB(b, h) + boff + n * 2048 + k * 1024); } while (0)
#define PG8_CAT8(x) __builtin_shufflevector(__builtin_bit_cast(i32x4, (x)[0]), __builtin_bit_cast(i32x4, (x)[1]), 0, 1, 2, 3, 4, 5, 6, 7)
#define PG8_MMA(ai, bj, At, Bt) do { __builtin_amdgcn_s_setprio(1); \
        if constexpr (FP8) { _Pragma("unroll") for (int m = 0; m < 4; ++m) _Pragma("unroll") for (int n = 0; n < 2; ++n) \
            acc[ai][bj][m][n] = __builtin_amdgcn_mfma_scale_f32_16x16x128_f8f6f4(PG8_CAT8(Bt[n]), PG8_CAT8(At[m]), acc[ai][bj][m][n], 0, 0, 0, 0x7F7F7F7F, 0, 0x7F7F7F7F); } \
        else { _Pragma("unroll") for (int m = 0; m < 4; ++m) _Pragma("unroll") for (int n = 0; n < 2; ++n) _Pragma("unroll") for (int k = 0; k < 2; ++k) \
            acc[ai][bj][m][n] = __builtin_amdgcn_mfma_f32_16x16x32_bf16(Bt[n][k], At[m][k], acc[ai][bj][m][n], 0, 0, 0); } \
        __builtin_amdgcn_s_setprio(0); } while (0)
#define PG8_WAIT_V(n) asm volatile("s_waitcnt vmcnt(" #n ")" ::: "memory")
#define PG8_WAIT_L(n) asm volatile("s_waitcnt lgkmcnt(" #n ")" ::: "memory")
#define PG8_BAR __builtin_amdgcn_s_barrier()
#define PG8_SCHED __builtin_amdgcn_sched_barrier(0)
    Unit cur, nxt; int ui = 0;
    if (!S.next(0, cur)) return;
    if (STAG_TICKS) { const unsigned long long dly = (unsigned long long)((blockIdx.x >> 3) & 3) * STAG_TICKS, t0 = __builtin_amdgcn_s_memrealtime(); while (__builtin_amdgcn_s_memrealtime() - t0 < dly) __builtin_amdgcn_s_sleep(8); }
    Acc acc;
#pragma unroll
    for (int a = 0; a < 2; ++a)
#pragma unroll
        for (int b = 0; b < 2; ++b)
#pragma unroll
            for (int m = 0; m < 4; ++m)
#pragma unroll
                for (int n = 0; n < 2; ++n) acc[a][b][m][n] = (f32x4){0.f, 0.f, 0.f, 0.f};
    bf16x8 At[4][2], B0[2][2], B1[2][2];
    unsigned offA[2][2], offN[2][2];
#define PG8_SLOT_DMA(unit, par) do { if constexpr (SLOTS == 2) {   \
            if (wid < 4) glds_s((const void*)((const char*)g.aux + (size_t)(unit).pm * (BM * 16) + wid * 1024), (unsigned)lane_id() * 16u, ldsbase + SLOT_OFF + (par) * SLOT_BYTES + wid * 1024); } \
        else { const void* _b = wid < 4 ? (const void*)(g.perm + (unit).pm * BM + (wid & 3) * 64) : (const void*)(g.aux + (unit).pm * BM + (wid & 3) * 64); \
            glds4_s(_b, (unsigned)lane_id() * 4u, ldsbase + SLOT_OFF + (par) * SLOT_BYTES + wid * 256); } } while (0)
#define PG8_SLOT_OFFS(par, o) do { const LAS int* _sl = (const LAS int*)(lds + SLOT_OFF + (par) * SLOT_BYTES); _Pragma("unroll") for (int _h = 0; _h < 2; ++_h) _Pragma("unroll") for (int _i = 0; _i < 2; ++_i) { \
        int _r = _sl[_h * HALF + Rr[_i]]; _r = _r < 0 ? 0 : (_r & 65535); (o)[_h][_i] = (unsigned)(_r * K + Cc[_i]) * 2u; } } while (0)
    if constexpr (SLOTS) { PG8_SLOT_DMA(cur, 0); asm volatile("s_waitcnt vmcnt(0)" ::: "memory"); __builtin_amdgcn_s_barrier(); asm volatile("" ::: "memory");
        if constexpr (GATHER) PG8_SLOT_OFFS(0, offA); }
    else if constexpr (GATHER) load_offs(g, cur, Rr, Cc, offA);
    const char* cA = GATHER ? (const char*)g.A : (const char*)g.A + (size_t)cur.pm * tstep; const char* cB = (const char*)g.Bt + (size_t)cur.brow * tstep;
    PG8_STAGE(PG8_SB(0, 0), cB, voffB); PG8_STAGE(PG8_SB(0, 1), cB + hstep, voffB); PG8_STAGE_A(PG8_SA(0, 0), cA, 0); PG8_STAGE_A(PG8_SA(0, 1), cA, 1);
    if (wr == 1) PG8_BAR;
    PG8_WAIT_V(2); PG8_BAR;
    PG8_STAGE(PG8_SB(1, 0), cB + kstep, voffB); PG8_STAGE_A(PG8_SA(1, 0), cA + kstep, 0); PG8_STAGE(PG8_SB(1, 1), cB + hstep + kstep, voffB);
    PG8_WAIT_V(6); PG8_BAR;
    for (;;) {
        const bool has_next = S.next(ui + 1, nxt);
        if constexpr (SLOTS) { if (has_next) PG8_SLOT_DMA(nxt, (ui + 1) & 1); }
        if constexpr (GATHER && SLOTS == 0) { if (has_next) load_offs(g, nxt, Rr, Cc, offN); else {
#pragma unroll
            for (int h = 0; h < 2; ++h)
#pragma unroll
                for (int i = 0; i < 2; ++i) offN[h][i] = offA[h][i]; } }
        const char* nA = has_next ? (GATHER ? (const char*)g.A : (const char*)g.A + (size_t)nxt.pm * tstep) : cA; const char* nB = has_next ? (const char*)g.Bt + (size_t)nxt.brow * tstep : cB;
        for (int t = 0; t < nt; t += 2) {
            const bool last = (t == nt - 2);
            const char* a1 = cA + (size_t)(t + 1) * kstep;
            const char* a2 = last ? nA : cA + (size_t)(t + 2) * kstep; const char* b2 = last ? nB : cB + (size_t)(t + 2) * kstep;
            const char* a3 = a2 + kstep; const char* b3 = b2 + kstep;
            PG8_LDB(B0, 0, 0); PG8_LDB(B1, 0, 1); PG8_SCHED; PG8_LDA(At, 0, 0); PG8_STAGE_A(PG8_SA(1, 1), a1, 1);
            if constexpr (GATHER && SLOTS != 0) { if (last) { if (has_next) PG8_SLOT_OFFS((ui + 1) & 1, offN); else {
#pragma unroll
                for (int h = 0; h < 2; ++h)
#pragma unroll
                    for (int i = 0; i < 2; ++i) offN[h][i] = offA[h][i]; } } }
            if constexpr (GATHER) { if (last) {
#pragma unroll
                for (int h = 0; h < 2; ++h)
#pragma unroll
                    for (int i = 0; i < 2; ++i) offA[h][i] = offN[h][i]; } }
            PG8_WAIT_V(8); PG8_WAIT_L(0); PG8_BAR; PG8_MMA(0, 0, At, B0); PG8_MMA(0, 1, At, B1); PG8_BAR; PG8_SCHED;
            PG8_LDA(At, 0, 1); PG8_STAGE(PG8_SB(0, 0), b2, voffB); PG8_STAGE(PG8_SB(0, 1), b2 + hstep, voffB); PG8_STAGE_A(PG8_SA(0, 0), a2, 0);
            PG8_WAIT_V(8); PG8_WAIT_L(0); PG8_BAR; PG8_MMA(1, 0, At, B0); PG8_MMA(1, 1, At, B1); PG8_BAR; PG8_SCHED;
            PG8_LDB(B0, 1, 0); PG8_LDB(B1, 1, 1); PG8_SCHED; PG8_LDA(At, 1, 0); PG8_STAGE_A(PG8_SA(0, 1), a2, 1);
            PG8_WAIT_V(8); PG8_WAIT_L(0); PG8_BAR; PG8_MMA(0, 0, At, B0); PG8_MMA(0, 1, At, B1); PG8_BAR; PG8_SCHED;
            PG8_LDA(At, 1, 1); PG8_STAGE(PG8_SB(1, 0), b3, voffB); PG8_STAGE(PG8_SB(1, 1), b3 + hstep, voffB); PG8_STAGE_A(PG8_SA(1, 0), a3, 0);
            PG8_WAIT_V(8); PG8_WAIT_L(0); PG8_BAR; PG8_MMA(1, 0, At, B0); PG8_MMA(1, 1, At, B1); PG8_BAR; PG8_SCHED;
        }
        if constexpr (ALIGN_EPI) { if (wr == 0) PG8_BAR; }
        E(acc, cur, wr, wc, lds, ui);
        if (!has_next) break;
#pragma unroll
        for (int a = 0; a < 2; ++a)
#pragma unroll
            for (int b = 0; b < 2; ++b)
#pragma unroll
                for (int m = 0; m < 4; ++m)
#pragma unroll
                    for (int n = 0; n < 2; ++n) acc[a][b][m][n] = (f32x4){0.f, 0.f, 0.f, 0.f};
        cur = nxt; cA = nA; cB = nB; ++ui;
        if constexpr (ALIGN_EPI) { if (wr == 1) PG8_BAR; }
    }
    PG8_WAIT_V(0);
    if constexpr (!ALIGN_EPI) { if (wr == 0) PG8_BAR; }
    PG8_BAR;
#undef PG8_SA
#undef PG8_SB
#undef PG8_STAGE
#undef PG8_STAGE_A
#undef PG8_SLOT_DMA
#undef PG8_SLOT_OFFS
#undef PG8_LDA
#undef PG8_LDB
#undef PG8_MMA
#undef PG8_CAT8
#undef PG8_WAIT_V
#undef PG8_WAIT_L
#undef PG8_BAR
#undef PG8_SCHED
}
}

#define XB_TMO      128
#define XB_XCNT(j)  (256  + 64 * (j))
#define XB_XSUB(j)  (1280 + 64 * (j))
#define XB_XGEN(j)  (2304 + 64 * (j))
#define XB_TOP      3328
#define XB_TOPGEN   3392
#define XCD_BAR_WORDS 3456
#define XB_SPIN_CAP (1u << 18)
__device__ __forceinline__ unsigned xb_ld(unsigned* p)              { return __hip_atomic_load(p, __ATOMIC_RELAXED, __HIP_MEMORY_SCOPE_AGENT); }
__device__ __forceinline__ unsigned xb_add(unsigned* p, unsigned v) { return __hip_atomic_fetch_add(p, v, __ATOMIC_RELAXED, __HIP_MEMORY_SCOPE_AGENT); }
__device__ __forceinline__ unsigned xb_xcc_id() { return (unsigned)__builtin_amdgcn_s_getreg((3 << 11) | 20) & 0xFu; }
#define XB_SPIN(cond, bar) do { unsigned _sp = 0; while (cond) { __builtin_amdgcn_s_sleep(1); \
    if ((++_sp & 255u) == 0u) { if (xb_ld(&(bar)[XB_TMO])) break; if (_sp > XB_SPIN_CAP) { atomicAdd(&(bar)[XB_TMO], 1u); break; } } } } while (0)
struct XcdBarrier { unsigned* bar; unsigned x; volatile LAS unsigned* st; };
__device__ __forceinline__ XcdBarrier xcd_barrier_post(unsigned* bar, volatile LAS unsigned* st) {
    XcdBarrier b; b.bar = bar; b.x = xb_xcc_id(); b.st = st;
    if (threadIdx.x == 0) (void)xb_add(&bar[XB_XCNT(b.x)], 1u);
    return b;
}
__device__ __forceinline__ void xcd_barrier_complete(unsigned* bar, unsigned x, unsigned& nloc, unsigned& nx) {
    const unsigned G = gridDim.x * gridDim.y * gridDim.z;
    unsigned sum, cnt, mine, sp = 0u;
    for (;;) {
        sum = 0u; cnt = 0u; mine = 0u;
#pragma unroll
        for (unsigned j = 0; j < 16; ++j) { const unsigned c = xb_ld(&bar[XB_XCNT(j)]); sum += c; cnt += (c > 0u) ? 1u : 0u; mine = (j == x) ? c : mine; }
        if (sum == G) break;
        __builtin_amdgcn_s_sleep(1);
        if ((++sp & 255u) == 0u) { if (xb_ld(&bar[XB_TMO])) break; if (sp > XB_SPIN_CAP) { atomicAdd(&bar[XB_TMO], 1u); break; } }
    }
    nloc = mine > 0u ? mine : 1u; nx = cnt > 0u ? cnt : 1u;
}
__device__ __forceinline__ void xcd_barrier(const XcdBarrier& b) {
    asm volatile("s_waitcnt vmcnt(0)" ::: "memory");
    __syncthreads();
    if (threadIdx.x == 0) {
        unsigned* bar = b.bar;
        __builtin_amdgcn_s_waitcnt(0);
        unsigned nloc = b.st[0], nx = b.st[1];
        if (nloc == 0u) { xcd_barrier_complete(bar, b.x, nloc, nx); b.st[0] = nloc; b.st[1] = nx; }
        const unsigned old = xb_add(&bar[XB_XSUB(b.x)], 1u);
        const unsigned gen = old / nloc;
        if (old + 1u == (gen + 1u) * nloc) {
            __builtin_amdgcn_fence(__ATOMIC_RELEASE, "agent");
            asm volatile("s_waitcnt vmcnt(0)" ::: "memory");
            const unsigned og = xb_add(&bar[XB_TOP], 1u);
            const unsigned tg = og / nx;
            if (og + 1u == (tg + 1u) * nx) xb_add(&bar[XB_TOPGEN], 1u);
            else XB_SPIN(xb_ld(&bar[XB_TOPGEN]) == tg, bar);
            __builtin_amdgcn_fence(__ATOMIC_ACQUIRE, "agent");
            xb_add(&bar[XB_XGEN(b.x)], 1u);
            asm volatile("s_waitcnt vmcnt(0)" ::: "memory");
        } else {
            XB_SPIN(xb_ld(&bar[XB_XGEN(b.x)]) == gen, bar);
            asm volatile("buffer_inv sc0" ::: "memory");
            asm volatile("s_waitcnt vmcnt(0)" ::: "memory");
        }
    }
    __syncthreads();
}

struct Args { const float* in[31]; float* out; unsigned char* ws; int ph_lo, ph_hi; };
typedef const __attribute__((address_space(4))) Args* ArgsP;

struct CvtDesc { const float* W; const float* gain; unsigned char* WT; int N, Kd, k0, n0, drow0; float qs; };
__device__ __forceinline__ CvtDesc cvt_decode(ArgsP a, int it) {
    constexpr int I_IN = 16 * 56, I_SQ = 16 * 32, I_UP = 16 * 88, I_DN = 44 * 32, I_LAYER = I_IN + 5 * I_SQ, I_FFN = 2 * I_UP + I_DN;
    unsigned char* ws = a->ws; CvtDesc d; d.gain = nullptr; d.qs = 0.f;
    if (it < 2 * I_LAYER) {
        const int l = it / I_LAYER; int r = it - l * I_LAYER;
        if (r < I_IN) { d.W = a->in[3] + (size_t)l * D * DIN; d.N = DIN; d.gain = a->in[2] + l * D; d.WT = ws + WS_WIN + (size_t)l * DIN * D * 2; d.Kd = D; d.k0 = 64 * (r / 56); d.n0 = 32 * (r % 56); d.drow0 = d.n0; }
        else { r -= I_IN; const int m = r / I_SQ; r -= m * I_SQ; d.N = D; d.Kd = D; d.k0 = 64 * (r / 32); d.n0 = 32 * (r % 32); d.drow0 = d.n0; const size_t lo = (size_t)l * D * D;
            if (m == 0)      { d.W = a->in[15] + lo; d.WT = ws + WS_WOUT + lo * 2; }
            else if (m == 1) { d.W = a->in[18] + lo; d.gain = a->in[16] + l * D; d.WT = ws + WS_WQ + lo * 2; }
            else if (m == 2) { d.W = a->in[19] + lo; d.gain = a->in[17] + l * D; d.WT = ws + WS_WK + lo * 2; }
            else if (m == 3) { d.W = a->in[20] + lo; d.gain = a->in[17] + l * D; d.WT = ws + WS_WV + lo * 2; }
            else             { d.W = a->in[21] + lo; d.WT = ws + WS_WO + lo * 2; } }
    } else {
        it -= 2 * I_LAYER; const int ex = it / I_FFN; int r = it - ex * I_FFN;
        const float *wg, *wu, *wd, *gn;
        if (ex == 0) { wg = a->in[23]; wu = a->in[24]; wd = a->in[25]; gn = a->in[22]; }
        else { const size_t e = ex - 1; wg = a->in[27] + e * D * DFF; wu = a->in[28] + e * D * DFF; wd = a->in[29] + e * DFF * D; gn = a->in[22] + D; }
        const bool up = r < 2 * I_UP;
        if (up) { const int isu = r >= I_UP; r -= isu * I_UP; d.W = isu ? wu : wg; d.N = DFF; d.gain = gn; d.Kd = D; d.k0 = 64 * (r / 88); d.n0 = 32 * (r % 88); d.drow0 = (d.n0 >> 7) * 256 + (d.n0 & 127) + (isu ? 128 : 0); }
        else { r -= 2 * I_UP; d.W = wd; d.N = D; d.Kd = DFF; d.k0 = 64 * (r / 32); d.n0 = 32 * (r % 32); d.drow0 = d.n0; }
        if (ex == 0) d.WT = up ? ws + WS_WGU : ws + WS_WD;
        else { const size_t e = ex - 1; d.WT = up ? ws + WS_MWGU + e * 2 * DFF * D : ws + WS_MWD + e * D * DFF; d.qs = up ? S8_UP : S8_DN; }
    }
    return d;
}
__device__ __forceinline__ void cvt_load(const CvtDesc& d, int lane, f32x4 (&v)[8], float (&g)[8]) {
    const float* p = d.W + (size_t)(d.k0 + (lane >> 3)) * d.N + d.n0 + 4 * (lane & 7);
#pragma unroll
    for (int j = 0; j < 8; ++j) { v[j] = __builtin_nontemporal_load((const f32x4*)(p + (size_t)(8 * j) * d.N));     g[j] = d.gain ? d.gain[d.k0 + (lane >> 3) + 8 * j] : 1.0f; }
}
__device__ __forceinline__ void cvt_store(const CvtDesc& d, int lane, const f32x4 (&v)[8], const float (&g)[8], LAS float* scr) {
    const float qm = d.qs != 0.f ? d.qs : 1.0f;
#pragma unroll
    for (int j = 0; j < 8; ++j) { LAS float* sp = scr + ((lane >> 3) + 8 * j) * 33 + 4 * (lane & 7); const float m = g[j] * qm;
        sp[0] = v[j][0] * m; sp[1] = v[j][1] * m; sp[2] = v[j][2] * m; sp[3] = v[j][3] * m; }
    asm volatile("s_waitcnt lgkmcnt(0)" ::: "memory");
    if (d.qs == 0.f) { const int c = lane & 7;
#pragma unroll
        for (int j = 0; j < 4; ++j) { const int n = (lane >> 3) + 8 * j; const LAS float* s = scr + (8 * c) * 33 + n;
            u32x4 o; o.x = pk_bf16(s[0 * 33], s[1 * 33]); o.y = pk_bf16(s[2 * 33], s[3 * 33]); o.z = pk_bf16(s[4 * 33], s[5 * 33]); o.w = pk_bf16(s[6 * 33], s[7 * 33]);
            st16_wt(d.WT + ((size_t)(d.drow0 + n) * d.Kd + d.k0 + 8 * c) * 2, o); }
    } else { const int c = lane & 3;
#pragma unroll
        for (int j = 0; j < 2; ++j) { const int n = (lane >> 2) + 16 * j; const LAS float* s = scr + (16 * c) * 33 + n;
            u32x4 o; o.x = pk_fp8x4(s[0 * 33], s[1 * 33], s[2 * 33], s[3 * 33]); o.y = pk_fp8x4(s[4 * 33], s[5 * 33], s[6 * 33], s[7 * 33]);
            o.z = pk_fp8x4(s[8 * 33], s[9 * 33], s[10 * 33], s[11 * 33]); o.w = pk_fp8x4(s[12 * 33], s[13 * 33], s[14 * 33], s[15 * 33]);
            __builtin_nontemporal_store(o, (u32x4*)(d.WT + (size_t)(d.drow0 + n) * d.Kd + d.k0 + 16 * c)); }
    }
    asm volatile("s_waitcnt lgkmcnt(0)" ::: "memory");
}

__device__ __forceinline__ void phase_prologue(ArgsP a, LAS unsigned char* lds, int vcu, int G, int tid, int lane, int wave) {
    unsigned char* ws = a->ws;
    LAS float* scr = (LAS float*)(lds + wave * 16384);
    const int gw = vcu * NWAVES + wave, NGW = G * NWAVES;
    constexpr int NITEMS = 2 * (16 * 56 + 5 * 16 * 32) + 9 * (2 * 16 * 88 + 44 * 32);
    {
        f32x4* rowss0 = (f32x4*)(ws + WS_ROWSS);
        for (int m0 = 2 * gw; m0 < T + MROWS; m0 += 2 * NGW) {
            f32x4 v[2][4];
#pragma unroll
            for (int q = 0; q < 2; ++q) { const int m = m0 + q; const bool isx = m < T; const int r = isx ? m : m - T;
                const f32x4* xr = (const f32x4*)((isx ? a->in[0] : a->in[1]) + (size_t)r * D) + lane;
#pragma unroll
                for (int j = 0; j < 4; ++j) v[q][j] = __builtin_nontemporal_load(&xr[64 * j]); }
#pragma unroll
            for (int q = 0; q < 2; ++q) { const int m = m0 + q; const bool isx = m < T; const int r = isx ? m : m - T; float s = 0.f;
#pragma unroll
                for (int j = 0; j < 4; ++j) s += (v[q][j][0] * v[q][j][0] + v[q][j][1] * v[q][j][1]) + (v[q][j][2] * v[q][j][2] + v[q][j][3] * v[q][j][3]);
                s = wave_sum(s);
                u32x2* o8 = (u32x2*)((isx ? (bf16*)(ws + WS_XB) : (bf16*)(ws + WS_MEMB)) + (size_t)r * D) + lane;
#pragma unroll
                for (int j = 0; j < 4; ++j) { u32x2 w; w.x = pk_bf16(v[q][j][0], v[q][j][1]); w.y = pk_bf16(v[q][j][2], v[q][j][3]); st8_wt(&o8[64 * j], w); }
                if (lane == 0) { if (isx) rowss0[r] = (f32x4){s, 0.f, 0.f, 0.f}; else ((u64*)(ws + OFF_MEMSS))[r] = ss_to_fix(s); } }
        }
    }
    if (gw < NITEMS) {
        CvtDesc d0 = cvt_decode(a, gw); f32x4 v[8]; float g[8]; cvt_load(d0, lane, v, g);
        for (int it = gw; it < NITEMS; it += NGW) {
            const int itn = it + NGW; const bool hn = itn < NITEMS;
            CvtDesc dn = d0; f32x4 w[8]; float gn[8];
            if (hn) { dn = cvt_decode(a, itn); cvt_load(dn, lane, w, gn); }
            cvt_store(d0, lane, v, g, scr);
            if (hn) { d0 = dn;
#pragma unroll
                for (int j = 0; j < 8; ++j) { v[j] = w[j]; g[j] = gn[j]; } }
        }
    }
    const int gt = vcu * NTHREADS + tid, NGT = G * NTHREADS;
    for (int i = gt; i < 2 * 4 * 128 * 128; i += NGT) { const int ii = (i >> 7) & 127, jj = i & 127; const float v = a->in[10][i]; ((bf16*)(ws + WS_SGUW))[i] = f2bf(((ii >> 6) >= (jj >> 6)) ? v : 0.f); }
    for (int i = gt; i < 2 * 4 * 64 * 64; i += NGT) { const int lg = i >> 12, o = (i >> 6) & 63, ii = i & 63; ((bf16*)(ws + WS_POOLW))[i] = f2bf(a->in[12][(lg << 12) + ii * 64 + o]); }
}

__device__ __forceinline__ void mixer_unit(ArgsP a, LAS unsigned char* lds, int l, int u, int tid_in, int lane_in, int wave) {
    int tid = tid_in, lane = lane_in;
    const bf16* z = (const bf16*)(a->ws + WS_Z); bf16* mixed = (bf16*)(a->ws + WS_MIXED);
    const int b = u >> 5, c = u & 31, t0 = c * 128; const size_t R0 = (size_t)b * SEQ + t0;
    u32x4 cvp[9], rv[12]; float sgl, sgb;
    MSEC(0);
    {
        const float* cw = a->in[4] + l * 31 * 384; const float* cb = a->in[5] + l * 384; const float* lg = a->in[6] + l * 384; const float* lb = a->in[7] + l * 384;
        LAS unsigned* wl = (LAS unsigned*)(lds + 135168);
        OPAQUE(tid);
        f32x2 cbv[3], lgv[3], lbv[3];
#pragma unroll
        for (int jt = 0; jt < 3; ++jt) { const unsigned p2 = (unsigned)((tid + NTHREADS * jt) % 192) * 8u; cbv[jt] = *(const f32x2*)((const char*)cb + p2); lgv[jt] = *(const f32x2*)((const char*)lg + p2); lbv[jt] = *(const f32x2*)((const char*)lb + p2); }
#pragma unroll 1
        for (int hb = 0; hb < 2; ++hb) { f32x2 wst[6];
#pragma unroll
          for (int q = 0; q < 6; ++q) { const unsigned idx = (unsigned)tid + (unsigned)(hb * 6 + q) * NTHREADS; wst[q] = (f32x2){0.f, 0.f}; if (idx < 31u * 192u) wst[q] = *(const f32x2*)((const char*)cw + idx * 8u); }
#pragma unroll
          for (int q = 0; q < 6; ++q) { const unsigned idx = (unsigned)tid + (unsigned)(hb * 6 + q) * NTHREADS; if (idx < 31u * 192u) wl[idx] = pk_bf16(wst[q].x, wst[q].y); } }
#pragma unroll 1
        for (int it0 = tid; it0 < 158 * 48; it0 += 5 * NTHREADS) {
            u32x4 av[5], gv[5];
#pragma unroll
            for (int q5 = 0; q5 < 5; ++q5) { const int it = it0 + q5 * NTHREADS, j = it / 48, v = it - j * 48; av[q5] = (u32x4){0u, 0u, 0u, 0u}; gv[q5] = av[q5];
                if (it < 158 * 48 && t0 - 30 + j >= 0) { const bf16* rp = z + (R0 + j - 30) * DIN + 8 * v; av[q5] = *(const u32x4*)rp; gv[q5] = *(const u32x4*)(rp + 384); } }
#pragma unroll
            for (int q5 = 0; q5 < 5; ++q5) { const int it = it0 + q5 * NTHREADS, j = it / 48, v = it - j * 48; u32x4 o;
#pragma unroll
                for (int q = 0; q < 4; ++q) o[q] = pk_bf16(bf_lo(av[q5][q]) * sigm(bf_lo(gv[q5][q])), bf_hi(av[q5][q]) * sigm(bf_hi(gv[q5][q])));
                if (it < 158 * 48) *(LAS u32x4*)(lds + j * 768 + v * 16) = o; }
        }
        EPI_BAR();
        MSEC(1);
        LAS float* part = (LAS float*)(lds + 122880);
        LAS float* fin = (LAS float*)(lds + 159744);
        OPAQUE(tid); lane = tid & 63;
#pragma unroll 1
        for (int jt = 0; jt < 3; ++jt) { const int item = tid + NTHREADS * jt, rg = item / 192, p = item - rg * 192, q3 = p >> 6;
            f32x2 w[31];
#pragma unroll
            for (int k = 0; k < 31; ++k) { const unsigned wq = wl[k * 192 + p]; w[k] = (f32x2){bf_lo(wq), bf_hi(wq)}; }
            const f32x2 bias = jt == 0 ? cbv[0] : jt == 1 ? cbv[1] : cbv[2];
            float y0[16], y1[16];
#pragma unroll
            for (int i = 0; i < 16; ++i) { y0[i] = bias.x; y1[i] = bias.y; }
            const LAS unsigned* hp = (const LAS unsigned*)lds + (rg * 16) * 192 + p;
#pragma unroll
            for (int jj = 0; jj < 46; ++jj) { const unsigned hv = hp[jj * 192]; const float h0 = bf_lo(hv), h1 = bf_hi(hv);
#pragma unroll
                for (int i = 0; i < 16; ++i) { const int k = jj - i; if (k >= 0 && k <= 30) { y0[i] += w[k].x * h0; y1[i] += w[k].y * h1; } } }
#pragma unroll
            for (int i = 0; i < 16; ++i) { float s1 = y0[i] + y1[i], s2 = y0[i] * y0[i] + y1[i] * y1[i];
                s1 = row16_sum(s1); s2 = row16_sum(s2);
                if ((lane & 15) == 0) { const int pi = ((rg * 16 + i) * 12 + q3 * 4 + (lane >> 4)) * 2; part[pi] = s1; part[pi + 1] = s2; }
                *(unsigned*)(mixed + (R0 + rg * 16 + i) * D + 2 * p) = pk_bf16(y0[i], y1[i]); }
        }
        EPI_BAR();
        MSEC(2);
        OPAQUE(tid);
#pragma unroll
        for (int q9 = 0; q9 < 9; ++q9) { const int it = tid + q9 * NTHREADS, j = it >> 5, v = it & 31; cvp[q9] = (u32x4){0u, 0u, 0u, 0u};
            if (it < 143 * 32 && t0 - 15 + j >= 0) cvp[q9] = *(const u32x4*)(z + (R0 + j - 15) * DIN + 1536 + 8 * v); }
        if (tid < 256) { const LAS float* pr = part + (tid >> 1) * 24 + (tid & 1); float sm = 0.f;
#pragma unroll
            for (int k = 0; k < 12; ++k) sm += pr[2 * k];
            fin[tid] = sm; }
        EPI_BAR();
        OPAQUE(tid);
        asm volatile("s_waitcnt vmcnt(0)" ::: "memory");
#pragma unroll 1
        for (int jt = 0; jt < 3; ++jt) { const int item = tid + NTHREADS * jt, rg = item / 192, p = item - rg * 192;
            const f32x2 g2 = jt == 0 ? lgv[0] : jt == 1 ? lgv[1] : lgv[2], b2 = jt == 0 ? lbv[0] : jt == 1 ? lbv[1] : lbv[2];
#pragma unroll
            for (int i = 0; i < 16; ++i) { const int row = rg * 16 + i;
                const float S1 = fin[row * 2], S2 = fin[row * 2 + 1];
                const float mean = S1 * (1.0f / 384.0f), var = S2 * (1.0f / 384.0f) - mean * mean, rstd = __builtin_amdgcn_rsqf(var + EPS);
                unsigned* mp = (unsigned*)(mixed + (R0 + row) * D + 2 * p); const unsigned yv = *mp;
                const float o0 = (bf_lo(yv) - mean) * rstd * g2.x + b2.x, o1 = (bf_hi(yv) - mean) * rstd * g2.y + b2.y;
                *mp = pk_bf16(silu_f(o0), silu_f(o1)); } }
    }
    {
        MSEC(3);
        OPAQUE(tid); lane = tid & 63;
        const bf16* pwT = (const bf16*)(a->ws + WS_POOLW) + l * 4 * 64 * 64; const float* pb = a->in[13] + l * 256; const float* psc = a->in[14] + l * 256;
        {
#pragma unroll
            for (int q9 = 0; q9 < 9; ++q9) { const int it = tid + q9 * NTHREADS, j = it >> 5, v = it & 31; if (it < 143 * 32) *(LAS u32x4*)(lds + j * 512 + v * 16) = cvp[q9]; } }
        EPI_BAR();
        OPAQUE(tid);
        bf16x8 pwf[2][4]; f32x4 pbv[4], pscv[4];
        { const int l2 = tid & 63, r = l2 & 15, kq = l2 >> 4, g = wave & 3;
#pragma unroll
            for (int ks = 0; ks < 2; ++ks)
#pragma unroll
                for (int n = 0; n < 4; ++n) pwf[ks][n] = *(const bf16x8*)(pwT + ((g * 64 + 16 * n + r) * 64 + 32 * ks + 8 * kq));
#pragma unroll
            for (int n = 0; n < 4; ++n) { const int ch = g * 64 + 16 * n + 4 * kq; pbv[n] = *(const f32x4*)(pb + ch); pscv[n] = *(const f32x4*)(psc + ch); } }
        sgl = 0.f; sgb = 0.f; if (tid < 384) { sgl = a->in[8][l * 384 + tid]; sgb = a->in[9][l * 384 + tid]; }
#pragma unroll
        for (int q12 = 0; q12 < 12; ++q12) rv[q12] = *(const u32x4*)(z + (R0 + (tid & 127)) * DIN + 1152 + (tid >> 7) * 96 + 8 * q12);
        { const int pp = tid & 127, rq = tid >> 7; const int w = 2 << (pp >> 5); const LAS unsigned* cp = (const LAS unsigned*)lds + pp; const int i0 = rq * 32;
            float s0 = 0.f, s1 = 0.f;
#pragma unroll
            for (int kk = 0; kk < 16; ++kk) if (kk < w) { const unsigned v = cp[(i0 + 15 - kk) * 128]; s0 += bf_lo(v); s1 += bf_hi(v); }
#pragma unroll 8
            for (int ii = 0; ii < 32; ++ii) { const int i = i0 + ii; const unsigned cv = cp[(i + 15) * 128];
                const int tpos = t0 + i + 1; const float inv = 1.0f / (float)(tpos < w ? tpos : w);
                *(LAS unsigned*)(lds + 73728 + i * 528 + pp * 4) = pk_bf16(s0 * inv - bf_lo(cv), s1 * inv - bf_hi(cv));
                if (ii < 31) { const unsigned vn = cp[(i + 16) * 128], vo = cp[(i + 16 - w) * 128]; s0 += bf_lo(vn) - bf_lo(vo); s1 += bf_hi(vn) - bf_hi(vo); } } }
        EPI_BAR();
        OPAQUE(tid); lane = tid & 63;
        { const int r = lane & 15, kq = lane >> 4, g = wave & 3, rh = wave >> 2; f32x4 acc[4][4];
#pragma unroll
            for (int rt = 0; rt < 4; ++rt)
#pragma unroll
                for (int n = 0; n < 4; ++n) acc[rt][n] = (f32x4){0.f, 0.f, 0.f, 0.f};
#pragma unroll
            for (int ks = 0; ks < 2; ++ks)
#pragma unroll
                for (int rt = 0; rt < 4; ++rt) { const bf16x8 af = *(const LAS bf16x8*)(lds + 73728 + (64 * rh + 16 * rt + r) * 528 + (g * 64 + 32 * ks + 8 * kq) * 2);
#pragma unroll
                    for (int n = 0; n < 4; ++n) acc[rt][n] = __builtin_amdgcn_mfma_f32_16x16x32_bf16(pwf[ks][n], af, acc[rt][n], 0, 0, 0); }
            LAS unsigned char* pat = lds + wave * (16 * 144);
#pragma unroll
            for (int rt = 0; rt < 4; ++rt) {
#pragma unroll
                for (int n = 0; n < 4; ++n) { const f32x4 o = (acc[rt][n] + pbv[n]) * pscv[n];
                    u32x2 w2; w2.x = pk_bf16(o[0], o[1]); w2.y = pk_bf16(o[2], o[3]); *(LAS u32x2*)(pat + r * 144 + n * 32 + kq * 8) = w2; }
                asm volatile("s_waitcnt lgkmcnt(0)" ::: "memory");
#pragma unroll
                for (int j = 0; j < 2; ++j) { const int id = j * 64 + lane, row = id >> 3, c = id & 7;
                    const u32x4 w = *(const LAS u32x4*)(pat + row * 144 + c * 16);
                    st16_wt(mixed + (R0 + 64 * rh + 16 * rt + row) * D + 768 + g * 64 + c * 8, w); }
                asm volatile("s_waitcnt lgkmcnt(0)" ::: "memory"); } }
        EPI_BAR();
    }
    {
        MSEC(4);
        OPAQUE(tid); lane = tid & 63;
        const float* lg = a->in[8] + l * 384; const float* lb = a->in[9] + l * 384; const float* sb = a->in[11] + l * 4 * 128;
        const bf16* Wm = (const bf16*)(a->ws + WS_SGUW) + (size_t)l * 4 * 128 * 128;
        LAS float* prm = (LAS float*)(lds + 126976);
        if (tid < 384) { prm[tid] = sgl; prm[384 + tid] = sgb; }
        { const int j = tid & 127, qd = __builtin_amdgcn_readfirstlane(tid >> 7); float vv[96]; float s1 = 0.f, s2 = 0.f;
#pragma unroll
            for (int k = 0; k < 12; ++k) { const u32x4 x = rv[k];
#pragma unroll
                for (int q = 0; q < 4; ++q) { const float e0 = gelu_tanh(bf_lo(x[q])), e1 = gelu_tanh(bf_hi(x[q])); vv[8 * k + 2 * q] = e0; vv[8 * k + 2 * q + 1] = e1; s1 += e0 + e1; s2 += e0 * e0 + e1 * e1; } }
            LAS float* st = (LAS float*)(lds + 122880);
            st[(j * 4 + qd) * 2] = s1; st[(j * 4 + qd) * 2 + 1] = s2;
            EPI_BAR();
            const float S1 = st[j * 8] + st[j * 8 + 2] + st[j * 8 + 4] + st[j * 8 + 6], S2 = st[j * 8 + 1] + st[j * 8 + 3] + st[j * 8 + 5] + st[j * 8 + 7];
            const float mean = S1 * (1.0f / 384.0f), var = S2 * (1.0f / 384.0f) - mean * mean, rstd = __builtin_amdgcn_rsqf(var + EPS);
#pragma unroll
            for (int cidx = 0; cidx < 96; ++cidx) { const float o = (vv[cidx] - mean) * rstd * prm[qd * 96 + cidx] + prm[384 + qd * 96 + cidx];
                *(LAS bf16*)(lds + (qd * 96 + cidx) * 272 + j * 2) = f2bf(o); } }
        EPI_BAR();
        MSEC(5);
        OPAQUE(tid); lane = tid & 63;
        { const int hd = wave >> 1, ih = wave & 1, r = lane & 15, kq = lane >> 4; f32x4 acc[6][4];
#pragma unroll
            for (int dt = 0; dt < 6; ++dt)
#pragma unroll
                for (int it = 0; it < 4; ++it) acc[dt][it] = (f32x4){0.f, 0.f, 0.f, 0.f};
            bf16x8 wf[4][4]; u32x2 uu[4][6];
            const bf16* Wh = Wm + (size_t)hd * 128 * 128;
#pragma unroll
            for (int ks = 0; ks < 4; ++ks)
#pragma unroll
                for (int it = 0; it < 4; ++it) wf[ks][it] = *(const bf16x8*)(Wh + (64 * ih + 16 * it + r) * 128 + 32 * ks + 8 * kq);
#pragma unroll
            for (int it = 0; it < 4; ++it)
#pragma unroll
                for (int dt = 0; dt < 6; ++dt) uu[it][dt] = *(const u32x2*)(z + (R0 + 64 * ih + 16 * it + r) * DIN + 768 + hd * 96 + 16 * dt + 4 * kq);
#pragma unroll
            for (int ks = 0; ks < 4; ++ks) { if (ks >= 2 && ih == 0) continue;
#pragma unroll
                for (int dt = 0; dt < 6; ++dt) { const bf16x8 vf = *(const LAS bf16x8*)(lds + (hd * 96 + 16 * dt + r) * 272 + (32 * ks + 8 * kq) * 2);
#pragma unroll
                    for (int it = 0; it < 4; ++it) acc[dt][it] = __builtin_amdgcn_mfma_f32_16x16x32_bf16(vf, wf[ks][it], acc[dt][it], 0, 0, 0); } }
            LAS unsigned char* pat = lds + 106496 + wave * (16 * 208);
            float sbv4[4];
#pragma unroll
            for (int it = 0; it < 4; ++it) sbv4[it] = sb[hd * 128 + 64 * ih + 16 * it + r];
#pragma unroll
            for (int it = 0; it < 4; ++it) { const float sbv = sbv4[it];
#pragma unroll
                for (int dt = 0; dt < 6; ++dt) { const u32x2 u2 = uu[it][dt];
                    const float o0 = gelu_tanh(bf_lo(u2.x)) * (acc[dt][it][0] + sbv), o1 = gelu_tanh(bf_hi(u2.x)) * (acc[dt][it][1] + sbv);
                    const float o2 = gelu_tanh(bf_lo(u2.y)) * (acc[dt][it][2] + sbv), o3 = gelu_tanh(bf_hi(u2.y)) * (acc[dt][it][3] + sbv);
                    u32x2 w2; w2.x = pk_bf16(o0, o1); w2.y = pk_bf16(o2, o3); *(LAS u32x2*)(pat + r * 208 + dt * 32 + kq * 8) = w2; }
                asm volatile("s_waitcnt lgkmcnt(0)" ::: "memory");
#pragma unroll
                for (int j = 0; j < 3; ++j) { const int id = j * 64 + lane, row = id / 12, c = id - row * 12;
                    const u32x4 w = *(const LAS u32x4*)(pat + row * 208 + c * 16);
                    st16_wt(mixed + (R0 + 64 * ih + 16 * it + row) * D + 384 + hd * 96 + c * 8, w); }
                asm volatile("s_waitcnt lgkmcnt(0)" ::: "memory"); } }
        EPI_BAR();
        MSEC(6);
    }
}

__device__ __forceinline__ void attn_dma_k(const bf16* Kbase, int t, unsigned ldsbase, int wave, int lane) {
#pragma unroll
    for (int i = 0; i < 4; ++i) { const int pi = wave * 4 + i, rowt = 2 * pi + (lane >> 5), cl = (lane & 31) ^ (rowt & 31);
        pg8::glds_s((const void*)Kbase, (unsigned)((64 * t + rowt) * 2048 + cl * 8) * 2u, ldsbase + (unsigned)t * 32768u + (unsigned)pi * 1024u); }
}
__device__ __forceinline__ void attn_dma_v(const bf16* Vbase, int t, unsigned ldsbase, int wave, int lane) {
#pragma unroll
    for (int i = 0; i < 4; ++i) { const int pi = wave * 4 + i, row = 8 * pi + (lane >> 3), cl = (lane & 7) ^ (row & 7);
        pg8::glds_s((const void*)Vbase, (unsigned)(row * 2048 + 64 * t + cl * 8) * 2u, ldsbase + (unsigned)t * 32768u + (unsigned)pi * 1024u); }
}
__device__ __forceinline__ void attn_phase(ArgsP a, LAS unsigned char* lds, int l, int vcu, int G, int tid, int wave) {
    const bf16* Q = (const bf16*)(a->ws + WS_Q); bf16* O = (bf16*)(a->ws + WS_O);
    const bf16* KB = (const bf16*)(a->ws + WS_KB); const bf16* VT = (const bf16*)(a->ws + WS_VT);
    const unsigned ldsbase = (unsigned)(size_t)lds;
    int lane = tid & 63;
    bool first = true;
    bf16x8 qf[16];
#define ATT_LOADQ(uu, s0, s1) do { const int _bh = (uu) >> 4; const bf16* _qp = Q + ((size_t)(_bh >> 2) * SEQ + ((uu) & 15) * 256 + wave * 32 + (lane & 31)) * D + (_bh & 3) * 256 + 8 * (lane >> 5); \
        _Pragma("unroll") for (int s = s0; s < s1; ++s) qf[s] = *(const bf16x8*)(_qp + 16 * s); } while (0)
    constexpr int QPRE_N = 6;
    if (ATT_QPRE && vcu < 512) ATT_LOADQ(vcu, 0, QPRE_N);
    for (int u = vcu; u < 512; u += G) {
        const int qt = u & 15, bh = u >> 4, b = bh >> 2, h = bh & 3;
        const int un = u + G; const bool has_next = un < 512;
        const bf16* Kbase = KB + (size_t)(b * 256) * 2048 + l * 1024 + h * 256;
        const bf16* Vbase = VT + (size_t)(l * 1024 + h * 256) * 2048 + b * 256;
        const bf16* Knext = KB + (size_t)(((un >> 4) >> 2) * 256) * 2048 + l * 1024 + ((un >> 4) & 3) * 256;
        OPAQUE(lane);
        if (first) {
#pragma unroll
            for (int t = 0; t < 4; ++t) attn_dma_k(Kbase, t, ldsbase, wave, lane); }
        first = false;
        const int r = lane & 31, h2 = lane >> 5;
        if (!ATT_QPRE) ATT_LOADQ(u, 0, 16);
        asm volatile("s_waitcnt vmcnt(0)" ::: "memory");
        __syncthreads();
        if (ATT_QPRE) ATT_LOADQ(u, QPRE_N, 16);
        f32x16 sacc[8];
#pragma unroll
        for (int kt = 0; kt < 8; ++kt)
#pragma unroll
            for (int j = 0; j < 16; ++j) sacc[kt][j] = 0.f;
#define ATT_LDK(i) (*(const LAS bf16x8*)(lds + ((i) >> 5) * 32768 + (32 * ((i) & 1) + r) * 512 + (((2 * (((i) >> 1) & 15) + h2) ^ r) * 16)))
        { bf16x8 kb[4];
#pragma unroll
          for (int i = 0; i < 4; ++i) kb[i] = ATT_LDK(i);
#pragma unroll
          for (int idx = 0; idx < 128; ++idx) { const int t = idx >> 5, sq = (idx >> 1) & 15, k2 = idx & 1;
              sacc[2 * t + k2] = __builtin_amdgcn_mfma_f32_32x32x16_bf16(kb[idx & 3], qf[sq], sacc[2 * t + k2], 0, 0, 0);
              if (idx + 4 < 128) kb[idx & 3] = ATT_LDK(idx + 4);
              __builtin_amdgcn_sched_barrier(0);
              if ((idx & 31) == 31) {
                  asm volatile("" ::: "memory"); __builtin_amdgcn_s_barrier(); asm volatile("" ::: "memory");
                  OPAQUE(lane); attn_dma_v(Vbase, t, ldsbase, wave, lane); __builtin_amdgcn_sched_barrier(0); } } }
#undef ATT_LDK
        float mx = -3.0e38f;
#pragma unroll
        for (int kt = 0; kt < 8; ++kt)
#pragma unroll
            for (int j = 0; j < 16; ++j) mx = fmaxf(mx, sacc[kt][j]);
        mx = fmaxf(mx, shfl_xor_f(mx, 32));
        float sum = 0.f; bf16x8 pf[8][2];
#pragma unroll
        for (int kt = 0; kt < 8; ++kt) {
            float p[16];
#pragma unroll
            for (int j = 0; j < 16; ++j) { p[j] = __builtin_amdgcn_exp2f(sacc[kt][j] - mx); sum += p[j]; }
#pragma unroll
            for (int s2 = 0; s2 < 2; ++s2) { u32x4 w; w.x = pk_bf16_v(p[8 * s2], p[8 * s2 + 1]); w.y = pk_bf16_v(p[8 * s2 + 2], p[8 * s2 + 3]); w.z = pk_bf16_v(p[8 * s2 + 4], p[8 * s2 + 5]); w.w = pk_bf16_v(p[8 * s2 + 6], p[8 * s2 + 7]);
                pf[kt][s2] = __builtin_bit_cast(bf16x8, w); }
            __builtin_amdgcn_sched_barrier(0); }
        sum += shfl_xor_f(sum, 32);
        const float inv = 1.0f / sum;
        f32x16 oacc[8]; f32x16 zero16;
#pragma unroll
        for (int j = 0; j < 16; ++j) zero16[j] = 0.f;
        asm volatile("s_waitcnt vmcnt(12)" ::: "memory"); __builtin_amdgcn_s_barrier(); asm volatile("" ::: "memory");
        { OPAQUE(lane); const int r2 = lane & 31, g2 = lane >> 5;
#define ATT_LDV(t, j) (*(const LAS bf16x8*)(lds + (t) * 32768 + (32 * ((j) & 7) + r2) * 128 + (((2 * ((j) >> 3) + g2) ^ (r2 & 7)) * 16)))
#pragma unroll
          for (int t = 0; t < 4; ++t) { bf16x8 vb[4];
#pragma unroll
              for (int i = 0; i < 4; ++i) vb[i] = ATT_LDV(t, i);
#pragma unroll
              for (int j = 0; j < 32; ++j) { const int s4 = j >> 3, dt = j & 7;
                  oacc[dt] = __builtin_amdgcn_mfma_f32_32x32x16_bf16(vb[j & 3], pf[2 * t + (s4 >> 1)][s4 & 1], (t == 0 && s4 == 0) ? zero16 : oacc[dt], 0, 0, 0);
                  if (j + 4 < 32) vb[j & 3] = ATT_LDV(t, j + 4);
                  __builtin_amdgcn_sched_barrier(0); }
              if (t < 3) { if (has_next) asm volatile("s_waitcnt vmcnt(8)" ::: "memory");
                  else if (t == 0) asm volatile("s_waitcnt vmcnt(8)" ::: "memory"); else if (t == 1) asm volatile("s_waitcnt vmcnt(4)" ::: "memory"); else asm volatile("s_waitcnt vmcnt(0)" ::: "memory"); }
              asm volatile("" ::: "memory"); __builtin_amdgcn_s_barrier(); asm volatile("" ::: "memory");
              if (has_next) { int l2 = lane; OPAQUE(l2); attn_dma_k(Knext, t, ldsbase, wave, l2); __builtin_amdgcn_sched_barrier(0); } }
#undef ATT_LDV
        }
        { OPAQUE(lane); const int r2 = lane & 31, g2 = lane >> 5; LAS unsigned char* pat = lds + 131072 + wave * 2048;
#pragma unroll
            for (int dp = 0; dp < 4; ++dp)
#pragma unroll
                for (int rh = 0; rh < 2; ++rh) {
                    if (ATT_QPRE && dp == 2 && rh == 0 && has_next) ATT_LOADQ(un, 0, QPRE_N);
                    if ((r2 >> 4) == rh) {
#pragma unroll
                        for (int d2 = 0; d2 < 2; ++d2)
#pragma unroll
                            for (int g4 = 0; g4 < 4; ++g4) { const int dt = 2 * dp + d2; u32x2 w; w.x = pk_bf16(oacc[dt][4 * g4] * inv, oacc[dt][4 * g4 + 1] * inv); w.y = pk_bf16(oacc[dt][4 * g4 + 2] * inv, oacc[dt][4 * g4 + 3] * inv);
                                const int c8 = d2 * 8 + g4 * 2 + g2, lr = r2 & 15;
                                *(LAS u32x2*)(pat + lr * 128 + ((((c8 >> 1) ^ (lr & 7)) * 16) + (c8 & 1) * 8)) = w; } }
                    asm volatile("s_waitcnt lgkmcnt(0)" ::: "memory");
#pragma unroll
                    for (int j = 0; j < 2; ++j) { const int row = 8 * j + (lane >> 3), c = lane & 7;
                        const u32x4 w = *(const LAS u32x4*)(pat + row * 128 + ((c ^ (row & 7)) * 16));
                        st16_wt(O + ((size_t)b * SEQ + qt * 256 + wave * 32 + rh * 16 + row) * D + h * 256 + dp * 64 + c * 8, w); }
                    asm volatile("s_waitcnt lgkmcnt(0)" ::: "memory");
                }
        }
    }
#undef ATT_LOADQ
    asm volatile("s_waitcnt vmcnt(0)" ::: "memory");
    __syncthreads();
}

constexpr size_t WS_CHUNKCNT = WS_ROUTE + 4 * (size_t)T * 4 + 3 * (size_t)PERMROWS * 4;
__device__ __forceinline__ void phase_router(ArgsP a, LAS unsigned char* lds, int vcu, int G, int tid, int lane, int wave) {
    unsigned char* ws = a->ws;
    constexpr int BP = 2064;
    LAS unsigned char* bt = lds;
    LAS float* lg = (LAS float*)(lds + 36864 + wave * 512);
    LAS int* hist = (LAS int*)(lds + 36864 + 4096);
    const float* gn = a->in[22] + D; const float* rw = a->in[26];
    { f32x4 wv[2][2]; float gk[2];
#pragma unroll
        for (int q = 0; q < 2; ++q) { const int k = tid + NTHREADS * q; wv[q][0] = *(const f32x4*)(rw + k * 8); wv[q][1] = *(const f32x4*)(rw + k * 8 + 4); gk[q] = gn[k]; }
#pragma unroll
        for (int q = 0; q < 2; ++q) { const int k = tid + NTHREADS * q;
#pragma unroll
            for (int e = 0; e < 8; ++e) { const float w = gk[q] * wv[q][e >> 2][e & 3];
                const unsigned hi = pk_bf16(w, 0.f) & 0xffffu; const float hif = __uint_as_float(hi << 16);
                *(LAS bf16*)(bt + e * BP + k * 2) = (bf16)hi; *(LAS bf16*)(bt + (8 + e) * BP + k * 2) = f2bf(w - hif); } } }
    const f32x4* rowss = (const f32x4*)(ws + WS_ROWSS) + 5 * T;
    int* sel = (int*)(ws + WS_ROUTE); float* gate = (float*)(ws + WS_ROUTE + 2 * T * 4); int* chunkcnt = (int*)(ws + WS_CHUNKCNT);
    const int r = lane & 15, kq = lane >> 4;
    for (int chunk = vcu; chunk < T / 128; chunk += G) {
        __syncthreads();
        if (tid < 8) hist[tid] = 0;
        __syncthreads();
        const int mb = chunk * 128 + wave * 16;
        const bf16* xp = (const bf16*)(ws + WS_XB) + (size_t)(mb + r) * D + 8 * kq;
        float rs[4];
#pragma unroll
        for (int i = 0; i < 4; ++i) rs[i] = rstd4(rowss[mb + 4 * kq + i]);
        f32x4 acc = {0.f, 0.f, 0.f, 0.f};
#pragma unroll
        for (int hf = 0; hf < 2; ++hf) { bf16x8 af[16];
#pragma unroll
            for (int s = 0; s < 16; ++s) af[s] = *(const bf16x8*)(xp + 32 * (16 * hf + s));
#pragma unroll
            for (int s = 0; s < 16; ++s) { const bf16x8 bfr = *(const LAS bf16x8*)(bt + r * BP + (32 * (16 * hf + s) + 8 * kq) * 2);
                acc = __builtin_amdgcn_mfma_f32_16x16x32_bf16(af[s], bfr, acc, 0, 0, 0); } }
#pragma unroll
        for (int i = 0; i < 4; ++i) { const float v = acc[i] + dpp_f<0x128>(acc[i]); if (r < 8) lg[(4 * kq + i) * 8 + r] = v * rs[i]; }
        asm volatile("s_waitcnt lgkmcnt(0)" ::: "memory");
        if (lane < 16) { const int m = mb + lane; const f32x4 p0 = *(const LAS f32x4*)(lg + lane * 8), p1 = *(const LAS f32x4*)(lg + lane * 8 + 4);
            const float p[8] = {p0[0], p0[1], p0[2], p0[3], p1[0], p1[1], p1[2], p1[3]};
            int i0 = 0; float v0 = p[0];
#pragma unroll
            for (int e = 1; e < 8; ++e) if (p[e] > v0) { v0 = p[e]; i0 = e; }
            int i1 = -1; float v1 = -3.0e38f;
#pragma unroll
            for (int e = 0; e < 8; ++e) if (e != i0 && p[e] > v1) { v1 = p[e]; i1 = e; }
            const float g0 = 1.0f / (1.0f + __expf(v1 - v0)), g1 = 1.0f - g0;
            sel[m] = i0; sel[T + m] = i1; gate[m] = g0; gate[T + m] = g1;
            __hip_atomic_fetch_add(&hist[i0], 1, __ATOMIC_RELAXED, __HIP_MEMORY_SCOPE_WORKGROUP); __hip_atomic_fetch_add(&hist[i1], 1, __ATOMIC_RELAXED, __HIP_MEMORY_SCOPE_WORKGROUP); }
        __syncthreads();
        { int t3 = tid; OPAQUE(t3); if (t3 < 8) chunkcnt[chunk * 8 + t3] = hist[t3]; }
    }
}
__device__ __forceinline__ void phase_lists(ArgsP a, LAS unsigned char* lds, int vcu, int G, int tid) {
    unsigned char* ws = a->ws;
    const int* chunkcnt = (const int*)(ws + WS_CHUNKCNT);
    const f32x4* rowss = (const f32x4*)(ws + WS_ROWSS) + 5 * T;
    const int* sel = (const int*)(ws + WS_ROUTE); const float* gate = (const float*)(ws + WS_ROUTE + 2 * T * 4);
    int* perm = (int*)(ws + WS_ROUTE + 4 * T * 4); float* rsp = (float*)(ws + WS_ROUTE + 4 * T * 4 + (size_t)PERMROWS * 4); float* gp = (float*)(ws + WS_ROUTE + 4 * T * 4 + 2 * (size_t)PERMROWS * 4);
    LAS int* lc = (LAS int*)lds;
    LAS int* tot = (LAS int*)(lds + 64);
    LAS int* lb = (LAS int*)(lds + 128);
    const int lane = tid & 63, wv = __builtin_amdgcn_readfirstlane(tid >> 6);
    for (int chunk = vcu; chunk < T / 128; chunk += G) {
        __syncthreads();
        if (tid < 8) lc[tid] = 0;
        { float sa = 0.f, sb = 0.f;
#pragma unroll
            for (int i = 0; i < 4; ++i) { const int c = 4 * lane + i; const float v = (float)chunkcnt[c * 8 + wv]; sa += v; sb += (c < chunk) ? v : 0.f; }
            sa = wave_sum(sa); sb = wave_sum(sb);
            if (lane == 0) { tot[wv] = (int)sa; lb[wv] = (int)sb; } }
        __syncthreads();
        if (chunk == 0 && tid < 8) ((int*)(ws + OFF_MOECNT))[tid] = tot[tid];
        if (tid < 256) { const int sl = tid >> 7, tok = chunk * 128 + (tid & 127); const int e = sel[sl * T + tok];
            const int rnk = __hip_atomic_fetch_add(&lc[e], 1, __ATOMIC_RELAXED, __HIP_MEMORY_SCOPE_WORKGROUP);
            int off = 0;
#pragma unroll
            for (int j = 0; j < 8; ++j) { const int tl = (tot[j] + 255) >> 8; if (j < e) off += tl * 256; }
            const int pos = off + lb[e] + rnk;
            perm[pos] = tok + 65536 * sl; rsp[pos] = rstd4(rowss[tok]); gp[pos] = gate[sl * T + tok]; }
        if (chunk < 8) { const int e = chunk; int off = 0, ce = 0;
#pragma unroll
            for (int j = 0; j < 8; ++j) { const int cj = tot[j]; const int tl = (cj + 255) >> 8; if (j < e) off += tl * 256; if (j == e) ce = cj; }
            const int end = off + ((ce + 255) >> 8) * 256;
            for (int pos = off + ce + tid; pos < end; pos += NTHREADS) { perm[pos] = -1; rsp[pos] = 0.f; gp[pos] = 0.f; } }
    }
}

__device__ __forceinline__ void phase_final(ArgsP a, int vcu, int G, int lane, int wave) {
    const float* g = a->in[30]; const bf16* Y1 = (const bf16*)(a->ws + WS_Y1);
    const int gw = vcu * NWAVES + wave, NGW = G * NWAVES;
    f32x4 gv[4];
#pragma unroll
    for (int j = 0; j < 4; ++j) gv[j] = ((const f32x4*)g)[lane + 64 * j];
    for (int m0 = gw; m0 < T; m0 += 4 * NGW) {
        u32x2 xx[4][4], yy[4][4];
#pragma unroll
        for (int q4 = 0; q4 < 4; ++q4) { const int m = m0 + q4 * NGW; const u32x2* yr = (const u32x2*)(Y1 + (size_t)m * D) + lane; const u32x2* xbr = (const u32x2*)((const bf16*)(a->ws + WS_XB) + (size_t)m * D) + lane;
#pragma unroll
            for (int j = 0; j < 4; ++j) { xx[q4][j] = __builtin_nontemporal_load(&xbr[64 * j]); yy[q4][j] = __builtin_nontemporal_load(&yr[64 * j]); } }
#pragma unroll
        for (int q4 = 0; q4 < 4; ++q4) { const int m = m0 + q4 * NGW; f32x4* xr = (f32x4*)(a->out + (size_t)m * D) + lane; f32x4 v[4]; float ss = 0.f;
#pragma unroll
            for (int j = 0; j < 4; ++j) { v[j] = (f32x4){bf_lo(xx[q4][j].x) + bf_lo(yy[q4][j].x), bf_hi(xx[q4][j].x) + bf_hi(yy[q4][j].x), bf_lo(xx[q4][j].y) + bf_lo(yy[q4][j].y), bf_hi(xx[q4][j].y) + bf_hi(yy[q4][j].y)};
                ss += (v[j][0] * v[j][0] + v[j][1] * v[j][1]) + (v[j][2] * v[j][2] + v[j][3] * v[j][3]); }
            const float rstd = __builtin_amdgcn_rsqf(wave_sum(ss) * (1.0f / 1024.0f) + EPS);
#pragma unroll
            for (int j = 0; j < 4; ++j) __builtin_nontemporal_store(v[j] * rstd * gv[j], &xr[64 * j]); }
    }
}

__global__ void __launch_bounds__(NTHREADS, 2) fwd_kernel(Args args_byval) {
    extern __shared__ __attribute__((aligned(16))) unsigned char lds_raw[];
    LAS unsigned char* lds = (LAS unsigned char*)lds_raw;
    const int wave = __builtin_amdgcn_readfirstlane((int)threadIdx.x >> 6);
    const int G = gridDim.x; const int bx = blockIdx.x; const int vcu = (G % 8 == 0) ? (bx % 8) * (G / 8) + bx / 8 : bx;
#define ARGS() ArgsP args = (ArgsP)__builtin_amdgcn_kernarg_segment_ptr(); asm volatile("" : "+s"(args)); unsigned char* ws = args->ws; f32x4* rowss = (f32x4*)(ws + WS_ROWSS); bf16* XB = (bf16*)(ws + WS_XB); (void)rowss; (void)XB
#define TID() (wave * 64 + lane_id())
    volatile LAS unsigned* MISC = (volatile LAS unsigned*)(lds + MISC_OFF);
    if (threadIdx.x < 64) MISC[threadIdx.x] = 0u;
    __syncthreads();
    int lo, hi; XcdBarrier bar;
    { ARGS(); lo = args->ph_lo; hi = args->ph_hi; bar.bar = (unsigned*)ws + CW_BAR; bar.x = 0; bar.st = nullptr;
      if (hi - lo > 1) bar = xcd_barrier_post((unsigned*)ws + CW_BAR, MISC + 8); }
    unsigned long long pr_acc = 0ull, pr_t0 = 0ull;
#define IN(k) (((PROBE_MASK >> (k)) & 1u) ? (pr_t0 = __builtin_amdgcn_s_memrealtime(), lo <= (k) && (k) < hi) : (lo <= (k) && (k) < hi))
#define SEAM(k) do { if (lo <= (k) && (k) + 1 < hi) xcd_barrier(bar); if ((PROBE_MASK >> (k)) & 1u) pr_acc += __builtin_amdgcn_s_memrealtime() - pr_t0; } while (0)
    constexpr float QSCALE = 0.0625f * 1.4426950408889634f;

    if (EN_PRO && IN(0)) { ARGS(); for (int rep = 0; rep < REP_PRO; ++rep) { int t2 = TID(); OPAQUE(t2); phase_prologue(args, lds, vcu, G, t2, t2 & 63, wave); __syncthreads(); } }
    SEAM(0);
#pragma unroll 1
    for (int l = 0; l < 2; ++l) {
        const int pb = 1 + 8 * l;
        if (EN_GEMM && EN_G1 && IN(pb)) { ARGS();
            if (EN_KV && l == 0 && bx >= 128) {
                if (bx < 192) { pg8::Gemm g{(const bf16*)(ws + WS_MEMB), (const bf16*)(ws + WS_WK), nullptr, MROWS, 2048, D}; pg8::StaticOrder S; S.init(MROWS, 2048, 64, bx - 128);
                    pg8::EpiRowScale<false> E{(bf16*)(ws + WS_KB), 2048, (const void*)(ws + OFF_MEMSS), 1.0f};
                    pg8::gemm_phase<pg8::EpiRowScale<false>, pg8::StaticOrder, true, false>(lds, g, S, E, wave); }
                else { pg8::Gemm g{(const bf16*)(ws + WS_WV), (const bf16*)(ws + WS_MEMB), nullptr, 2048, MROWS, D}; pg8::StaticOrder S; S.init(2048, MROWS, 64, bx - 192);
                    pg8::EpiColScale E{(bf16*)(ws + WS_VT), 2048, (const u64*)(ws + OFF_MEMSS)};
                    pg8::gemm_phase<pg8::EpiColScale, pg8::StaticOrder, true, false>(lds, g, S, E, wave); }
            }
            pg8::Gemm g{XB, (const bf16*)(ws + WS_WIN) + (size_t)l * DIN * D, nullptr, T, DIN, D, (const float*)(rowss + (size_t)(3 * l) * T)}; pg8::StaticOrder S; S.init(T, DIN, G, bx);
            pg8::EpiRowScale<false, true> E{(bf16*)(ws + WS_Z), DIN, nullptr, 1.0f};
            pg8::gemm_phase<pg8::EpiRowScale<false, true>, pg8::StaticOrder, true, false, false, 2>(lds, g, S, E, wave);
        }
        SEAM(pb);
        if (EN_MIX && IN(pb + 1)) { ARGS(); for (int rep = 0; rep < REP_MIX; ++rep) { int t2 = TID(); asm volatile("" : "+v"(t2)); for (int u = vcu; u < 256; u += G) mixer_unit(args, lds, l, u, t2, t2 & 63, wave); } }
        SEAM(pb + 1);
        if (EN_GEMM && EN_G2 && IN(pb + 2)) { ARGS();
            pg8::Gemm g{(const bf16*)(ws + WS_MIXED), (const bf16*)(ws + WS_WOUT) + (size_t)l * D * D, nullptr, T, D, D}; pg8::StaticOrder S; S.init(T, D, G, bx);
            pg8::EpiResid<false, true> E{XB, nullptr, (float*)(rowss + (size_t)(3 * l + 1) * T), 1.0f, nullptr};
            pg8::gemm_phase<pg8::EpiResid<false, true>, pg8::StaticOrder, true, false>(lds, g, S, E, wave);
        }
        SEAM(pb + 2);
        if (EN_GEMM && EN_G3 && IN(pb + 3)) { ARGS();
            pg8::Gemm g{XB, (const bf16*)(ws + WS_WQ) + (size_t)l * D * D, nullptr, T, D, D, (const float*)(rowss + (size_t)(3 * l + 1) * T)}; pg8::StaticOrder S; S.init(T, D, G, bx);
            pg8::EpiRowScale<false, true> E{(bf16*)(ws + WS_Q), D, nullptr, QSCALE};
            for (int rep = 0; rep < REP_Q; ++rep) pg8::gemm_phase<pg8::EpiRowScale<false, true>, pg8::StaticOrder, true, false, false, 2>(lds, g, S, E, wave);
        }
        SEAM(pb + 3);
        if (EN_ATT && IN(pb + 4)) { ARGS(); for (int rep = 0; rep < REP_ATT; ++rep) { int t2 = TID(); asm volatile("" : "+v"(t2)); attn_phase(args, lds, l, vcu, G, t2, wave); } }
        SEAM(pb + 4);
        if (EN_GEMM && EN_G2 && IN(pb + 5)) { ARGS();
            pg8::Gemm g{(const bf16*)(ws + WS_O), (const bf16*)(ws + WS_WO) + (size_t)l * D * D, nullptr, T, D, D}; pg8::StaticOrder S; S.init(T, D, G, bx);
            pg8::EpiResid<false, true> E{XB, l == 1 ? ws + WS_XB8 : nullptr, (float*)(rowss + (size_t)(3 * l + 2) * T), 1.0f, nullptr};
            pg8::gemm_phase<pg8::EpiResid<false, true>, pg8::StaticOrder, true, false>(lds, g, S, E, wave);
        }
        SEAM(pb + 5);
        if (l == 0) {
            if (EN_GEMM && EN_G4 && IN(7)) { ARGS();
                pg8::Gemm g{XB, (const bf16*)(ws + WS_WGU), nullptr, T, 2 * DFF, D, (const float*)(rowss + (size_t)2 * T)}; pg8::StaticOrder S; S.init(T, 2 * DFF, G, bx);
                pg8::EpiSwiglu<false, true> E{(bf16*)(ws + WS_H), DFF, nullptr};
                for (int rep = 0; rep < REP_UP; ++rep) pg8::gemm_phase<pg8::EpiSwiglu<false, true>, pg8::StaticOrder, true, false, false, 2>(lds, g, S, E, wave);
            }
            SEAM(7);
            if (EN_GEMM && EN_G2 && IN(8)) { ARGS();
                pg8::Gemm g{(const bf16*)(ws + WS_H), (const bf16*)(ws + WS_WD), nullptr, T, D, DFF}; pg8::StaticOrder S; S.init(T, D, G, bx);
                pg8::EpiResid<false, true> E{XB, nullptr, (float*)(rowss + (size_t)3 * T), 1.0f, nullptr};
                pg8::gemm_phase<pg8::EpiResid<false, true>, pg8::StaticOrder, true, false>(lds, g, S, E, wave);
            }
            SEAM(8);
        } else {
            if (EN_ROUTE && IN(15)) { ARGS(); int t2 = TID(); OPAQUE(t2); phase_router(args, lds, vcu, G, t2, t2 & 63, wave); }
            SEAM(15);
            if (EN_ROUTE && IN(16)) { ARGS(); int t2 = TID(); OPAQUE(t2); phase_lists(args, lds, vcu, G, t2); }
            SEAM(16);
            if (EN_MOE && EN_MUP && IN(17)) { ARGS();
                const int* perm = (const int*)(ws + WS_ROUTE + 4 * T * 4); const float* rsp = (const float*)(ws + WS_ROUTE + 4 * T * 4 + (size_t)PERMROWS * 4);
                pg8::MoeOrder S; S.G = G; S.c = bx; S.tp[0] = 0; S.nN = 2 * DFF / 256;
                const int* cnt = (const int*)(ws + OFF_MOECNT);
#pragma unroll
                for (int j = 0; j < 8; ++j) S.tp[j + 1] = S.tp[j] + ((__builtin_amdgcn_readfirstlane(cnt[j]) + 255) >> 8);
                pg8::Gemm g{(const bf16*)(ws + WS_XB8), (const bf16*)(ws + WS_MWGU), perm, T, 2 * DFF, D / 2, rsp};
                pg8::EpiSwiglu8 E{ws + WS_H, DFF, rsp};
                pg8::gemm_phase<pg8::EpiSwiglu8, pg8::MoeOrder, true, true, true, 1>(lds, g, S, E, wave);
            }
            SEAM(17);
            if (EN_MOE && EN_MDN && IN(18)) { ARGS();
                const int* perm = (const int*)(ws + WS_ROUTE + 4 * T * 4); const float* gp = (const float*)(ws + WS_ROUTE + 4 * T * 4 + 2 * (size_t)PERMROWS * 4);
                pg8::MoeOrder S; S.G = G; S.c = bx; S.tp[0] = 0; S.nN = D / 256;
                const int* cnt = (const int*)(ws + OFF_MOECNT);
#pragma unroll
                for (int j = 0; j < 8; ++j) S.tp[j + 1] = S.tp[j] + ((__builtin_amdgcn_readfirstlane(cnt[j]) + 255) >> 8);
                pg8::Gemm g{(const bf16*)(ws + WS_H), (const bf16*)(ws + WS_MWD), perm, T, D, DFF / 2, gp};
                pg8::EpiResid<true, false> E{XB, nullptr, nullptr, 1.0f / S8_DN, (bf16*)(ws + WS_Y1)};
                pg8::gemm_phase<pg8::EpiResid<true, false>, pg8::MoeOrder, true, false, true, 1>(lds, g, S, E, wave);
            }
            SEAM(18);
            if (IN(19)) { ARGS(); int t2 = TID(); OPAQUE(t2); phase_final(args, vcu, G, t2 & 63, wave); }
            SEAM(19);
            if (PROBE_K && IN(19)) { ARGS();
                pg8::Gemm g{XB, (const bf16*)(ws + WS_WGU), nullptr, T, 2048, PROBE_K}; pg8::StaticOrder S; S.init(T, 2048, G, bx);
                pg8::EpiRowScale<false> E{(bf16*)(ws + WS_ACT), 2048, rowss, 1.0f};
                pg8::gemm_phase<pg8::EpiRowScale<false>, pg8::StaticOrder, true, false>(lds, g, S, E, wave); }
        }
    }
    if (PROBE_MLO >= 0 && bx == PROBE_MWG) { const unsigned long long t0 = __builtin_amdgcn_s_memrealtime(), dl = MISC[40]; while (__builtin_amdgcn_s_memrealtime() - t0 < dl) __builtin_amdgcn_s_sleep(8); }
    if (PROBE_MASK && bx == 0) { const unsigned long long t0 = __builtin_amdgcn_s_memrealtime(); while (__builtin_amdgcn_s_memrealtime() - t0 < pr_acc) __builtin_amdgcn_s_sleep(8); }
#undef IN
#undef SEAM
}

extern "C" void kernel_launch(void* const* d_in, const int* in_sizes, int n_in, void* d_out, int out_size, void* d_ws, size_t ws_size, hipStream_t stream) {
    static int grid = 0;
    if (grid == 0) {
        if (n_in != 31 || in_sizes[0] != T * D || out_size != T * D || ws_size < WS_END) { fprintf(stderr, "kernel_launch: unexpected shapes (n_in %d, in0 %d, out %d, ws %zu)\n", n_in, n_in > 0 ? in_sizes[0] : -1, out_size, ws_size); grid = -1; return; }
        int dev = 0, cus = 0;
        if (hipGetDevice(&dev) != hipSuccess || hipDeviceGetAttribute(&cus, hipDeviceAttributeMultiprocessorCount, dev) != hipSuccess) { grid = -1; return; }
        if (hipFuncSetAttribute((const void*)fwd_kernel, hipFuncAttributeMaxDynamicSharedMemorySize, LDS_BYTES) != hipSuccess) { fprintf(stderr, "kernel_launch: hipFuncSetAttribute failed\n"); grid = -1; return; }
        int per_cu = 0;
        if (hipOccupancyMaxActiveBlocksPerMultiprocessor(&per_cu, (const void*)fwd_kernel, NTHREADS, LDS_BYTES) != hipSuccess || per_cu < 1) fprintf(stderr, "kernel_launch: occupancy query reports %d\n", per_cu);
        (void)hipGetLastError();
        if (cus < 256) { fprintf(stderr, "kernel_launch: built for a 256-CU device (found %d CUs)\n", cus); grid = -1; return; }
        grid = 256;
    }
    if (grid < 0) return;
    (void)hipMemsetAsync(d_ws, 0, CTL_ZERO_BYTES, stream);
    Args a{};
    for (int i = 0; i < 31; ++i) a.in[i] = (const float*)d_in[i];
    a.out = (float*)d_out; a.ws = (unsigned char*)d_ws;
#if MK_PER_PHASE
    for (int ph = 0; ph < NPH; ++ph) { a.ph_lo = ph; a.ph_hi = ph + 1; hipLaunchKernelGGL(fwd_kernel, dim3(grid), dim3(NTHREADS), LDS_BYTES, stream, a); }
#else
    a.ph_lo = 0; a.ph_hi = NPH; hipLaunchKernelGGL(fwd_kernel, dim3(grid), dim3(NTHREADS), LDS_BYTES, stream, a);
#endif
}
```
